# Optimizing an MI355X kernel written in HIP

```python
import jax
import jax.numpy as jnp
from jax import lax
import numpy as np

D_MODEL = 1024
BATCH = 4
SEQ = 8192
DEPTH = 4

CHUNK = 64
N_MIXERS = 4
Q_BLOCK = 128
NORM_EPS = 1e-6
D_FF = 4 * D_MODEL

SB_HEADS = 16
SB_HEAD_DIM = D_MODEL // SB_HEADS
HG_HEADS = 8
HG_KEY_DIM = D_MODEL // HG_HEADS
HG_VAL_DIM = D_MODEL // HG_HEADS
RW_HEAD_DIM = 64
RW_HEADS = D_MODEL // RW_HEAD_DIM
RW_DECAY_LORA = 64
RW_AAA_LORA = 64
RW_GATE_LORA = 128
RW_GN_EPS = 64e-5
RW_DECAY_OFFSET = 0.5
SC_WIDTH = 3

N_SB = (DEPTH + N_MIXERS - 1) // N_MIXERS
N_HG = (DEPTH + N_MIXERS - 2) // N_MIXERS
N_RW = (DEPTH + N_MIXERS - 3) // N_MIXERS
N_SC = (DEPTH + N_MIXERS - 4) // N_MIXERS

kernel_name = 'hybrid_stickbreak_hgrn2_rwkv7_shortconv_trunk'


def rms_norm(x, g):
    xf = x.astype(jnp.float32)
    y = xf * lax.rsqrt(jnp.mean(jnp.square(xf), axis=-1, keepdims=True) + NORM_EPS)
    return (y * g.astype(jnp.float32)).astype(x.dtype)


def squared_relu_mlp(x, w_up, w_down):
    return jnp.square(jax.nn.relu(x @ w_up)) @ w_down


def stick_breaking_mixer(xn, w_qkv, w_out):
    B, S, _ = xn.shape
    qkv = xn @ w_qkv
    q, k, v = jnp.split(qkv, 3, axis=-1)
    heads = lambda t: t.reshape(B, S, SB_HEADS, SB_HEAD_DIM).transpose(0, 2, 1, 3)
    q, k, v = heads(q), heads(k), heads(v)
    scale = SB_HEAD_DIM ** -0.5
    outs = []
    for blk in range(S // Q_BLOCK):
        start = blk * Q_BLOCK
        end = start + Q_BLOCK
        kb, vb = k[:, :, :end], v[:, :, :end]
        z = jnp.einsum('bhqd,bhkd->bhqk', q[:, :, start:end], kb).astype(jnp.float32) * scale
        mask = jnp.arange(end)[None, :] < (start + jnp.arange(Q_BLOCK))[:, None]
        log_rest = jnp.where(mask, jax.nn.log_sigmoid(-z), 0.0)
        suffix = lax.cumsum(log_rest, axis=3, reverse=True) - log_rest
        attn = jnp.where(mask, jnp.exp(jax.nn.log_sigmoid(z) + suffix), 0.0)
        outs.append(jnp.einsum('bhqk,bhkd->bhqd', attn.astype(vb.dtype), vb))
    o = jnp.concatenate(outs, axis=2).transpose(0, 2, 1, 3).reshape(B, S, D_MODEL)
    return o @ w_out


def hgrn_lower_bound(table, layer_idx):
    p = jax.nn.softmax(table.astype(jnp.float32), axis=0)
    c = jnp.cumsum(p, axis=0)
    return c[layer_idx] - c[0]


def hgrn2_mixer(xn, w_in, lb, norm_g, w_out):
    B, S, _ = xn.shape
    nc = S // CHUNK
    proj = (xn @ w_in).astype(jnp.float32)
    q, fz, iv, g = jnp.split(proj, 4, axis=-1)
    q = jax.nn.silu(q)
    log_f = jnp.logaddexp(jnp.log(lb), jnp.log1p(-lb) + jax.nn.log_sigmoid(fz))
    kf = -jnp.expm1(log_f)

    def chunks(t, dim):
        return t.reshape(B, nc, CHUNK, HG_HEADS, dim).transpose(1, 0, 3, 2, 4)

    causal = jnp.tril(jnp.ones((CHUNK, CHUNK), dtype=bool))

    def step(state, inp):
        qc, lfc, kc, vc = inp
        b = lax.cumsum(lfc, axis=2)
        inter = jnp.einsum('bhtk,bhkv->bhtv', qc * jnp.exp(b), state)
        diff = b[:, :, :, None, :] - b[:, :, None, :, :]
        decay = jnp.exp(jnp.where(causal[None, None, :, :, None], diff, -jnp.inf))
        scores = jnp.einsum('bhtk,bhtsk,bhsk->bhts', qc, decay, kc)
        intra = jnp.einsum('bhts,bhsv->bhtv', scores, vc)
        b_last = b[:, :, -1:, :]
        new_state = (jnp.exp(b_last[:, :, 0, :])[..., None] * state
                     + jnp.einsum('bhsk,bhsv->bhkv', kc * jnp.exp(b_last - b), vc))
        return new_state, inter + intra

    s0 = jnp.zeros((B, HG_HEADS, HG_KEY_DIM, HG_VAL_DIM), jnp.float32)
    _, o = lax.scan(step, s0, (chunks(q, HG_KEY_DIM), chunks(log_f, HG_KEY_DIM),
                               chunks(kf, HG_KEY_DIM), chunks(iv, HG_VAL_DIM)))
    o = o.transpose(1, 0, 3, 2, 4).reshape(B, S, HG_HEADS, HG_VAL_DIM)
    o = o * lax.rsqrt(jnp.mean(jnp.square(o), axis=-1, keepdims=True) + NORM_EPS)
    o = o.reshape(B, S, D_MODEL) * norm_g * jax.nn.silu(g)
    return (o @ w_out).astype(xn.dtype)


def rwkv7_mixer(xn, mix, w_in, w0, w1, w2, a0, a1, a2, g1, g2, k_k, k_a, r_k, ln_g, ln_b, w_out):
    B, S, _ = xn.shape
    xf = xn.astype(jnp.float32)
    xx = jnp.pad(xf, ((0, 0), (1, 0), (0, 0)))[:, :S] - xf
    lerp = lambda c: xf + xx * mix[c]
    r = lerp(0) @ w_in[0]
    k = lerp(1) @ w_in[1]
    v = lerp(2) @ w_in[2]
    w_log = -jax.nn.softplus(-(w0 + jnp.tanh(lerp(3) @ w1) @ w2)) - RW_DECAY_OFFSET
    decay = jnp.exp(-jnp.exp(w_log))
    a = jax.nn.sigmoid(a0 + (lerp(4) @ a1) @ a2)
    g = jax.nn.sigmoid(lerp(5) @ g1) @ g2
    heads = lambda t: t.reshape(B, S, RW_HEADS, RW_HEAD_DIM)
    kk = heads(k * k_k)
    kk = kk / jnp.maximum(jnp.linalg.norm(kk, axis=-1, keepdims=True), 1e-12)
    k = k * (1.0 + (a - 1.0) * k_a)
    r_h, k_h, v_h, w_h, a_h = heads(r), heads(k), heads(v), heads(decay), heads(a)
    tm = lambda t: jnp.swapaxes(t, 0, 1)

    def step(state, inp):
        r_t, w_t, k_t, v_t, kk_t, a_t = inp
        sa = jnp.einsum('bhvk,bhk->bhv', state, -kk_t)
        state = (state * w_t[:, :, None, :]
                 + sa[..., None] * (kk_t * a_t)[:, :, None, :]
                 + v_t[..., None] * k_t[:, :, None, :])
        return state, jnp.einsum('bhvk,bhk->bhv', state, r_t)

    s0 = jnp.zeros((B, RW_HEADS, RW_HEAD_DIM, RW_HEAD_DIM), jnp.float32)
    _, y = lax.scan(step, s0, (tm(r_h), tm(w_h), tm(k_h), tm(v_h), tm(kk), tm(a_h)))
    y = jnp.swapaxes(y, 0, 1)
    mu = jnp.mean(y, axis=-1, keepdims=True)
    var = jnp.mean(jnp.square(y - mu), axis=-1, keepdims=True)
    yn = ((y - mu) * lax.rsqrt(var + RW_GN_EPS)).reshape(B, S, D_MODEL) * ln_g + ln_b
    bonus = jnp.sum(r_h * k_h * r_k, axis=-1, keepdims=True) * v_h
    out = (yn + bonus.reshape(B, S, D_MODEL)) * g
    return (out @ w_out).astype(xn.dtype)


def short_conv_mixer(xn, w_in, conv_w, conv_b, w_out):
    bg, cg, hx = jnp.split(xn @ w_in, 3, axis=-1)
    u = cg * hx
    y = lax.conv_general_dilated(u, conv_w[:, None, :].astype(u.dtype), window_strides=(1,),
                                 padding=[(SC_WIDTH - 1, 0)],
                                 dimension_numbers=('NWC', 'WIO', 'NWC'),
                                 feature_group_count=D_MODEL) + conv_b
    return (bg * y) @ w_out


def setup_inputs(seed: int = 0) -> dict:
    key = jax.random.key(seed)
    ks = list(jax.random.split(key, 40))
    nrm = lambda shape, scale: scale * jax.random.normal(ks.pop(), shape, jnp.float32)
    D = D_MODEL
    inv = D ** -0.5
    return {
        'x': nrm((BATCH, SEQ, D), 1.0),
        'norm_mix_g': 1.0 + nrm((DEPTH, D), 0.02),
        'norm_ffn_g': 1.0 + nrm((DEPTH, D), 0.02),
        'ffn_w_up': nrm((DEPTH, D, D_FF), inv),
        'ffn_w_down': nrm((DEPTH, D_FF, D), D_FF ** -0.5),
        'final_norm_g': 1.0 + nrm((D,), 0.02),
        'sb_w_qkv': nrm((N_SB, D, 3 * D), inv),
        'sb_w_out': nrm((N_SB, D, D), inv),
        'hg_w_in': nrm((N_HG, D, 4 * D), inv),
        'hg_lower_bounds': nrm((DEPTH, D), 0.1),
        'hg_norm_g': 1.0 + nrm((N_HG, D), 0.02),
        'hg_w_out': nrm((N_HG, D, D), inv),
        'rw_mix': jax.random.uniform(ks.pop(), (N_RW, 6, D), jnp.float32),
        'rw_w_in': nrm((N_RW, 3, D, D), inv),
        'rw_w0': nrm((N_RW, D), 0.5),
        'rw_w1': nrm((N_RW, D, RW_DECAY_LORA), inv),
        'rw_w2': nrm((N_RW, RW_DECAY_LORA, D), 0.5 * RW_DECAY_LORA ** -0.5),
        'rw_a0': nrm((N_RW, D), 0.1),
        'rw_a1': nrm((N_RW, D, RW_AAA_LORA), inv),
        'rw_a2': nrm((N_RW, RW_AAA_LORA, D), 0.5 * RW_AAA_LORA ** -0.5),
        'rw_g1': nrm((N_RW, D, RW_GATE_LORA), inv),
        'rw_g2': nrm((N_RW, RW_GATE_LORA, D), RW_GATE_LORA ** -0.5),
        'rw_k_k': 0.85 + nrm((N_RW, D), 0.02),
        'rw_k_a': 1.0 + nrm((N_RW, D), 0.02),
        'rw_r_k': nrm((N_RW, RW_HEADS, RW_HEAD_DIM), 0.1),
        'rw_ln_g': 1.0 + nrm((N_RW, D), 0.02),
        'rw_ln_b': nrm((N_RW, D), 0.02),
        'rw_w_out': nrm((N_RW, D, D), inv),
        'sc_w_in': nrm((N_SC, D, 3 * D), inv),
        'sc_conv_w': nrm((N_SC, SC_WIDTH, D), SC_WIDTH ** -0.5),
        'sc_conv_b': nrm((N_SC, D), 0.02),
        'sc_w_out': nrm((N_SC, D, D), inv),
    }


def reference(x, norm_mix_g, norm_ffn_g, ffn_w_up, ffn_w_down, final_norm_g,
              sb_w_qkv, sb_w_out, hg_w_in, hg_lower_bounds, hg_norm_g, hg_w_out,
              rw_mix, rw_w_in, rw_w0, rw_w1, rw_w2, rw_a0, rw_a1, rw_a2, rw_g1, rw_g2,
              rw_k_k, rw_k_a, rw_r_k, rw_ln_g, rw_ln_b, rw_w_out,
              sc_w_in, sc_conv_w, sc_conv_b, sc_w_out):
    h = x
    for i in range(DEPTH):
        m, j = i % N_MIXERS, i // N_MIXERS
        xn = rms_norm(h, norm_mix_g[i])
        if m == 0:
            y = stick_breaking_mixer(xn, sb_w_qkv[j], sb_w_out[j])
        elif m == 1:
            lb = hgrn_lower_bound(hg_lower_bounds, i)
            y = hgrn2_mixer(xn, hg_w_in[j], lb, hg_norm_g[j], hg_w_out[j])
        elif m == 2:
            y = rwkv7_mixer(xn, rw_mix[j], rw_w_in[j], rw_w0[j], rw_w1[j], rw_w2[j],
                            rw_a0[j], rw_a1[j], rw_a2[j], rw_g1[j], rw_g2[j],
                            rw_k_k[j], rw_k_a[j], rw_r_k[j], rw_ln_g[j], rw_ln_b[j], rw_w_out[j])
        else:
            y = short_conv_mixer(xn, sc_w_in[j], sc_conv_w[j], sc_conv_b[j], sc_w_out[j])
        h = h + y
        h = h + squared_relu_mlp(rms_norm(h, norm_ffn_g[i]), ffn_w_up[i], ffn_w_down[i])
    return rms_norm(h, final_norm_g)
```

```cpp
#include <hip/hip_runtime.h>
#include <hip/hip_cooperative_groups.h>
#include <cstdio>
#include <cstdint>
namespace cg = cooperative_groups;
namespace pg8 {
#define PG8_LAS __attribute__((address_space(3)))
typedef unsigned short bf16_t;
typedef short bf16x8 __attribute__((ext_vector_type(8)));
typedef float f32x4 __attribute__((ext_vector_type(4)));
typedef unsigned u32x4 __attribute__((ext_vector_type(4)));
constexpr int BM = 256, BK = 64, HALF = 128, HTB = HALF * BK * 2  , STAGE_BYTES = 8 * HTB, NXCD = 8, WGM = 8;

__host__ __device__ __forceinline__ int lds_byte(int r, int c) { const int st = (r >> 4) * 2 + (c >> 5), rr = r & 15, cc = c & 31, ob = rr * 64 + cc * 2; return st * 1024 + (ob ^ (((ob >> 9) & 1) << 5)); }
__host__ __device__ __forceinline__ void stage_rc(int b, int& R, int& C) { const int st = b / 1024, sb = b % 1024, swz = sb ^ (((sb >> 9) & 1) << 5); R = (st >> 1) * 16 + swz / 64; C = (st & 1) * 32 + (swz % 64) / 2; }
__host__ __device__ __forceinline__ int perm32(int rho) { const int n = rho >> 4, i = rho & 15; return 8 * (i >> 2) + 4 * n + (i & 3); }

struct Unit { int pm, pn; };
struct Gemm { const bf16_t* A; const bf16_t* Bt; int M, N, K; };

struct StaticOrder {
    int nM, nN, nwg, G, c;
    __host__ __device__ void init(int M, int N, int G_, int c_) { nM = M / BM; nN = N / BM; nwg = nM * nN; G = G_; c = c_; }
    __host__ __device__ bool next(int i, Unit& u) const {
        const long L = (long)i * G + c; if (L >= nwg) return false;
        int wgid = (int)L; { const int q = nwg / NXCD, r = nwg % NXCD, xcd = wgid % NXCD, off = wgid / NXCD; wgid = (xcd < r ? xcd * (q + 1) : r * (q + 1) + (xcd - r) * q) + off; }
        const int wgm = nN >= 8 ? 4 : WGM; const int nig = wgm * nN, gid = wgid / nig, fm = gid * wgm, gsz = (nM - fm) < wgm ? (nM - fm) : wgm;
        u.pm = fm + ((wgid % nig) % gsz); u.pn = (wgid % nig) / gsz; return true;
    }
    __device__ __forceinline__ void a_ready(const Unit&) const {}
    __device__ __forceinline__ void done(const Unit&) const {}
};

__device__ __forceinline__ unsigned cvt_pk_bf16(float lo, float hi) { unsigned r; asm volatile("v_cvt_pk_bf16_f32 %0, %1, %2" : "=v"(r) : "v"(lo), "v"(hi)); return r; }
typedef unsigned u32x4 __attribute__((ext_vector_type(4)));
typedef unsigned u32x2 __attribute__((ext_vector_type(2)));
constexpr float LOG2E = 1.4426950408889634f;
__device__ __forceinline__ float fast_sigmoid(float x) { return __builtin_amdgcn_rcpf(1.0f + __builtin_amdgcn_exp2f(-x * LOG2E)); }
__device__ __forceinline__ float row_rs(const float* rs, int row) {
    const f32x4* p = (const f32x4*)(rs + (size_t)row * 16);
    const f32x4 a = p[0], b = p[1], c = p[2], d = p[3];
    const float s = ((a[0] + a[1]) + (a[2] + a[3])) + ((b[0] + b[1]) + (b[2] + b[3])) + ((c[0] + c[1]) + (c[2] + c[3])) + ((d[0] + d[1]) + (d[2] + d[3]));
    return 1.0f / sqrtf(s * (1.0f / 1024.0f) + 1e-6f);
}
template <int MODE> struct EpiAct {
    static constexpr bool PERM = true, AFTER_DRAIN = false;
    bf16_t* O; int ldc; int split_cols; size_t split_stride; const float* rs; float scale0; const float* aux;
    __device__ __forceinline__ void operator()(const f32x4 (&acc)[2][2][4][2], const Unit& u, int wr, int wc, int fr, int fq) const {
        const int row0 = u.pm * BM + wr * 64 + fr; int colt = u.pn * BM; bf16_t* base = O; int t = 0;
        if (split_cols) { t = colt / split_cols; base += (size_t)t * split_stride; colt -= t * split_cols; }
        const float sc = (MODE == 0 && t == 0) ? scale0 : 1.f;
        const int col0 = colt + wc * 32 + 8 * fq;
        f32x4 lbk[2][2];
#pragma unroll
        for (int bj = 0; bj < 2; ++bj)
#pragma unroll
            for (int n = 0; n < 2; ++n) lbk[bj][n] = (MODE == 2 && t == 1) ? *(const f32x4*)(aux + col0 + bj * HALF + 4 * n) : (f32x4){0.f, 0.f, 0.f, 0.f};
        float rsv[2][4];
        if (rs) {
            f32x4 part[2][4];
#pragma unroll
            for (int ai = 0; ai < 2; ++ai)
#pragma unroll
                for (int m = 0; m < 4; ++m) part[ai][m] = *(const f32x4*)(rs + (size_t)(row0 + ai * HALF + m * 16) * 16 + 4 * fq);
#pragma unroll
            for (int ai = 0; ai < 2; ++ai)
#pragma unroll
                for (int m = 0; m < 4; ++m) { float s = (part[ai][m][0] + part[ai][m][1]) + (part[ai][m][2] + part[ai][m][3]); s += __shfl_xor(s, 16); s += __shfl_xor(s, 32);
                    rsv[ai][m] = sc / sqrtf(s * (1.0f / 1024.0f) + 1e-6f); }
        } else {
#pragma unroll
            for (int ai = 0; ai < 2; ++ai)
#pragma unroll
                for (int m = 0; m < 4; ++m) rsv[ai][m] = sc;
        }
#pragma unroll
        for (int ai = 0; ai < 2; ++ai)
#pragma unroll
            for (int m = 0; m < 4; ++m) {
                const int row = row0 + ai * HALF + m * 16;
                const float r = rsv[ai][m];
                bf16_t* rowp = base + (size_t)row * ldc + col0;
#pragma unroll
                for (int bj = 0; bj < 2; ++bj) {
                    f32x4 v[2] = {acc[ai][bj][m][0] * r, acc[ai][bj][m][1] * r};
#pragma unroll
                    for (int n = 0; n < 2; ++n)
#pragma unroll
                        for (int j = 0; j < 4; ++j) {
                            float x = v[n][j];
                            if (MODE == 1) { x = fmaxf(x, 0.f); x = x * x; }
                            if (MODE == 2) {
                                if (t == 0 || t == 3) x = x * fast_sigmoid(x);
                                else if (t == 1) x = lbk[bj][n][j] * __builtin_amdgcn_rcpf(1.0f + __builtin_amdgcn_exp2f(x * LOG2E));
                            }
                            v[n][j] = x;
                        }
                    u32x4 w; w.x = cvt_pk_bf16(v[0][0], v[0][1]); w.y = cvt_pk_bf16(v[0][2], v[0][3]); w.z = cvt_pk_bf16(v[1][0], v[1][1]); w.w = cvt_pk_bf16(v[1][2], v[1][3]);
                    *(u32x4*)(rowp + bj * HALF) = w;
                }
            }
    }
};
struct EpiRw1 {
    static constexpr bool PERM = true, AFTER_DRAIN = false;
    bf16_t* RKV; size_t split_stride; bf16_t* L;
    __device__ __forceinline__ void operator()(const f32x4 (&acc)[2][2][4][2], const Unit& u, int wr, int wc, int fr, int fq) const {
        const int row0 = u.pm * BM + wr * 64 + fr;
        const bool lora = (u.pn >= 12);
        bf16_t* base = lora ? L : RKV + (size_t)(u.pn >> 2) * split_stride;
        const int ldc = lora ? 256 : 1024;
        const int col0 = (lora ? 0 : (u.pn & 3) * BM) + wc * 32 + 8 * fq;
#pragma unroll
        for (int ai = 0; ai < 2; ++ai)
#pragma unroll
            for (int m = 0; m < 4; ++m) {
                bf16_t* rowp = base + (size_t)(row0 + ai * HALF + m * 16) * ldc + col0;
#pragma unroll
                for (int bj = 0; bj < 2; ++bj) {
                    f32x4 v[2] = {acc[ai][bj][m][0], acc[ai][bj][m][1]};
                    if (lora) {
#pragma unroll
                        for (int n = 0; n < 2; ++n)
#pragma unroll
                            for (int j = 0; j < 4; ++j) {
                                float x = v[n][j];
                                if (bj == 1) x = fast_sigmoid(x);
                                else if (wc < 2) x = 1.0f - 2.0f * __builtin_amdgcn_rcpf(1.0f + __builtin_amdgcn_exp2f(fminf(x, 40.f) * (2.0f * LOG2E)));
                                v[n][j] = x;
                            }
                    }
                    u32x4 w; w.x = cvt_pk_bf16(v[0][0], v[0][1]); w.y = cvt_pk_bf16(v[0][2], v[0][3]); w.z = cvt_pk_bf16(v[1][0], v[1][1]); w.w = cvt_pk_bf16(v[1][2], v[1][3]);
                    *(u32x4*)(rowp + bj * HALF) = w;
                }
            }
    }
};
struct EpiRw2 {
    static constexpr bool PERM = true, AFTER_DRAIN = false;
    bf16_t* WM; size_t offA, offG; const float* w0; const float* a0;
    __device__ __forceinline__ void operator()(const f32x4 (&acc)[2][2][4][2], const Unit& u, int wr, int wc, int fr, int fq) const {
        const int row0 = u.pm * BM + wr * 64 + fr; const int t = u.pn >> 2;
        bf16_t* base = WM + (t == 1 ? offA : (size_t)0) + (t == 2 ? offG : (size_t)0);
        const float* bias = t == 0 ? w0 : a0;
        const int col0 = (u.pn & 3) * BM + wc * 32 + 8 * fq;
        f32x4 bv[2][2];
#pragma unroll
        for (int bj = 0; bj < 2; ++bj)
#pragma unroll
            for (int n = 0; n < 2; ++n) bv[bj][n] = (t < 2) ? *(const f32x4*)(bias + col0 + bj * HALF + 4 * n) : (f32x4){0.f, 0.f, 0.f, 0.f};
#pragma unroll
        for (int ai = 0; ai < 2; ++ai)
#pragma unroll
            for (int m = 0; m < 4; ++m) {
                bf16_t* rowp = base + (size_t)(row0 + ai * HALF + m * 16) * 1024 + col0;
#pragma unroll
                for (int bj = 0; bj < 2; ++bj) {
                    f32x4 v[2] = {acc[ai][bj][m][0], acc[ai][bj][m][1]};
                    if (t < 2) {
                        v[0] += bv[bj][0]; v[1] += bv[bj][1];
#pragma unroll
                        for (int n = 0; n < 2; ++n)
#pragma unroll
                            for (int j = 0; j < 4; ++j) {
                                float x = fast_sigmoid(v[n][j]);
                                if (t == 0) x = 1.0f - __builtin_amdgcn_exp2f(x * (-0.6065306597126334f * LOG2E));
                                v[n][j] = x;
                            }
                    }
                    u32x4 w; w.x = cvt_pk_bf16(v[0][0], v[0][1]); w.y = cvt_pk_bf16(v[0][2], v[0][3]); w.z = cvt_pk_bf16(v[1][0], v[1][1]); w.w = cvt_pk_bf16(v[1][2], v[1][3]);
                    *(u32x4*)(rowp + bj * HALF) = w;
                    asm volatile("" ::: "memory");
                }
            }
    }
};
struct EpiResid {
    static constexpr bool PERM = false, AFTER_DRAIN = false;
    const float* base; float* out; bf16_t* hb; float* rsq;
    __device__ __forceinline__ void operator()(const f32x4 (&acc)[2][2][4][2], const Unit& u, int wr, int wc, int fr, int fq) const {
        const int col0 = u.pn * BM + wc * 32 + 4 * fq;
#pragma unroll
        for (int ai = 0; ai < 2; ++ai) {
            f32x4 pre[4][2][2];
#pragma unroll
            for (int m = 0; m < 4; ++m) { const size_t off = (size_t)(u.pm * BM + ai * HALF + wr * 64 + m * 16 + fr) * 1024 + col0;
#pragma unroll
                for (int bj = 0; bj < 2; ++bj)
#pragma unroll
                    for (int n = 0; n < 2; ++n) pre[m][bj][n] = *(const f32x4*)(base + off + bj * HALF + n * 16); }
#pragma unroll
            for (int m = 0; m < 4; ++m) {
                const int row = u.pm * BM + ai * HALF + wr * 64 + m * 16 + fr; const size_t off = (size_t)row * 1024 + col0;
                float ss = 0.f;
#pragma unroll
                for (int bj = 0; bj < 2; ++bj)
#pragma unroll
                    for (int n = 0; n < 2; ++n) {
                        const f32x4 o = pre[m][bj][n] + acc[ai][bj][m][n];
                        *(f32x4*)(out + off + bj * HALF + n * 16) = o;
                        u32x2 w; w.x = cvt_pk_bf16(o[0], o[1]); w.y = cvt_pk_bf16(o[2], o[3]);
                        *(u32x2*)(hb + off + bj * HALF + n * 16) = w;
                        ss += (o[0] * o[0] + o[1] * o[1]) + (o[2] * o[2] + o[3] * o[3]);
                    }
                ss += __shfl_xor(ss, 16); ss += __shfl_xor(ss, 32);
                if (fq == 0) rsq[(size_t)row * 16 + u.pn * 4 + wc] = ss;
            }
        }
    }
};
template <class Epi, class Sched, bool ALIGN_EPI = false, bool SP2 = false>
__device__ __forceinline__ void gemm_phase(PG8_LAS unsigned char* lds, const Gemm g, const Sched& S, const Epi& E) {
    int tid_ = threadIdx.x; asm volatile("" : "+v"(tid_)); const int tid = tid_, wid = __builtin_amdgcn_readfirstlane(tid >> 6), lane = tid & 63, wr = wid >> 2, wc = wid & 3, fr = lane & 15, fq = lane >> 4;
    const int K = g.K, nt = K / BK;
    unsigned voffA[2], voffB[2];
#pragma unroll
    for (int i = 0; i < 2; ++i) { int R, C; stage_rc(tid * 16 + i * 8192, R, C); const int Rb = Epi::PERM ? ((R & ~31) + perm32(R & 31)) : R;
        voffA[i] = (unsigned)(R * K + C) * 2u; voffB[i] = (unsigned)(Rb * K + C) * 2u; }
    const size_t kstep = (size_t)(BK * 2);
    const size_t hstep = (size_t)HALF * K * 2;
    const size_t tstep = 2 * hstep;
    const unsigned ldsw = (unsigned)wid * 1024u;
    const int aoff = lds_byte(wr * 64 + fr, fq * 8), boff = lds_byte(wc * 32 + fr, fq * 8);
#define PG8_SA(b, h) (((b) * 2 + (h)) * HTB)
#define PG8_SB(b, h) ((4 + (b) * 2 + (h)) * HTB)
#define PG8_STAGE(bufoff, gbase, voff) do { _Pragma("unroll") for (int _i = 0; _i < 2; ++_i) \
        __builtin_amdgcn_global_load_lds((const unsigned*)((const char*)(gbase) + (voff)[_i]), (PG8_LAS unsigned*)(lds + (bufoff) + ldsw + _i * 8192), 16, 0, 0); } while (0)
#define PG8_LDA(dst, b, h) do { _Pragma("unroll") for (int m = 0; m < 4; ++m) _Pragma("unroll") for (int k = 0; k < 2; ++k) dst[m][k] = *(const PG8_LAS bf16x8*)(lds + PG8_SA(b, h) + aoff + m * 2048 + k * 1024); } while (0)
#define PG8_LDB(dst, b, h) do { _Pragma("unroll") for (int n = 0; n < 2; ++n) _Pragma("unroll") for (int k = 0; k < 2; ++k) dst[n][k] = *(const PG8_LAS bf16x8*)(lds + PG8_SB(b, h) + boff + n * 2048 + k * 1024); } while (0)
#define PG8_MMA(ai, bj, At, Bt) do { __builtin_amdgcn_s_setprio(1); _Pragma("unroll") for (int m = 0; m < 4; ++m) _Pragma("unroll") for (int n = 0; n < 2; ++n) _Pragma("unroll") for (int k = 0; k < 2; ++k) \
        acc[ai][bj][m][n] = __builtin_amdgcn_mfma_f32_16x16x32_bf16(Bt[n][k], At[m][k], acc[ai][bj][m][n], 0, 0, 0); __builtin_amdgcn_s_setprio(0); } while (0)
#define PG8_WAIT_V(n) asm volatile("s_waitcnt vmcnt(" #n ")" ::: "memory")
#define PG8_WAIT_L(n) asm volatile("s_waitcnt lgkmcnt(" #n ")" ::: "memory")
#define PG8_BAR __builtin_amdgcn_s_barrier()
#define PG8_SCHED __builtin_amdgcn_sched_barrier(0)
    Unit cur, nxt; int ui = 0;
    if (!S.next(0, cur)) return;
    f32x4 acc[2][2][4][2];
#pragma unroll
    for (int a = 0; a < 2; ++a)
#pragma unroll
        for (int b = 0; b < 2; ++b)
#pragma unroll
            for (int m = 0; m < 4; ++m)
#pragma unroll
                for (int n = 0; n < 2; ++n) acc[a][b][m][n] = (f32x4){0.f, 0.f, 0.f, 0.f};
    bf16x8 At[4][2], B0[2][2], B1[2][2];
    const char* cA = (const char*)g.A + (size_t)cur.pm * tstep; const char* cB = (const char*)g.Bt + (size_t)cur.pn * tstep;
    S.a_ready(cur);
    if constexpr (SP2) {
        PG8_STAGE(PG8_SB(0, 0), cB, voffB); PG8_STAGE(PG8_SB(0, 1), cB + hstep, voffB); PG8_STAGE(PG8_SA(0, 0), cA, voffA); PG8_STAGE(PG8_SA(0, 1), cA + hstep, voffA);
        if (wr == 1) PG8_BAR;
        PG8_WAIT_V(2); PG8_BAR;
        PG8_STAGE(PG8_SB(1, 0), cB + kstep, voffB); PG8_STAGE(PG8_SA(1, 0), cA + kstep, voffA); PG8_STAGE(PG8_SB(1, 1), cB + hstep + kstep, voffB);
        PG8_WAIT_V(6); PG8_BAR;
    } else {
        PG8_STAGE(PG8_SB(0, 0), cB, voffB); PG8_STAGE(PG8_SA(0, 0), cA, voffA); PG8_STAGE(PG8_SB(0, 1), cB + hstep, voffB); PG8_STAGE(PG8_SA(0, 1), cA + hstep, voffA);
        if (wr == 1) PG8_BAR;
        PG8_WAIT_V(4); PG8_BAR;
        PG8_STAGE(PG8_SB(1, 0), cB + kstep, voffB); PG8_STAGE(PG8_SA(1, 0), cA + kstep, voffA); PG8_STAGE(PG8_SB(1, 1), cB + hstep + kstep, voffB);
        PG8_WAIT_V(6); PG8_BAR;
    }
    for (;;) {
        const bool has_next = S.next(ui + 1, nxt);
        const char* nA = has_next ? (const char*)g.A + (size_t)nxt.pm * tstep : cA; const char* nB = has_next ? (const char*)g.Bt + (size_t)nxt.pn * tstep : cB;
        for (int t = 0; t < nt; t += 2) {
            const bool last = (t == nt - 2);
            const char* a1 = cA + (size_t)(t + 1) * kstep;
            const char* a2 = last ? nA : cA + (size_t)(t + 2) * kstep; const char* b2 = last ? nB : cB + (size_t)(t + 2) * kstep;
            const char* a3 = a2 + kstep; const char* b3 = b2 + kstep;
            if (last && has_next) S.a_ready(nxt);
            if constexpr (SP2) {
            PG8_LDB(B0, 0, 0); PG8_LDB(B1, 0, 1); PG8_SCHED; PG8_LDA(At, 0, 0); PG8_STAGE(PG8_SA(1, 1), a1 + hstep, voffA);
            PG8_WAIT_V(8); PG8_WAIT_L(0); PG8_BAR; PG8_MMA(0, 0, At, B0); PG8_MMA(0, 1, At, B1); PG8_BAR; PG8_SCHED;
            PG8_LDA(At, 0, 1); PG8_STAGE(PG8_SB(0, 0), b2, voffB); PG8_STAGE(PG8_SB(0, 1), b2 + hstep, voffB); PG8_STAGE(PG8_SA(0, 0), a2, voffA);
            PG8_WAIT_V(8); PG8_WAIT_L(0); PG8_BAR; PG8_MMA(1, 0, At, B0); PG8_MMA(1, 1, At, B1); PG8_BAR; PG8_SCHED;
            PG8_LDB(B0, 1, 0); PG8_LDB(B1, 1, 1); PG8_SCHED; PG8_LDA(At, 1, 0); PG8_STAGE(PG8_SA(0, 1), a2 + hstep, voffA);
            PG8_WAIT_V(8); PG8_WAIT_L(0); PG8_BAR; PG8_MMA(0, 0, At, B0); PG8_MMA(0, 1, At, B1); PG8_BAR; PG8_SCHED;
            PG8_LDA(At, 1, 1); PG8_STAGE(PG8_SB(1, 0), b3, voffB); PG8_STAGE(PG8_SB(1, 1), b3 + hstep, voffB); PG8_STAGE(PG8_SA(1, 0), a3, voffA);
            PG8_WAIT_V(8); PG8_WAIT_L(0); PG8_BAR; PG8_MMA(1, 0, At, B0); PG8_MMA(1, 1, At, B1); PG8_BAR; PG8_SCHED;
            } else {
            PG8_LDB(B0, 0, 0); PG8_SCHED; PG8_LDA(At, 0, 0); PG8_STAGE(PG8_SA(1, 1), a1 + hstep, voffA);
            PG8_WAIT_L(8); PG8_BAR; PG8_WAIT_L(0); PG8_MMA(0, 0, At, B0); PG8_BAR; PG8_SCHED;
            PG8_LDB(B1, 0, 1); PG8_STAGE(PG8_SB(0, 0), b2, voffB);
            PG8_BAR; PG8_WAIT_L(0); PG8_MMA(0, 1, At, B1); PG8_BAR;
            PG8_LDA(At, 0, 1); PG8_STAGE(PG8_SA(0, 0), a2, voffA);
            PG8_BAR; PG8_WAIT_L(0); PG8_MMA(1, 0, At, B0); PG8_BAR; PG8_SCHED;
            PG8_STAGE(PG8_SB(0, 1), b2 + hstep, voffB);
            PG8_WAIT_V(6); PG8_BAR; PG8_MMA(1, 1, At, B1); PG8_BAR;
            PG8_LDB(B0, 1, 0); PG8_SCHED; PG8_LDA(At, 1, 0); PG8_STAGE(PG8_SA(0, 1), a2 + hstep, voffA);
            PG8_WAIT_L(8); PG8_BAR; PG8_WAIT_L(0); PG8_MMA(0, 0, At, B0); PG8_BAR; PG8_SCHED;
            PG8_LDB(B1, 1, 1); PG8_STAGE(PG8_SB(1, 0), b3, voffB);
            PG8_BAR; PG8_WAIT_L(0); PG8_MMA(0, 1, At, B1); PG8_BAR;
            PG8_LDA(At, 1, 1); PG8_STAGE(PG8_SA(1, 0), a3, voffA);
            PG8_BAR; PG8_WAIT_L(0); PG8_MMA(1, 0, At, B0); PG8_BAR; PG8_SCHED;
            PG8_STAGE(PG8_SB(1, 1), b3 + hstep, voffB);
            PG8_WAIT_V(6); PG8_BAR; PG8_MMA(1, 1, At, B1); PG8_BAR;
            }
        }
        if constexpr (ALIGN_EPI) { if (wr == 0) PG8_BAR; }
        if constexpr (!Epi::AFTER_DRAIN) { E(acc, cur, wr, wc, fr, fq); S.done(cur); }
        if (!has_next) break;
#pragma unroll
        for (int a = 0; a < 2; ++a)
#pragma unroll
            for (int b = 0; b < 2; ++b)
#pragma unroll
                for (int m = 0; m < 4; ++m)
#pragma unroll
                    for (int n = 0; n < 2; ++n) acc[a][b][m][n] = (f32x4){0.f, 0.f, 0.f, 0.f};
        cur = nxt; cA = nA; cB = nB; ++ui;
        if constexpr (ALIGN_EPI) { if (wr == 1) PG8_BAR; }
    }
    PG8_WAIT_V(0);
    if constexpr (!ALIGN_EPI) { if (wr == 0) PG8_BAR; }
    PG8_BAR;
    if constexpr (Epi::AFTER_DRAIN) { E.fused(acc, cur, wr, wc, fr, fq, lds, wid, lane); S.done(cur); }
#undef PG8_SA
#undef PG8_SB
#undef PG8_STAGE
#undef PG8_LDA
#undef PG8_LDB
#undef PG8_MMA
#undef PG8_WAIT_V
#undef PG8_WAIT_L
#undef PG8_BAR
#undef PG8_SCHED
}
}
#define GAS __attribute__((address_space(1)))
#define LAS __attribute__((address_space(3)))
typedef unsigned short bf16;
typedef unsigned v4u __attribute__((ext_vector_type(4)));
typedef unsigned v2u __attribute__((ext_vector_type(2)));
typedef float f32x4 __attribute__((ext_vector_type(4)));
typedef short bf16x8 __attribute__((ext_vector_type(8)));
#ifndef REP_HG
#define REP_HG 1
#endif
#ifndef REP_RW
#define REP_RW 1
#endif
#ifndef REP_UP
#define REP_UP 1
#endif
#ifndef REP_ATT
#define REP_ATT 1
#endif
#ifndef REP_PRO
#define REP_PRO 1
#endif
#ifndef REP_G1
#define REP_G1 1
#endif
#ifndef REP_G2
#define REP_G2 1
#endif
#ifndef REP_SC
#define REP_SC 1
#endif
#ifndef REP_DN
#define REP_DN 1
#endif
#ifndef REP_OUT
#define REP_OUT 1
#endif
#ifndef REP_HGL
#define REP_HGL 1
#endif
#ifndef REP_IN
#define REP_IN 1
#endif
#ifndef REP_SYNC
#define REP_SYNC 1
#endif
#define GRID_SYNC() do { for (int r_ = 0; r_ < REP_SYNC; ++r_) xcd_barrier(xbar); } while (0)
constexpr int NWAVES = 8, NTHR = 512;
constexpr int M = 32768, D = 1024, SEQ = 8192, FF = 4096;
constexpr size_t MiB = 1u << 20;
constexpr size_t WS_BAR = 64 * 1024, WS_BAR_BYTES = 16 * 1024;
constexpr size_t WS_LBK = 0;
constexpr size_t WS_RS = 1 * MiB;
constexpr size_t WS_WA = 4 * MiB, WS_WB = 18 * MiB, WS_WO = 20 * MiB, WS_WUP = 22 * MiB, WS_WDN = 30 * MiB;
constexpr size_t WS_HB = 38 * MiB;
constexpr size_t WS_BIG = 102 * MiB;
constexpr size_t SLOT = 64 * MiB;
constexpr size_t WS_END = 512 * MiB;
constexpr int LDS_BYTES = 163840;
constexpr float LOG2E_F = 1.4426950408889634f;

#define LDS_WAIT() asm volatile("s_waitcnt lgkmcnt(0)" ::: "memory")
typedef float f32x2_t __attribute__((ext_vector_type(2))); typedef __bf16 bf16x2_t __attribute__((ext_vector_type(2)));
__device__ __forceinline__ unsigned pk2(float lo, float hi) { const f32x2_t v = {lo, hi}; const bf16x2_t b = __builtin_convertvector(v, bf16x2_t); return __builtin_bit_cast(unsigned, b); }
__device__ __forceinline__ unsigned f2bf(float f) { return pk2(f, 0.f) & 0xffffu; }
__device__ __forceinline__ float bflo(unsigned u) { return __builtin_bit_cast(float, u << 16); }
__device__ __forceinline__ float bfhi(unsigned u) { return __builtin_bit_cast(float, u & 0xffff0000u); }
__device__ __forceinline__ float bf1(unsigned short b) { return __builtin_bit_cast(float, (unsigned)b << 16); }
__device__ __forceinline__ f32x4 bf4(v2u u) { return (f32x4){bflo(u.x), bfhi(u.x), bflo(u.y), bfhi(u.y)}; }
__device__ __forceinline__ float wave_sum(float v) {
#pragma unroll
    for (int o = 1; o < 64; o <<= 1) v += __shfl_xor(v, o);
    return v;
}
template <int CTRL> __device__ __forceinline__ float dpp_f(float x) { return __builtin_bit_cast(float, __builtin_amdgcn_update_dpp(0, __builtin_bit_cast(int, x), CTRL, 0xf, 0xf, true)); }
__device__ __forceinline__ float row16_sum(float x) { x += dpp_f<0xB1>(x); x += dpp_f<0x4E>(x); x += dpp_f<0x141>(x); x += dpp_f<0x140>(x); return x; }

__device__ __forceinline__ void wt_item(const float* W, int K, int N, bf16* WT, int ld, int row_off, int col_off, const float* sc, LAS float* scr, int item, int lane) {
    const int nblk = N / 32, kb = item / nblk, nb = item % nblk, k0 = 64 * kb, n0 = 32 * nb;
    f32x4 wv[8]; float sv[8];
#pragma unroll
    for (int i = 0; i < 8; ++i) { const int kk = 8 * i + (lane >> 3); wv[i] = *(const f32x4*)(W + (size_t)(k0 + kk) * N + n0 + 4 * (lane & 7)); sv[i] = sc ? sc[k0 + kk] : 1.f; }
#pragma unroll
    for (int i = 0; i < 8; ++i) { const int kk = 8 * i + (lane >> 3); LAS float* d = scr + kk * 33 + 4 * (lane & 7); d[0] = wv[i][0] * sv[i]; d[1] = wv[i][1] * sv[i]; d[2] = wv[i][2] * sv[i]; d[3] = wv[i][3] * sv[i]; }
    LDS_WAIT(); asm volatile("" ::: "memory");
    const int c = lane & 7;
#pragma unroll
    for (int j = 0; j < 4; ++j) { const int n = (lane >> 3) + 8 * j; const LAS float* s = scr + (8 * c) * 33 + n;
        v4u o; o.x = pk2(s[0 * 33], s[1 * 33]); o.y = pk2(s[2 * 33], s[3 * 33]); o.z = pk2(s[4 * 33], s[5 * 33]); o.w = pk2(s[6 * 33], s[7 * 33]);
        *(v4u*)(WT + (size_t)(row_off + n0 + n) * ld + col_off + k0 + 8 * c) = o; }
    LDS_WAIT(); asm volatile("" ::: "memory");
}
__device__ __forceinline__ void conv_mat(const float* W, int K, int N, bf16* WT, int ld, int row_off, int col_off, const float* sc, LAS float* scr, int gw, int ngw, int lane) {
    const int nitems = (K / 64) * (N / 32);
    for (int it = gw; it < nitems; it += ngw) wt_item(W, K, N, WT, ld, row_off, col_off, sc, scr, it, lane);
}

__device__ __forceinline__ void attn_phase(const bf16* Q, const bf16* K, const bf16* V, bf16* O, int gw, int ngw, int lane) {
    const int fr = lane & 15, fq = lane >> 4;
    for (int unit = gw; unit < (M / 16) * 16; unit += ngw) {
        const int qt = unit & 511, bh = unit >> 9, h = bh & 15, b = bh >> 4;
        const int t0 = qt * 16; const size_t rowb = (size_t)b * SEQ;
        const bf16* qp = Q + (rowb + t0 + fr) * 1024 + h * 64 + fq * 8;
        const bf16x8 qb0 = *(const bf16x8*)(qp), qb1 = *(const bf16x8*)(qp + 32);
        f32x4 o[4];
#pragma unroll
        for (int dt = 0; dt < 4; ++dt) o[dt] = (f32x4){0.f, 0.f, 0.f, 0.f};
        float carry = 1.f;
        const int tq = t0 + fr;
        bf16x8 kn0, kn1; unsigned short vn[4][4];
#define ATT_LOAD(SH) { int sk_ = (SH) - fr; sk_ = sk_ < 0 ? 0 : sk_; const bf16* kp_ = K + (rowb + sk_) * 1024 + h * 64 + fq * 8; kn0 = *(const bf16x8*)(kp_); kn1 = *(const bf16x8*)(kp_ + 32); \
            _Pragma("unroll") for (int j = 0; j < 4; ++j) { int sv_ = (SH) - (4 * fq + j); sv_ = sv_ < 0 ? 0 : sv_; const bf16* vp_ = V + (rowb + sv_) * 1024 + h * 64 + fr; \
                _Pragma("unroll") for (int dt = 0; dt < 4; ++dt) vn[dt][j] = vp_[16 * dt]; } }
        ATT_LOAD(t0 + 14)
        for (int s_hi = t0 + 14; s_hi >= 0; s_hi -= 16) {
            const bf16x8 ka0 = kn0, ka1 = kn1;
            unsigned short vv[4][4];
#pragma unroll
            for (int j = 0; j < 4; ++j)
#pragma unroll
                for (int dt = 0; dt < 4; ++dt) vv[dt][j] = vn[dt][j];
            ATT_LOAD(s_hi - 16)
            f32x4 z = (f32x4){0.f, 0.f, 0.f, 0.f};
            z = __builtin_amdgcn_mfma_f32_16x16x32_bf16(ka0, qb0, z, 0, 0, 0);
            z = __builtin_amdgcn_mfma_f32_16x16x32_bf16(ka1, qb1, z, 0, 0, 0);
            float dd[4], sg[4];
#pragma unroll
            for (int i = 0; i < 4; ++i) {
                const int s = s_hi - (4 * fq + i);
                const bool valid = (s >= 0) && (s < tq);
                const float e = __builtin_amdgcn_exp2f(fminf(z[i], 100.f));
                const float d = __builtin_amdgcn_rcpf(1.0f + e);
                dd[i] = valid ? d : 1.f; sg[i] = valid ? e * d : 0.f;
            }
            const float c1 = dd[0], c2 = c1 * dd[1], c3 = c2 * dd[2], g = c3 * dd[3];
            const float g0 = __shfl(g, fr), g1 = __shfl(g, fr + 16), g2 = __shfl(g, fr + 32), g3 = __shfl(g, fr + 48);
            float pre = carry;
            if (fq > 0) pre *= g0;
            if (fq > 1) pre *= g1;
            if (fq > 2) pre *= g2;
            carry = carry * ((g0 * g1) * (g2 * g3));
            const float p0 = sg[0] * pre, p1 = sg[1] * (pre * c1), p2 = sg[2] * (pre * c2), p3 = sg[3] * (pre * c3);
            bf16x8 pb; { const unsigned w0 = pk2(p0, p1), w1 = pk2(p2, p3); pb[0] = (short)(w0 & 0xffff); pb[1] = (short)(w0 >> 16); pb[2] = (short)(w1 & 0xffff); pb[3] = (short)(w1 >> 16); pb[4] = 0; pb[5] = 0; pb[6] = 0; pb[7] = 0; }
#pragma unroll
            for (int dt = 0; dt < 4; ++dt) {
                bf16x8 va; va[0] = (short)vv[dt][0]; va[1] = (short)vv[dt][1]; va[2] = (short)vv[dt][2]; va[3] = (short)vv[dt][3]; va[4] = 0; va[5] = 0; va[6] = 0; va[7] = 0;
                o[dt] = __builtin_amdgcn_mfma_f32_16x16x32_bf16(va, pb, o[dt], 0, 0, 0);
            }
            if (__builtin_amdgcn_ballot_w64(carry != 0.f) == 0ull) break;
        }
#undef ATT_LOAD
        bf16* op = O + (rowb + t0 + fr) * 1024 + h * 64 + fq * 4;
#pragma unroll
        for (int dt = 0; dt < 4; ++dt) { v2u w; w.x = pk2(o[dt][0], o[dt][1]); w.y = pk2(o[dt][2], o[dt][3]); *(v2u*)(op + 16 * dt) = w; }
    }
}

typedef unsigned u32x4_t __attribute__((ext_vector_type(4)));
__device__ __forceinline__ bf16x8 mk8(unsigned a, unsigned b, unsigned c, unsigned d) { const u32x4_t t = {a, b, c, d}; return __builtin_bit_cast(bf16x8, t); }
__device__ __forceinline__ void hg_prep(bf16* QS, bf16* KF, bf16* KT, float* DB, int gw, int ngw, int lane) {
    for (int it = gw; it < (M / 16) * 4; it += ngw) {
        const int chunk = it >> 2, c = (it & 3) * 256 + 4 * lane;
        const size_t base = (size_t)chunk * 16 * 1024 + c;
        v2u kin[16], qin[16];
#pragma unroll
        for (int t = 0; t < 16; ++t) { kin[t] = *(const v2u*)(KF + base + (size_t)t * 1024); qin[t] = *(const v2u*)(QS + base + (size_t)t * 1024); }
        float b[4] = {0.f, 0.f, 0.f, 0.f};
        unsigned ktp[4][8];
#pragma unroll
        for (int t2 = 0; t2 < 8; ++t2) {
            float kt2[2][4];
#pragma unroll
            for (int u = 0; u < 2; ++u) {
                const int t = 2 * t2 + u;
                const f32x4 kf = bf4(kin[t]), q = bf4(qin[t]);
                float qt[4];
#pragma unroll
                for (int j = 0; j < 4; ++j) {
                    const float fdec = fmaxf(1.0f - kf[j], 1e-4f);
                    b[j] += __builtin_amdgcn_logf(fdec);
                    const float e = __builtin_amdgcn_exp2f(b[j]);
                    qt[j] = q[j] * e; kt2[u][j] = kf[j] * __builtin_amdgcn_rcpf(e);
                }
                v2u qo; qo.x = pk2(qt[0], qt[1]); qo.y = pk2(qt[2], qt[3]); *(v2u*)(QS + base + (size_t)t * 1024) = qo;
                v2u ko; ko.x = pk2(kt2[u][0], kt2[u][1]); ko.y = pk2(kt2[u][2], kt2[u][3]); *(v2u*)(KF + base + (size_t)t * 1024) = ko;
            }
#pragma unroll
            for (int j = 0; j < 4; ++j) ktp[j][t2] = pk2(kt2[0][j], kt2[1][j]);
        }
        f32x4 dv; dv[0] = __builtin_amdgcn_exp2f(b[0]); dv[1] = __builtin_amdgcn_exp2f(b[1]); dv[2] = __builtin_amdgcn_exp2f(b[2]); dv[3] = __builtin_amdgcn_exp2f(b[3]);
        *(f32x4*)(DB + (size_t)chunk * 1024 + c) = dv;
#pragma unroll
        for (int j = 0; j < 4; ++j) { v4u* kp = (v4u*)(KT + ((size_t)chunk * 1024 + c + j) * 16);
            kp[0] = (v4u){ktp[j][0], ktp[j][1], ktp[j][2], ktp[j][3]}; kp[1] = (v4u){ktp[j][4], ktp[j][5], ktp[j][6], ktp[j][7]}; }
    }
}
__device__ __forceinline__ void hg_local(const bf16* KT, const bf16* IV, const float* DB, float* SL, float* DT) {
    int tid_ = threadIdx.x; asm volatile("" : "+v"(tid_)); const int tid = tid_, lane = tid & 63, w = __builtin_amdgcn_readfirstlane(tid >> 6), fr = lane & 15, fq = lane >> 4;
    for (int unit = blockIdx.x; unit < 256; unit += gridDim.x) {
        const int seg = unit & 7, bh = unit >> 3, h = bh & 7, b = bh >> 3;
        if (seg == 7) continue;
        f32x4 S[8], DTt[8];
#pragma unroll
        for (int kt = 0; kt < 8; ++kt) { S[kt] = (f32x4){0.f, 0.f, 0.f, 0.f}; DTt[kt] = (f32x4){1.f, 1.f, 1.f, 1.f}; }
        const size_t m0 = (size_t)b * SEQ + (size_t)seg * 1024;
        v2u kt1[8], kt2[8]; f32x4 d1[8], d2[8]; unsigned short v1_[4], v2_[4];
#define HGL_LOAD(KTV, DV, VV, CJ) { const int cj_ = (CJ) < 64 ? (CJ) : 63; const size_t chunk_ = (m0 >> 4) + cj_, mrow_ = m0 + 16 * cj_; \
          _Pragma("unroll") for (int kt = 0; kt < 8; ++kt) { KTV[kt] = *(const v2u*)(KT + (chunk_ * 1024 + 128 * h + 16 * kt + fr) * 16 + 4 * fq); DV[kt] = *(const f32x4*)(DB + chunk_ * 1024 + 128 * h + 16 * kt + 4 * fq); } \
          const bf16* vp_ = IV + (mrow_ + 4 * fq) * 1024 + 128 * h + 16 * w + fr; VV[0] = vp_[0]; VV[1] = vp_[1024]; VV[2] = vp_[2048]; VV[3] = vp_[3072]; }
        HGL_LOAD(kt1, d1, v1_, 0) HGL_LOAD(kt2, d2, v2_, 1)
        for (int ci = 0; ci < 64; ++ci) {
            v2u ktv[8]; f32x4 dv[8];
#pragma unroll
            for (int kt = 0; kt < 8; ++kt) { ktv[kt] = kt1[kt]; dv[kt] = d1[kt]; kt1[kt] = kt2[kt]; d1[kt] = d2[kt]; }
            const unsigned v0 = v1_[0], v1 = v1_[1], v2 = v1_[2], v3 = v1_[3];
#pragma unroll
            for (int x = 0; x < 4; ++x) v1_[x] = v2_[x];
            HGL_LOAD(kt2, d2, v2_, ci + 2)
            const bf16x8 vb = mk8(v0 | (v1 << 16), v2 | (v3 << 16), 0u, 0u);
#pragma unroll
            for (int kt = 0; kt < 8; ++kt) { S[kt] = __builtin_amdgcn_mfma_f32_16x16x32_bf16(mk8(ktv[kt].x, ktv[kt].y, 0u, 0u), vb, S[kt], 0, 0, 0); S[kt] = S[kt] * dv[kt]; DTt[kt] = DTt[kt] * dv[kt]; }
        }
#undef HGL_LOAD
#pragma unroll
        for (int kt = 0; kt < 8; ++kt) {
#pragma unroll
            for (int i = 0; i < 4; ++i) SL[((size_t)(bh * 8 + seg) * 128 + 16 * kt + 4 * fq + i) * 128 + 16 * w + fr] = S[kt][i];
            if (w == 0 && fr == 0) *(f32x4*)(DT + (size_t)(bh * 8 + seg) * 128 + 16 * kt + 4 * fq) = DTt[kt];
        }
    }
}
__device__ __forceinline__ void hg_out(const bf16* QT, const bf16* KTL, const bf16* KT, const bf16* IV, const float* DB, const float* SL, const float* DT, const float* norm_g, bf16* SGO, LAS unsigned char* lds) {
    int tid_ = threadIdx.x; asm volatile("" : "+v"(tid_)); const int tid = tid_, lane = tid & 63, w = __builtin_amdgcn_readfirstlane(tid >> 6), fr = lane & 15, fq = lane >> 4;
    LAS float* ssb = (LAS float*)lds;
    for (int unit = blockIdx.x; unit < 256; unit += gridDim.x) {
        const int seg = unit & 7, bh = unit >> 3, h = bh & 7, b = bh >> 3;
        f32x4 S[8];
#pragma unroll
        for (int kt = 0; kt < 8; ++kt) S[kt] = (f32x4){0.f, 0.f, 0.f, 0.f};
        for (int j = 0; j < seg; ++j) {
#pragma unroll
            for (int kt = 0; kt < 8; ++kt) {
                const f32x4 dt = *(const f32x4*)(DT + (size_t)(bh * 8 + j) * 128 + 16 * kt + 4 * fq);
#pragma unroll
                for (int i = 0; i < 4; ++i) S[kt][i] = S[kt][i] * dt[i] + SL[((size_t)(bh * 8 + j) * 128 + 16 * kt + 4 * fq + i) * 128 + 16 * w + fr];
            }
        }
        const float ng = norm_g[128 * h + 16 * w + fr];
        const size_t m0 = (size_t)b * SEQ + (size_t)seg * 1024;
        v2u qn[8], kn[8];
        { const bf16* qp = QT + (m0 + fr) * 1024 + 128 * h + 4 * fq; const bf16* kp = KTL + (m0 + fr) * 1024 + 128 * h + 4 * fq;
#pragma unroll
          for (int x = 0; x < 8; ++x) { qn[x] = *(const v2u*)(qp + 16 * x); kn[x] = *(const v2u*)(kp + 16 * x); } }
        unsigned short vn[4], gn[4];
        { const bf16* vp = IV + (m0 + 4 * fq) * 1024 + 128 * h + 16 * w + fr; const bf16* gq = SGO + (m0 + 4 * fq) * 1024 + 128 * h + 16 * w + fr;
          vn[0] = vp[0]; vn[1] = vp[1024]; vn[2] = vp[2048]; vn[3] = vp[3072]; gn[0] = gq[0]; gn[1] = gq[1024]; gn[2] = gq[2048]; gn[3] = gq[3072]; }
        for (int ci = 0; ci < 64; ++ci) {
            const size_t chunk = (m0 >> 4) + ci, mrow = m0 + 16 * ci;
            v2u ktv[8]; f32x4 dv[8];
#pragma unroll
            for (int kt = 0; kt < 8; ++kt) { ktv[kt] = *(const v2u*)(KT + (chunk * 1024 + 128 * h + 16 * kt + fr) * 16 + 4 * fq); dv[kt] = *(const f32x4*)(DB + chunk * 1024 + 128 * h + 16 * kt + 4 * fq); }
            const unsigned v0 = vn[0], v1 = vn[1], v2 = vn[2], v3 = vn[3];
            bf16* gp = SGO + (mrow + 4 * fq) * 1024 + 128 * h + 16 * w + fr;
            const float sg0 = bf1(gn[0]), sg1 = bf1(gn[1]), sg2 = bf1(gn[2]), sg3 = bf1(gn[3]);
            { const size_t mn = m0 + 16 * (ci + 1 < 64 ? ci + 1 : ci); const bf16* vp = IV + (mn + 4 * fq) * 1024 + 128 * h + 16 * w + fr; const bf16* gq = SGO + (mn + 4 * fq) * 1024 + 128 * h + 16 * w + fr;
              if (ci + 1 < 64) { vn[0] = vp[0]; vn[1] = vp[1024]; vn[2] = vp[2048]; vn[3] = vp[3072]; gn[0] = gq[0]; gn[1] = gq[1024]; gn[2] = gq[2048]; gn[3] = gq[3072]; } }
            v2u qc[8], kc[8];
#pragma unroll
            for (int x = 0; x < 8; ++x) { qc[x] = qn[x]; kc[x] = kn[x]; }
            { const size_t mn = m0 + 16 * (ci + 1 < 64 ? ci + 1 : ci); const bf16* qp = QT + (mn + fr) * 1024 + 128 * h + 4 * fq; const bf16* kp = KTL + (mn + fr) * 1024 + 128 * h + 4 * fq;
#pragma unroll
              for (int x = 0; x < 8; ++x) { qn[x] = *(const v2u*)(qp + 16 * x); kn[x] = *(const v2u*)(kp + 16 * x); } }
            const bf16x8 vb = mk8(v0 | (v1 << 16), v2 | (v3 << 16), 0u, 0u);
            f32x4 pt = (f32x4){0.f, 0.f, 0.f, 0.f};
#pragma unroll
            for (int p = 0; p < 4; ++p) pt = __builtin_amdgcn_mfma_f32_16x16x32_bf16(mk8(kc[2 * p].x, kc[2 * p].y, kc[2 * p + 1].x, kc[2 * p + 1].y), mk8(qc[2 * p].x, qc[2 * p].y, qc[2 * p + 1].x, qc[2 * p + 1].y), pt, 0, 0, 0);
#pragma unroll
            for (int i = 0; i < 4; ++i) if (4 * fq + i > fr) pt[i] = 0.f;
            f32x4 o = (f32x4){0.f, 0.f, 0.f, 0.f};
#pragma unroll
            for (int p = 0; p < 4; ++p) {
                const bf16x8 sb = mk8(pk2(S[2 * p][0], S[2 * p][1]), pk2(S[2 * p][2], S[2 * p][3]), pk2(S[2 * p + 1][0], S[2 * p + 1][1]), pk2(S[2 * p + 1][2], S[2 * p + 1][3]));
                o = __builtin_amdgcn_mfma_f32_16x16x32_bf16(mk8(qc[2 * p].x, qc[2 * p].y, qc[2 * p + 1].x, qc[2 * p + 1].y), sb, o, 0, 0, 0);
            }
            o = __builtin_amdgcn_mfma_f32_16x16x32_bf16(mk8(pk2(pt[0], pt[1]), pk2(pt[2], pt[3]), 0u, 0u), vb, o, 0, 0, 0);
#pragma unroll
            for (int kt = 0; kt < 8; ++kt) { S[kt] = __builtin_amdgcn_mfma_f32_16x16x32_bf16(mk8(ktv[kt].x, ktv[kt].y, 0u, 0u), vb, S[kt], 0, 0, 0); S[kt] = S[kt] * dv[kt]; }
            LAS float* sb_ = ssb + (ci & 1) * 128;
#pragma unroll
            for (int i = 0; i < 4; ++i) { const float ss = row16_sum(o[i] * o[i]); if (fr == 0) sb_[(4 * fq + i) * 8 + w] = ss; }
            __syncthreads();
            const float sgv[4] = {sg0, sg1, sg2, sg3};
#pragma unroll
            for (int i = 0; i < 4; ++i) {
                const f32x4 a0 = *(const LAS f32x4*)(sb_ + (4 * fq + i) * 8), a1 = *(const LAS f32x4*)(sb_ + (4 * fq + i) * 8 + 4);
                const float tot = ((a0[0] + a0[1]) + (a0[2] + a0[3])) + ((a1[0] + a1[1]) + (a1[2] + a1[3]));
                const float r = 1.0f / sqrtf(tot * (1.0f / 128.0f) + 1e-6f);
                gp[(size_t)i * 1024] = (bf16)f2bf(o[i] * r * ng * sgv[i]);
            }
        }
        __syncthreads();
    }
}

__device__ __forceinline__ void rw_prep(const float* h, const float* rs, const float* g, bf16* A2, int gw, int ngw, int lane) {
    for (int it = gw; it < M / 2; it += ngw) {
        const int m = 2 * it, t = m & (SEQ - 1);
        const int mp = t ? m - 1 : m;
        f32x4 x[3][4], pr[3];
#pragma unroll
        for (int u = 0; u < 3; ++u) { const int mm = u == 0 ? mp : m + u - 1; pr[u] = *(const f32x4*)(rs + (size_t)mm * 16 + 4 * (lane & 3));
#pragma unroll
            for (int j = 0; j < 4; ++j) x[u][j] = *(const f32x4*)(h + (size_t)mm * 1024 + 4 * lane + 256 * j); }
        float r3[3];
#pragma unroll
        for (int u = 0; u < 3; ++u) { float s = (pr[u][0] + pr[u][1]) + (pr[u][2] + pr[u][3]); s += dpp_f<0xB1>(s); s += dpp_f<0x4E>(s); r3[u] = 1.0f / sqrtf(s * (1.0f / 1024.0f) + 1e-6f); }
        if (t == 0) r3[0] = 0.f;
#pragma unroll
        for (int j = 0; j < 4; ++j) {
            const int c = 4 * lane + 256 * j;
            const f32x4 gc = *(const f32x4*)(g + c);
            const f32x4 xp = x[0][j] * gc * r3[0], x0 = x[1][j] * gc * r3[1], x1 = x[2][j] * gc * r3[2];
            const f32x4 d0 = xp - x0, d1 = x0 - x1;
            v2u o;
            o.x = pk2(x0[0], x0[1]); o.y = pk2(x0[2], x0[3]); *(v2u*)(A2 + (size_t)m * 2048 + c) = o;
            o.x = pk2(d0[0], d0[1]); o.y = pk2(d0[2], d0[3]); *(v2u*)(A2 + (size_t)m * 2048 + 1024 + c) = o;
            o.x = pk2(x1[0], x1[1]); o.y = pk2(x1[2], x1[3]); *(v2u*)(A2 + (size_t)(m + 1) * 2048 + c) = o;
            o.x = pk2(d1[0], d1[1]); o.y = pk2(d1[2], d1[3]); *(v2u*)(A2 + (size_t)(m + 1) * 2048 + 1024 + c) = o;
        }
    }
}
constexpr int RWS_AH = 0, RWS_RB = 2048, RWS_KGT = 4096, RWS_BGT = 6144, RWS_G15 = 8192, RWS_KNI = 8448, RWS_WVI = 9472, RWS_VCI = 10496, RWS_SLOT = 11264;
constexpr int RWT_AB = 0, RWT_BT = 2048, RWT_KT = 4096, RWT_ABT = 6144, RWT_NM = 0  , RWT_TM = 2048  , RWT_BYTES = 8192;
constexpr int RW_NSLOT = 9, RW_NPROD = 7, RW_RING = RW_NSLOT * RWS_SLOT, RW_FLAGS = RW_RING + RW_NPROD * RWT_BYTES;
struct RwRaw4 { v2u r[4], k[4], wm[4], a[4]; unsigned short v[4]; };
__device__ __forceinline__ void rw_load4(RwRaw4& x, const bf16* R, const bf16* K, const bf16* V, const bf16* WM, const bf16* A, size_t m, int ch, int vch) {
#pragma unroll
    for (int j = 0; j < 4; ++j) { const size_t off = (m + j) * 1024 + ch;
        x.r[j] = *(const v2u*)(R + off); x.k[j] = *(const v2u*)(K + off); x.wm[j] = *(const v2u*)(WM + off); x.a[j] = *(const v2u*)(A + off); x.v[j] = V[(m + j) * 1024 + vch]; }
}
__device__ __forceinline__ bf16x8 lds_op16(const LAS unsigned char* mtx, int row, int kbyte) { return *(const LAS bf16x8*)(mtx + row * 128 + kbyte); }
__device__ __forceinline__ v2u lds_8(const LAS unsigned char* p) { return *(const LAS v2u*)p; }
__device__ __forceinline__ void rw_scan(const bf16* R, const bf16* K, const bf16* V, const bf16* WM, const bf16* A, const float* k_k, const float* k_a, bf16* Y, LAS unsigned char* lds) {
    int tid_ = threadIdx.x; asm volatile("" : "+v"(tid_)); const int tid = tid_, lane = tid & 63, w = __builtin_amdgcn_readfirstlane(tid >> 6);
    const int fr = lane & 15, fq = lane >> 4;
    constexpr int NCH = SEQ / 16;
    for (int unit = blockIdx.x; unit < 256; unit += gridDim.x) {
        const int rg = unit & 3, h = (unit >> 2) & 15, b = unit >> 6;
        const size_t row0 = (size_t)b * SEQ;
        volatile LAS unsigned* flg = (volatile LAS unsigned*)(lds + RW_FLAGS);
        if (tid < 16) flg[tid] = 0u;
        __syncthreads();
        if (w >= 1) {
            const int pw = w - 1, ch = 64 * h + 4 * fr, vch = 64 * h + 16 * rg + fr;
            LAS unsigned char* tmp = lds + RW_RING + pw * RWT_BYTES;
            const f32x4 kkc = *(const f32x4*)(k_k + ch), kac = *(const f32x4*)(k_a + ch);
            RwRaw4 nx; rw_load4(nx, R, K, V, WM, A, row0 + 16 * pw + 4 * fq, ch, vch);
            for (int cj = pw; cj < NCH; cj += RW_NPROD) {
                {
                    const RwRaw4 cu = nx;
                    { const int cn = cj + RW_NPROD < NCH ? cj + RW_NPROD : cj; rw_load4(nx, R, K, V, WM, A, row0 + 16 * (size_t)cn + 4 * fq, ch, vch); }
                    while ((int)flg[RW_NSLOT] < cj - (RW_NSLOT - 1)) __builtin_amdgcn_s_sleep(2);
                    asm volatile("" ::: "memory");
                    LAS unsigned char* slot = lds + (cj % RW_NSLOT) * RWS_SLOT;
                    f32x4 wv[4], kk[4], km[4], be[4], rr[4];
#pragma unroll
                    for (int j = 0; j < 4; ++j) {
                        const f32x4 r = bf4(cu.r[j]), k = bf4(cu.k[j]), wm = bf4(cu.wm[j]), a = bf4(cu.a[j]);
                        const f32x4 kr = k * kkc;
                        const float n2 = row16_sum((kr[0] * kr[0] + kr[1] * kr[1]) + (kr[2] * kr[2] + kr[3] * kr[3]));
                        const float inv = 1.0f / fmaxf(sqrtf(n2), 1e-12f);
                        kk[j] = kr * inv; be[j] = kk[j] * a; km[j] = k * (1.0f + (a - 1.0f) * kac); wv[j] = 1.0f - wm; rr[j] = r;
                    }
                    f32x4 g[4]; g[0] = wv[0]; g[1] = g[0] * wv[1]; g[2] = g[1] * wv[2]; g[3] = g[2] * wv[3];
                    f32x4 pre = (f32x4){1.f, 1.f, 1.f, 1.f}, all = (f32x4){1.f, 1.f, 1.f, 1.f};
#pragma unroll
                    for (int x = 0; x < 4; ++x) {
                        const float t0 = __shfl(g[3][x], fr), t1 = __shfl(g[3][x], 16 + fr), t2 = __shfl(g[3][x], 32 + fr), t3 = __shfl(g[3][x], 48 + fr);
                        float p = 1.f; if (fq > 0) p *= t0; if (fq > 1) p *= t1; if (fq > 2) p *= t2;
                        pre[x] = p; all[x] = (t0 * t1) * (t2 * t3);
                    }
                    unsigned kgp[4][2], bgp[4][2], abp[4][2];
                    float kgt[4][4], bgt[4][4], abt[4][4];
#pragma unroll
                    for (int j = 0; j < 4; ++j) {
                        const f32x4 Gs = pre * g[j], Gm = j ? pre * g[j - 1] : pre;
                        f32x4 ginv; ginv[0] = __builtin_amdgcn_rcpf(Gs[0]); ginv[1] = __builtin_amdgcn_rcpf(Gs[1]); ginv[2] = __builtin_amdgcn_rcpf(Gs[2]); ginv[3] = __builtin_amdgcn_rcpf(Gs[3]);
                        const f32x4 alb = kk[j] * Gm, rb = rr[j] * Gs, bet = be[j] * ginv, ktl = km[j] * ginv;
                        const int s = 4 * fq + j;
                        v2u o;
                        o.x = pk2(alb[0], alb[1]); o.y = pk2(alb[2], alb[3]); *(LAS v2u*)(tmp + RWT_AB + s * 128 + 8 * fr) = o;
                        o.x = pk2(bet[0], bet[1]); o.y = pk2(bet[2], bet[3]); *(LAS v2u*)(tmp + RWT_BT + s * 128 + 8 * fr) = o;
                        o.x = pk2(ktl[0], ktl[1]); o.y = pk2(ktl[2], ktl[3]); *(LAS v2u*)(tmp + RWT_KT + s * 128 + 8 * fr) = o;
                        o.x = pk2(rb[0], rb[1]); o.y = pk2(rb[2], rb[3]); *(LAS v2u*)(slot + RWS_RB + s * 128 + 8 * fr) = o;
#pragma unroll
                        for (int x = 0; x < 4; ++x) { kgt[x][j] = ktl[x] * all[x]; bgt[x][j] = -(bet[x] * all[x]); abt[x][j] = alb[x]; }
                    }
#pragma unroll
                    for (int x = 0; x < 4; ++x) {
                        const int kch = 4 * fr + x;
                        v2u o;
                        o.x = pk2(kgt[x][0], kgt[x][1]); o.y = pk2(kgt[x][2], kgt[x][3]); *(LAS v2u*)(slot + RWS_KGT + kch * 32 + 8 * fq) = o;
                        o.x = pk2(bgt[x][0], bgt[x][1]); o.y = pk2(bgt[x][2], bgt[x][3]); *(LAS v2u*)(slot + RWS_BGT + kch * 32 + 8 * fq) = o;
                        o.x = pk2(abt[x][0], abt[x][1]); o.y = pk2(abt[x][2], abt[x][3]); *(LAS v2u*)(tmp + RWT_ABT + kch * 32 + 8 * fq) = o;
                    }
                    if (fq == 0) *(LAS f32x4*)(slot + RWS_G15 + 16 * fr) = all;
                    const unsigned vlo = (unsigned)cu.v[0] | ((unsigned)cu.v[1] << 16), vhi = (unsigned)cu.v[2] | ((unsigned)cu.v[3] << 16);
                    { v2u o; o.x = vlo; o.y = vhi; *(LAS v2u*)(slot + RWS_VCI + 8 * lane) = o; }
                    LDS_WAIT(); asm volatile("" ::: "memory");
                    f32x4 nac = (f32x4){0.f, 0.f, 0.f, 0.f}, kat = nac, krt = nac, nrt = nac;
#pragma unroll
                    for (int p = 0; p < 2; ++p) {
                        const int kb = (32 * p + 8 * fq) * 2;
                        const bf16x8 oAB = lds_op16(tmp + RWT_AB, fr, kb), oBT = lds_op16(tmp + RWT_BT, fr, kb), oKT = lds_op16(tmp + RWT_KT, fr, kb), oRB = lds_op16(slot + RWS_RB, fr, kb);
                        nac = __builtin_amdgcn_mfma_f32_16x16x32_bf16(oBT, oAB, nac, 0, 0, 0);
                        kat = __builtin_amdgcn_mfma_f32_16x16x32_bf16(oKT, oAB, kat, 0, 0, 0);
                        krt = __builtin_amdgcn_mfma_f32_16x16x32_bf16(oKT, oRB, krt, 0, 0, 0);
                        nrt = __builtin_amdgcn_mfma_f32_16x16x32_bf16(oBT, oRB, nrt, 0, 0, 0);
                    }
#pragma unroll
                    for (int i = 0; i < 4; ++i) { const int rr_ = 4 * fq + i;
                        if (rr_ >= fr) { nac[i] = 0.f; kat[i] = 0.f; }
                        if (rr_ > fr) { krt[i] = 0.f; nrt[i] = 0.f; } }
                    { u32x4_t o; o.x = pk2(krt[0], krt[1]); o.y = pk2(krt[2], krt[3]); o.z = pk2(-nrt[0], -nrt[1]); o.w = pk2(-nrt[2], -nrt[3]); *(LAS u32x4_t*)(slot + RWS_KNI + 16 * lane) = o; }
                    LDS_WAIT(); asm volatile("" ::: "memory");
                    *(LAS f32x4*)(tmp + RWT_NM + (fr * 16 + 4 * fq) * 4) = nac;
                    LDS_WAIT(); asm volatile("" ::: "memory");
                    float Tc[16];
                    f32x4 nvv[16][4];
#define RW_LD_ROWS(lo, hi) _Pragma("unroll") for (int s = lo; s <= hi; ++s) _Pragma("unroll") for (int r4 = 0; r4 < (s + 3) / 4; ++r4) nvv[s][r4] = *(const LAS f32x4*)(tmp + RWT_NM + (s * 16 + 4 * r4) * 4);
#define RW_DO_ROWS(lo, hi) _Pragma("unroll") for (int s = lo; s <= hi; ++s) { float acc_ = (s == fr) ? 1.f : 0.f; \
                        _Pragma("unroll") for (int r4 = 0; r4 < (s + 3) / 4; ++r4) _Pragma("unroll") for (int e = 0; e < 4; ++e) if (4 * r4 + e < s) acc_ -= nvv[s][r4][e] * Tc[4 * r4 + e]; \
                        Tc[s] = acc_; }
                    RW_LD_ROWS(1, 8) RW_LD_ROWS(9, 12)
                    asm volatile("" ::: "memory");
                    RW_DO_ROWS(0, 8)
                    RW_LD_ROWS(13, 15)
                    asm volatile("" ::: "memory");
                    RW_DO_ROWS(9, 12)
                    RW_DO_ROWS(13, 15)
#undef RW_LD_ROWS
#undef RW_DO_ROWS
#pragma unroll
                    for (int e = 0; e < 4; ++e) {
                        float tv = Tc[0];
#pragma unroll
                        for (int s = 0; s < 16; ++s) if (s == 4 * fq + e) tv = Tc[s];
                        *(LAS unsigned short*)(tmp + RWT_TM + ((4 * fq + e) * 16 + fr) * 2) = (unsigned short)f2bf(tv);
                    }
                    LDS_WAIT(); asm volatile("" ::: "memory");
                    const v2u tq = lds_8(tmp + RWT_TM + (fr * 16 + 4 * fq) * 2);
                    const bf16x8 opT = mk8(tq.x, tq.y, 0u, 0u);
                    f32x4 xac = __builtin_amdgcn_mfma_f32_16x16x32_bf16(mk8(pk2(kat[0], kat[1]), pk2(kat[2], kat[3]), 0u, 0u), mk8(vlo, vhi, 0u, 0u), (f32x4){0.f, 0.f, 0.f, 0.f}, 0, 0, 0);
                    const f32x4 wvv = __builtin_amdgcn_mfma_f32_16x16x32_bf16(opT, mk8(pk2(xac[0], xac[1]), pk2(xac[2], xac[3]), 0u, 0u), (f32x4){0.f, 0.f, 0.f, 0.f}, 0, 0, 0);
                    *(LAS f32x4*)(slot + RWS_WVI + 16 * lane) = wvv;
                    f32x4 aht[4];
#pragma unroll
                    for (int nt = 0; nt < 4; ++nt) {
                        const v2u ab = lds_8(tmp + RWT_ABT + (16 * nt + fr) * 32 + 8 * fq);
                        aht[nt] = __builtin_amdgcn_mfma_f32_16x16x32_bf16(mk8(ab.x, ab.y, 0u, 0u), opT, (f32x4){0.f, 0.f, 0.f, 0.f}, 0, 0, 0);
                    }
#pragma unroll
                    for (int p = 0; p < 2; ++p) { u32x4_t o; o.x = pk2(aht[2 * p][0], aht[2 * p][1]); o.y = pk2(aht[2 * p][2], aht[2 * p][3]); o.z = pk2(aht[2 * p + 1][0], aht[2 * p + 1][1]); o.w = pk2(aht[2 * p + 1][2], aht[2 * p + 1][3]);
                        *(LAS u32x4_t*)(slot + RWS_AH + (p * 64 + lane) * 16) = o; }
                    LDS_WAIT(); asm volatile("" ::: "memory");
                    if (lane == 0) flg[cj % RW_NSLOT] = (unsigned)(cj + 1);
                }
            }
        } else {
            f32x4 St[4];
#pragma unroll
            for (int kt = 0; kt < 4; ++kt) St[kt] = (f32x4){0.f, 0.f, 0.f, 0.f};
            {
#pragma unroll 1
                for (int c = 0; c < NCH; ++c) {
                    const LAS unsigned char* slot = lds + (c % RW_NSLOT) * RWS_SLOT;
                    while (flg[c % RW_NSLOT] != (unsigned)(c + 1)) __builtin_amdgcn_s_sleep(1);
                    asm volatile("" ::: "memory");
                    f32x4 zt = *(const LAS f32x4*)(slot + RWS_WVI + 16 * lane);
                    f32x4 y = (f32x4){0.f, 0.f, 0.f, 0.f};
#pragma unroll
                    for (int p = 0; p < 2; ++p) {
                        const bf16x8 sb = mk8(pk2(St[2 * p][0], St[2 * p][1]), pk2(St[2 * p][2], St[2 * p][3]), pk2(St[2 * p + 1][0], St[2 * p + 1][1]), pk2(St[2 * p + 1][2], St[2 * p + 1][3]));
                        const v2u r0 = lds_8(slot + RWS_RB + fr * 128 + (32 * p + 4 * fq) * 2), r1 = lds_8(slot + RWS_RB + fr * 128 + (32 * p + 16 + 4 * fq) * 2);
                        zt = __builtin_amdgcn_mfma_f32_16x16x32_bf16(*(const LAS bf16x8*)(slot + RWS_AH + (p * 64 + lane) * 16), sb, zt, 0, 0, 0);
                        y = __builtin_amdgcn_mfma_f32_16x16x32_bf16(mk8(r0.x, r0.y, r1.x, r1.y), sb, y, 0, 0, 0);
                    }
                    const v2u vc = lds_8(slot + RWS_VCI + 8 * lane);
                    const bf16x8 b2 = mk8(vc.x, vc.y, pk2(zt[0], zt[1]), pk2(zt[2], zt[3]));
                    y = __builtin_amdgcn_mfma_f32_16x16x32_bf16(*(const LAS bf16x8*)(slot + RWS_KNI + 16 * lane), b2, y, 0, 0, 0);
#pragma unroll
                    for (int kt = 0; kt < 4; ++kt) {
                        const v2u kg = lds_8(slot + RWS_KGT + (16 * kt + fr) * 32 + 8 * fq), bg = lds_8(slot + RWS_BGT + (16 * kt + fr) * 32 + 8 * fq);
                        const f32x4 g15 = *(const LAS f32x4*)(slot + RWS_G15 + (16 * kt + 4 * fq) * 4);
                        St[kt] = __builtin_amdgcn_mfma_f32_16x16x32_bf16(mk8(kg.x, kg.y, bg.x, bg.y), b2, St[kt] * g15, 0, 0, 0);
                    }
                    bf16* yp = Y + (row0 + 16 * (size_t)c + 4 * fq) * 1024 + 64 * h + 16 * rg + fr;
#pragma unroll
                    for (int i = 0; i < 4; ++i) yp[(size_t)i * 1024] = (bf16)f2bf(y[i]);
                    LDS_WAIT(); asm volatile("" ::: "memory");
                    if (lane == 0) flg[RW_NSLOT] = (unsigned)(c + 1);
                }
            }
        }
        __syncthreads();
    }
}
__device__ __forceinline__ void rw_post(const bf16* Y, bf16* R, const bf16* K, const bf16* V, const bf16* A, const bf16* G, const float* k_a, const float* r_k, const float* ln_g, const float* ln_b, int gw, int ngw, int lane) {
    const int c = (gw & 3) * 256 + 4 * lane;
    const f32x4 ka = *(const f32x4*)(k_a + c), rk = *(const f32x4*)(r_k + c), lg = *(const f32x4*)(ln_g + c), lb = *(const f32x4*)(ln_b + c);
    for (int it = gw; it < M * 4; it += 2 * ngw) {
        const int it2 = (it + ngw < M * 4) ? it + ngw : it;
        const size_t off[2] = {(size_t)(it >> 2) * 1024 + c, (size_t)(it2 >> 2) * 1024 + c};
        v2u yv[2], rv[2], kv[2], vv[2], av[2], gv[2];
#pragma unroll
        for (int u = 0; u < 2; ++u) { yv[u] = *(const v2u*)(Y + off[u]); rv[u] = *(const v2u*)(R + off[u]); kv[u] = *(const v2u*)(K + off[u]); vv[u] = *(const v2u*)(V + off[u]); av[u] = *(const v2u*)(A + off[u]); gv[u] = *(const v2u*)(G + off[u]); }
#pragma unroll
        for (int u = 0; u < 2; ++u) {
            const f32x4 y = bf4(yv[u]), r = bf4(rv[u]), k = bf4(kv[u]), v = bf4(vv[u]), a = bf4(av[u]), g = bf4(gv[u]);
            const float mu = row16_sum((y[0] + y[1]) + (y[2] + y[3])) * (1.0f / 64.0f);
            const f32x4 yc = y - mu;
            const float var = row16_sum((yc[0] * yc[0] + yc[1] * yc[1]) + (yc[2] * yc[2] + yc[3] * yc[3])) * (1.0f / 64.0f);
            const float rstd = 1.0f / sqrtf(var + 64e-5f);
            const f32x4 km = k * (1.0f + (a - 1.0f) * ka);
            const f32x4 pr = r * km * rk;
            const float cs = row16_sum((pr[0] + pr[1]) + (pr[2] + pr[3]));
            const f32x4 o = (yc * rstd * lg + lb + v * cs) * g;
            v2u wv; wv.x = pk2(o[0], o[1]); wv.y = pk2(o[2], o[3]);
            if (u == 0 || it2 != it) *(v2u*)(R + off[u]) = wv;
        }
    }
}

__device__ __forceinline__ void sc_conv(const bf16* BG, const bf16* CG, const bf16* HX, const float* cw, const float* cb, bf16* O3, int gt, int ngt) {
    const int c = (gt & 127) * 8;
    float w0[8], w1[8], w2[8], bb[8];
#pragma unroll
    for (int j = 0; j < 8; ++j) { w0[j] = cw[c + j]; w1[j] = cw[1024 + c + j]; w2[j] = cw[2048 + c + j]; bb[j] = cb[c + j]; }
    for (int idx = gt; idx < M * 128; idx += 2 * ngt) {
        const int idx2 = idx + ngt < M * 128 ? idx + ngt : idx;
        v4u cv[2][3], hv[2][3], bv[2]; int tt[2]; size_t offs[2];
#pragma unroll
        for (int u = 0; u < 2; ++u) {
            const int m = (u ? idx2 : idx) >> 7; tt[u] = m & (SEQ - 1); offs[u] = (size_t)m * 1024 + c;
#pragma unroll
            for (int dt = 0; dt < 3; ++dt) { const size_t o2 = offs[u] - (size_t)((tt[u] - 2 + dt >= 0) ? (2 - dt) : 0) * 1024; cv[u][dt] = *(const v4u*)(CG + o2); hv[u][dt] = *(const v4u*)(HX + o2); }
            bv[u] = *(const v4u*)(BG + offs[u]);
        }
#pragma unroll
        for (int u = 0; u < 2; ++u) {
            float y[8];
#pragma unroll
            for (int j = 0; j < 8; ++j) y[j] = bb[j];
#pragma unroll
            for (int dt = 0; dt < 3; ++dt) {
                const float on = (tt[u] - 2 + dt >= 0) ? 1.f : 0.f;
                const float* wp = dt == 0 ? w0 : (dt == 1 ? w1 : w2);
                const v4u cq = cv[u][dt], hq = hv[u][dt];
                y[0] += on * wp[0] * (bflo(cq.x) * bflo(hq.x)); y[1] += on * wp[1] * (bfhi(cq.x) * bfhi(hq.x));
                y[2] += on * wp[2] * (bflo(cq.y) * bflo(hq.y)); y[3] += on * wp[3] * (bfhi(cq.y) * bfhi(hq.y));
                y[4] += on * wp[4] * (bflo(cq.z) * bflo(hq.z)); y[5] += on * wp[5] * (bfhi(cq.z) * bfhi(hq.z));
                y[6] += on * wp[6] * (bflo(cq.w) * bflo(hq.w)); y[7] += on * wp[7] * (bfhi(cq.w) * bfhi(hq.w));
            }
            const v4u bq = bv[u];
            v4u w; w.x = pk2(y[0] * bflo(bq.x), y[1] * bfhi(bq.x)); w.y = pk2(y[2] * bflo(bq.y), y[3] * bfhi(bq.y)); w.z = pk2(y[4] * bflo(bq.z), y[5] * bfhi(bq.z)); w.w = pk2(y[6] * bflo(bq.w), y[7] * bfhi(bq.w));
            if (u == 0 || idx2 != idx) *(v4u*)(O3 + offs[u]) = w;
        }
    }
}

#define XB_TMO      128
#define XB_XCNT(j)  (256  + 64 * (j))
#define XB_XSUB(j)  (1280 + 64 * (j))
#define XB_XGEN(j)  (2304 + 64 * (j))
#define XB_TOP      3328
#define XB_TOPGEN   3392
#define XCD_BAR_WORDS 3456
#define XB_SPIN_CAP (1u << 18)

__device__ __forceinline__ unsigned xb_ld(unsigned* p)              { return __hip_atomic_load(p, __ATOMIC_RELAXED, __HIP_MEMORY_SCOPE_AGENT); }
__device__ __forceinline__ unsigned xb_add(unsigned* p, unsigned v) { return __hip_atomic_fetch_add(p, v, __ATOMIC_RELAXED, __HIP_MEMORY_SCOPE_AGENT); }
__device__ __forceinline__ unsigned xb_xcc_id() { return (unsigned)__builtin_amdgcn_s_getreg((3 << 11) | 20) & 0xFu; }
#define XB_SPIN(cond, bar) do { unsigned _sp = 0; while (cond) { __builtin_amdgcn_s_sleep(1); \
    if ((++_sp & 255u) == 0u) { if (xb_ld(&(bar)[XB_TMO])) break; if (_sp > XB_SPIN_CAP) { atomicAdd(&(bar)[XB_TMO], 1u); break; } } } } while (0)

struct XcdBarrier {
    unsigned* bar; unsigned x;
    volatile LAS unsigned* st;
};

__device__ __forceinline__ XcdBarrier xcd_barrier_post(unsigned* bar, volatile LAS unsigned* st) {
    XcdBarrier b; b.bar = bar; b.x = xb_xcc_id(); b.st = st;
    if (threadIdx.x == 0) { const unsigned rk_ = xb_add(&bar[XB_XCNT(b.x)], 1u); st[2] = rk_; st[3] = b.x; }
    return b;
}
__device__ __forceinline__ void xcd_barrier_complete(unsigned* bar, unsigned x, unsigned& nloc, unsigned& nx) {
    const unsigned G = gridDim.x * gridDim.y * gridDim.z;
    unsigned sum, cnt, mine, sp = 0u;
    for (;;) {
        sum = 0u; cnt = 0u; mine = 0u;
#pragma unroll
        for (unsigned j = 0; j < 16; ++j) { const unsigned c = xb_ld(&bar[XB_XCNT(j)]); sum += c; cnt += (c > 0u) ? 1u : 0u; mine = (j == x) ? c : mine; }
        if (sum == G) break;
        __builtin_amdgcn_s_sleep(1);
        if ((++sp & 255u) == 0u) { if (xb_ld(&bar[XB_TMO])) break; if (sp > XB_SPIN_CAP) { atomicAdd(&bar[XB_TMO], 1u); break; } }
    }
    nloc = mine > 0u ? mine : 1u; nx = cnt > 0u ? cnt : 1u;
}

__device__ __forceinline__ void xcd_barrier(const XcdBarrier& b) {
    asm volatile("s_waitcnt vmcnt(0)" ::: "memory");
    __syncthreads();
    if (threadIdx.x == 0) {
        unsigned* bar = b.bar;
        __builtin_amdgcn_s_waitcnt(0);
        unsigned nloc = b.st[0], nx = b.st[1];
        if (nloc == 0u) { xcd_barrier_complete(bar, b.x, nloc, nx); b.st[0] = nloc; b.st[1] = nx; }
        const unsigned old = xb_add(&bar[XB_XSUB(b.x)], 1u);
        const unsigned gen = old / nloc;
        if (old + 1u == (gen + 1u) * nloc) {
            __builtin_amdgcn_fence(__ATOMIC_RELEASE, "agent");
            asm volatile("s_waitcnt vmcnt(0)" ::: "memory");
            const unsigned og = xb_add(&bar[XB_TOP], 1u);
            const unsigned tg = og / nx;
            if (og + 1u == (tg + 1u) * nx) xb_add(&bar[XB_TOPGEN], 1u);
            else XB_SPIN(xb_ld(&bar[XB_TOPGEN]) == tg, bar);
            __builtin_amdgcn_fence(__ATOMIC_ACQUIRE, "agent");
            xb_add(&bar[XB_XGEN(b.x)], 1u);
            asm volatile("s_waitcnt vmcnt(0)" ::: "memory");
        } else {
            XB_SPIN(xb_ld(&bar[XB_XGEN(b.x)]) == gen, bar);
            __builtin_amdgcn_fence(__ATOMIC_ACQUIRE, "agent");
            asm volatile("s_waitcnt vmcnt(0)" ::: "memory");
        }
    }
    __syncthreads();
}

struct Args { const float* in[32]; float* out; unsigned char* ws; };
#define PHASE_VARS \
    unsigned char* ws = a.ws; float* out = a.out; asm volatile("" : "+s"(ws), "+s"(out)); \
    int tid = threadIdx.x; asm volatile("" : "+v"(tid)); \
    const int lane = tid & 63, wave = __builtin_amdgcn_readfirstlane(tid >> 6); \
    const int vc = __builtin_amdgcn_readfirstlane((int)((volatile LAS unsigned*)(lds + LDS_BYTES - 64))[4]); (void)vc; \
    const int G = gridDim.x, gw = blockIdx.x * NWAVES + wave, ngw = G * NWAVES, gt = blockIdx.x * NTHR + tid, ngt = G * NTHR; \
    float* RS = (float*)(ws + WS_RS); float* LBK = (float*)(ws + WS_LBK); \
    bf16* WA = (bf16*)(ws + WS_WA); bf16* WB = (bf16*)(ws + WS_WB); bf16* WO = (bf16*)(ws + WS_WO); bf16* WUP = (bf16*)(ws + WS_WUP); bf16* WDN = (bf16*)(ws + WS_WDN); \
    bf16* HB = (bf16*)(ws + WS_HB); \
    bf16* B0 = (bf16*)(ws + WS_BIG); bf16* B1 = (bf16*)(ws + WS_BIG + SLOT); bf16* B2 = (bf16*)(ws + WS_BIG + 2 * SLOT); bf16* B3 = (bf16*)(ws + WS_BIG + 3 * SLOT); \
    bf16* B4 = (bf16*)(ws + WS_BIG + 4 * SLOT); bf16* B5 = (bf16*)(ws + WS_BIG + 5 * SLOT); bf16* B5b = (bf16*)(ws + WS_BIG + 5 * SLOT + 16 * MiB); \
    LAS float* scr = (LAS float*)(lds + wave * 16384); \
    (void)lane; (void)gw; (void)ngw; (void)gt; (void)ngt; (void)RS; (void)LBK; (void)WA; (void)WB; (void)WO; (void)WUP; (void)WDN; (void)HB; (void)B0; (void)B1; (void)B2; (void)B3; (void)B4; (void)B5; (void)B5b; (void)scr; (void)out; (void)G;
constexpr size_t SLOT_E = SLOT / 2;

__global__ void __launch_bounds__(NTHR, 2) fwd_megakernel(Args a) {
    extern __shared__ __attribute__((aligned(16))) unsigned char lds_raw[];
    cg::grid_group grid = cg::this_grid();
    LAS unsigned char* lds = (LAS unsigned char*)lds_raw;
    volatile LAS unsigned* xb_st = (volatile LAS unsigned*)(lds + LDS_BYTES - 64);
    if (threadIdx.x < 2) xb_st[threadIdx.x] = 0u;
    __syncthreads();
    const XcdBarrier xbar = xcd_barrier_post((unsigned*)(a.ws + WS_BAR), xb_st);

#pragma nounroll
    for (int layer = 0; layer < 4; ++layer) {
        for (int rp_ = 0; rp_ < REP_PRO; ++rp_) { PHASE_VARS
        const float* gmix = a.in[1] + layer * 1024; const float* gffn = a.in[2] + layer * 1024;
        conv_mat(a.in[3] + (size_t)layer * D * FF, D, FF, WUP, D, 0, 0, gffn, scr, gw, ngw, lane);
        conv_mat(a.in[4] + (size_t)layer * D * FF, FF, D, WDN, FF, 0, 0, nullptr, scr, gw, ngw, lane);
        if (layer == 0) {
            conv_mat(a.in[6], D, 3 * D, WA, D, 0, 0, gmix, scr, gw, ngw, lane);
            conv_mat(a.in[7], D, D, WO, D, 0, 0, nullptr, scr, gw, ngw, lane);
            for (int m0 = gw; m0 < M; m0 += 4 * ngw) {
                f32x4 v[4][4];
#pragma unroll
                for (int u = 0; u < 4; ++u) { const int ml = m0 + u * ngw < M ? m0 + u * ngw : m0; const f32x4* xr = (const f32x4*)(a.in[0] + (size_t)ml * 1024) + lane;
#pragma unroll
                    for (int j = 0; j < 4; ++j) v[u][j] = xr[64 * j]; }
#pragma unroll
                for (int u = 0; u < 4; ++u) { const int m = m0 + u * ngw; if (m >= M) break; float ss = 0.f;
#pragma unroll
                    for (int j = 0; j < 4; ++j) { ss += (v[u][j][0] * v[u][j][0] + v[u][j][1] * v[u][j][1]) + (v[u][j][2] * v[u][j][2] + v[u][j][3] * v[u][j][3]);
                        v2u w; w.x = pk2(v[u][j][0], v[u][j][1]); w.y = pk2(v[u][j][2], v[u][j][3]); *(v2u*)(HB + (size_t)m * 1024 + 4 * lane + 256 * j) = w; }
                    ss = wave_sum(ss);
                    if (lane < 16) RS[(size_t)m * 16 + lane] = lane == 0 ? ss : 0.f; }
            }
        } else if (layer == 1) {
            conv_mat(a.in[8], D, 4 * D, WA, D, 0, 0, gmix, scr, gw, ngw, lane);
            conv_mat(a.in[11], D, D, WO, D, 0, 0, nullptr, scr, gw, ngw, lane);
            for (int c = gt; c < 1024; c += ngt) {
                const float* tb = a.in[9]; const float t0 = tb[c], t1 = tb[1024 + c], t2 = tb[2048 + c], t3 = tb[3072 + c];
                const float mx = fmaxf(fmaxf(t0, t1), fmaxf(t2, t3));
                const float e0 = expf(t0 - mx), e1 = expf(t1 - mx), e2 = expf(t2 - mx), e3 = expf(t3 - mx);
                LBK[c] = 1.0f - e1 / (e0 + e1 + e2 + e3);
            }
        } else if (layer == 2) {
            const float* mix = a.in[12];
#pragma nounroll
            for (int j = 0; j < 3; ++j) {
                conv_mat(a.in[13] + (size_t)j * D * D, D, D, WA, 2048, 1024 * j, 0, nullptr, scr, gw, ngw, lane);
                conv_mat(a.in[13] + (size_t)j * D * D, D, D, WA, 2048, 1024 * j, 1024, mix + 1024 * j, scr, gw, ngw, lane);
            }
            conv_mat(a.in[15], D, 64, WA, 2048, 3072, 0, nullptr, scr, gw, ngw, lane); conv_mat(a.in[15], D, 64, WA, 2048, 3072, 1024, mix + 3 * 1024, scr, gw, ngw, lane);
            conv_mat(a.in[18], D, 64, WA, 2048, 3136, 0, nullptr, scr, gw, ngw, lane); conv_mat(a.in[18], D, 64, WA, 2048, 3136, 1024, mix + 4 * 1024, scr, gw, ngw, lane);
            conv_mat(a.in[20], D, 128, WA, 2048, 3200, 0, nullptr, scr, gw, ngw, lane); conv_mat(a.in[20], D, 128, WA, 2048, 3200, 1024, mix + 5 * 1024, scr, gw, ngw, lane);
            conv_mat(a.in[27], D, D, WO, D, 0, 0, nullptr, scr, gw, ngw, lane);
            for (int idx = gt; idx < 256 * 3072; idx += ngt) {
                const int k = idx / 3072, n = idx - k * 3072, grp = n >> 10, nn = n & 1023; float v = 0.f;
                if (grp == 0) { if (k < 64) v = a.in[16][k * 1024 + nn]; }
                else if (grp == 1) { if (k >= 64 && k < 128) v = a.in[19][(k - 64) * 1024 + nn]; }
                else { if (k >= 128) v = a.in[21][(k - 128) * 1024 + nn]; }
                WB[(size_t)n * 256 + k] = (bf16)f2bf(v);
            }
            rw_prep(out, RS, gmix, B0, gw, ngw, lane);
        } else {
            conv_mat(a.in[28], D, 3 * D, WA, D, 0, 0, gmix, scr, gw, ngw, lane);
            conv_mat(a.in[31], D, D, WO, D, 0, 0, nullptr, scr, gw, ngw, lane);
        }
        }
        if (layer == 0) {
            grid.sync();
            if (threadIdx.x == 0) {
                unsigned* bar_ = (unsigned*)(a.ws + WS_BAR); const unsigned myx = xb_st[3]; unsigned cnt = 0u, ok = 1u, idx = 0u;
                for (unsigned j = 0; j < 16; ++j) { const unsigned c_ = xb_ld(&bar_[XB_XCNT(j)]); if (c_) { if (c_ * 8u != gridDim.x) ok = 0u; if (j < myx) ++idx; ++cnt; } }
                if (cnt != 8u) ok = 0u;
                xb_st[4] = ok ? xb_st[2] * 8u + idx : (unsigned)blockIdx.x;
            }
            __syncthreads();
        }
        else GRID_SYNC();

        if (layer == 0 || layer == 3) {
            { PHASE_VARS
            pg8::Gemm g{HB, WA, M, 3 * D, D}; pg8::StaticOrder S; S.init(M, 3 * D, G, vc);
            pg8::EpiAct<0> E{B0, 1024, 1024, SLOT_E, RS, layer == 0 ? 0.125f * LOG2E_F : 1.0f, nullptr};
            for (int r_ = 0; r_ < REP_IN; ++r_) pg8::gemm_phase<pg8::EpiAct<0>, pg8::StaticOrder, true, true>(lds, g, S, E); }
            GRID_SYNC();
            { PHASE_VARS
            if (layer == 0) { for (int r_ = 0; r_ < REP_ATT; ++r_) attn_phase(B0, B1, B2, B3, gw, ngw, lane); }
            else { for (int r_ = 0; r_ < REP_SC; ++r_) sc_conv(B0, B1, B2, a.in[29], a.in[30], B3, gt, ngt); } }
        } else if (layer == 1) {
            { PHASE_VARS
            pg8::Gemm g{HB, WA, M, 4 * D, D}; pg8::StaticOrder S; S.init(M, 4 * D, G, vc);
            pg8::EpiAct<2> E{B0, 1024, 1024, SLOT_E, RS, 1.0f, LBK};
            for (int r_ = 0; r_ < REP_IN; ++r_) pg8::gemm_phase<pg8::EpiAct<2>, pg8::StaticOrder, true, true>(lds, g, S, E); }
            GRID_SYNC();
            { PHASE_VARS
            hg_prep(B0, B1, B4, (float*)B5, gw, ngw, lane); }
            GRID_SYNC();
            { PHASE_VARS
            for (int r_ = 0; r_ < REP_HGL; ++r_) hg_local(B4, B2, (const float*)B5, (float*)(ws + WS_BIG + 5 * SLOT + 8 * MiB), (float*)(ws + WS_BIG + 5 * SLOT + 24 * MiB)); }
            GRID_SYNC();
            { PHASE_VARS
            hg_out(B0, B1, B4, B2, (const float*)B5, (const float*)(ws + WS_BIG + 5 * SLOT + 8 * MiB), (const float*)(ws + WS_BIG + 5 * SLOT + 24 * MiB), a.in[10], B3, lds); }
        } else {
            { PHASE_VARS
              pg8::Gemm g{B0, WA, M, 3328, 2048}; pg8::StaticOrder S; S.init(M, 3328, G, vc);
              pg8::EpiRw1 E{B2, SLOT_E, B5};
              for (int r_ = 0; r_ < REP_G1; ++r_) pg8::gemm_phase<pg8::EpiRw1, pg8::StaticOrder, true, true>(lds, g, S, E); }
            GRID_SYNC();
            { PHASE_VARS
              int k256 = 256; asm volatile("" : "+s"(k256));
              pg8::Gemm g{B5, WB, M, 3 * D, k256}; pg8::StaticOrder S; S.init(M, 3 * D, G, vc);
              pg8::EpiRw2 E{B0, SLOT_E, 5 * SLOT_E + 8 * MiB, a.in[14], a.in[17]};
              for (int r_ = 0; r_ < REP_G2; ++r_) pg8::gemm_phase<pg8::EpiRw2, pg8::StaticOrder, true, true>(lds, g, S, E); }
            GRID_SYNC();
            { PHASE_VARS
            for (int r_ = 0; r_ < REP_RW; ++r_) rw_scan(B2, B3, B4, B0, B1, a.in[22], a.in[23], HB, lds); }
            GRID_SYNC();
            { PHASE_VARS
            rw_post(HB, B2, B3, B4, B1, B5b, a.in[23], a.in[24], a.in[25], a.in[26], gw, ngw, lane); }
        }
        GRID_SYNC();
        { PHASE_VARS
          const bf16* mix_out = (layer == 2) ? B2 : B3;
          pg8::Gemm g{mix_out, WO, M, D, D}; pg8::StaticOrder S; S.init(M, D, G, vc);
#pragma nounroll
          for (int r_ = 0; r_ < REP_OUT; ++r_) {
          pg8::EpiResid E{layer == 0 ? a.in[0] : out, r_ + 1 < REP_OUT ? (float*)B4 : out, HB, RS};
          pg8::gemm_phase<pg8::EpiResid, pg8::StaticOrder, true, true>(lds, g, S, E); } }
        GRID_SYNC();
        { PHASE_VARS
          pg8::Gemm g{HB, WUP, M, FF, D}; pg8::StaticOrder S; S.init(M, FF, G, vc);
          pg8::EpiAct<1> E{B0, FF, 0, 0, RS, 1.0f, nullptr};
#pragma nounroll
          for (int r_ = 0; r_ < REP_UP; ++r_) pg8::gemm_phase<pg8::EpiAct<1>, pg8::StaticOrder, true, true>(lds, g, S, E); }
        GRID_SYNC();
        { PHASE_VARS
          pg8::Gemm g{B0, WDN, M, D, FF}; pg8::StaticOrder S; S.init(M, D, G, vc);
#pragma nounroll
          for (int r_ = 0; r_ < REP_DN; ++r_) {
          pg8::EpiResid E{out, r_ + 1 < REP_DN ? (float*)B4 : out, HB, RS};
          pg8::gemm_phase<pg8::EpiResid, pg8::StaticOrder, true, true>(lds, g, S, E); } }
        GRID_SYNC();
    }
    { PHASE_VARS
    const f32x4* gr = (const f32x4*)(a.in[5]) + lane;
    const f32x4 g0 = gr[0], g1 = gr[64], g2 = gr[128], g3 = gr[192];
    for (int m0 = gw; m0 < M; m0 += 4 * ngw) {
        f32x4 v[4][4]; f32x4 pr[4];
#pragma unroll
        for (int u = 0; u < 4; ++u) { const int m = m0 + u * ngw < M ? m0 + u * ngw : m0; const f32x4* xr = (const f32x4*)(out + (size_t)m * 1024) + lane;
            pr[u] = *(const f32x4*)(RS + (size_t)m * 16 + 4 * (lane & 3));
#pragma unroll
            for (int j = 0; j < 4; ++j) v[u][j] = xr[64 * j]; }
#pragma unroll
        for (int u = 0; u < 4; ++u) { const int m = m0 + u * ngw; if (m >= M) break; f32x4* xr = (f32x4*)(out + (size_t)m * 1024) + lane;
            float s = (pr[u][0] + pr[u][1]) + (pr[u][2] + pr[u][3]); s += dpp_f<0xB1>(s); s += dpp_f<0x4E>(s);
            const float r = 1.0f / sqrtf(s * (1.0f / 1024.0f) + 1e-6f);
            xr[0] = v[u][0] * r * g0; xr[64] = v[u][1] * r * g1; xr[128] = v[u][2] * r * g2; xr[192] = v[u][3] * r * g3; }
    } }
}

extern "C" void kernel_launch(void* const* d_in, const int* in_sizes, int n_in, void* d_out, int out_size, void* d_ws, size_t ws_size, hipStream_t stream) {
    static int grid = 0;
    if (grid == 0) {
        if (n_in != 32 || out_size != M * D || ws_size < WS_END) { fprintf(stderr, "kernel_launch: unexpected shapes (n_in %d out %d ws %zu)\n", n_in, out_size, ws_size); grid = -1; return; }
        int dev = 0, cus = 0, per_cu = 0;
        hipGetDevice(&dev); hipDeviceGetAttribute(&cus, hipDeviceAttributeMultiprocessorCount, dev);
        hipFuncSetAttribute((const void*)fwd_megakernel, hipFuncAttributeMaxDynamicSharedMemorySize, LDS_BYTES);
        hipOccupancyMaxActiveBlocksPerMultiprocessor(&per_cu, (const void*)fwd_megakernel, NTHR, LDS_BYTES);
        if (per_cu < 1) { fprintf(stderr, "kernel_launch: occupancy query says %d blocks per CU\n", per_cu); per_cu = 1; }
        (void)hipGetLastError();
        grid = cus * per_cu;
    }
    if (grid < 0) return;
    if (hipMemsetAsync((char*)d_ws + WS_BAR, 0, WS_BAR_BYTES, stream) != hipSuccess) { fprintf(stderr, "kernel_launch: memset of the barrier words failed\n"); return; }
    Args a{};
    for (int i = 0; i < 32; ++i) a.in[i] = (const float*)d_in[i];
    a.out = (float*)d_out; a.ws = (unsigned char*)d_ws;
    void* args[] = {&a};
    hipError_t e = hipLaunchCooperativeKernel((const void*)fwd_megakernel, dim3(grid), dim3(NTHR), args, LDS_BYTES, stream);
    if (e != hipSuccess) fprintf(stderr, "cooperative launch failed: %s (grid %d)\n", hipGetErrorString(e), grid);
}
```

```cpp
#include <hip/hip_runtime.h>
#include <hip/hip_cooperative_groups.h>
#include <cstdio>
#include <cstdint>
namespace cg = cooperative_groups;
namespace pg8 {
#define PG8_LAS __attribute__((address_space(3)))
typedef unsigned short bf16_t;
typedef short bf16x8 __attribute__((ext_vector_type(8)));
typedef float f32x4 __attribute__((ext_vector_type(4)));
typedef unsigned u32x4 __attribute__((ext_vector_type(4)));
constexpr int BM = 256, BK = 64, HALF = 128, HTB = HALF * BK * 2  , STAGE_BYTES = 8 * HTB, NXCD = 8, WGM = 8;

__host__ __device__ __forceinline__ int lds_byte(int r, int c) { const int st = (r >> 4) * 2 + (c >> 5), rr = r & 15, cc = c & 31, ob = rr * 64 + cc * 2; return st * 1024 + (ob ^ (((ob >> 9) & 1) << 5)); }
__host__ __device__ __forceinline__ void stage_rc(int b, int& R, int& C) { const int st = b / 1024, sb = b % 1024, swz = sb ^ (((sb >> 9) & 1) << 5); R = (st >> 1) * 16 + swz / 64; C = (st & 1) * 32 + (swz % 64) / 2; }
__host__ __device__ __forceinline__ int perm32(int rho) { const int n = rho >> 4, i = rho & 15; return 8 * (i >> 2) + 4 * n + (i & 3); }

struct Unit { int pm, pn; };
struct Gemm { const bf16_t* A; const bf16_t* Bt; int M, N, K; };

struct StaticOrder {
    int nM, nN, nwg, G, c;
    __host__ __device__ void init(int M, int N, int G_, int c_) { nM = M / BM; nN = N / BM; nwg = nM * nN; G = G_; c = c_; }
    __host__ __device__ bool next(int i, Unit& u) const {
        const long L = (long)i * G + c; if (L >= nwg) return false;
        int wgid = (int)L; { const int q = nwg / NXCD, r = nwg % NXCD, xcd = wgid % NXCD, off = wgid / NXCD; wgid = (xcd < r ? xcd * (q + 1) : r * (q + 1) + (xcd - r) * q) + off; }
        const int wgm = nN >= 8 ? 4 : WGM; const int nig = wgm * nN, gid = wgid / nig, fm = gid * wgm, gsz = (nM - fm) < wgm ? (nM - fm) : wgm;
        u.pm = fm + ((wgid % nig) % gsz); u.pn = (wgid % nig) / gsz; return true;
    }
    __device__ __forceinline__ void a_ready(const Unit&) const {}
    __device__ __forceinline__ void done(const Unit&) const {}
};

__device__ __forceinline__ unsigned cvt_pk_bf16(float lo, float hi) { unsigned r; asm volatile("v_cvt_pk_bf16_f32 %0, %1, %2" : "=v"(r) : "v"(lo), "v"(hi)); return r; }
typedef unsigned u32x4 __attribute__((ext_vector_type(4)));
typedef unsigned u32x2 __attribute__((ext_vector_type(2)));
constexpr float LOG2E = 1.4426950408889634f;
__device__ __forceinline__ float fast_sigmoid(float x) { return __builtin_amdgcn_rcpf(1.0f + __builtin_amdgcn_exp2f(-x * LOG2E)); }
__device__ __forceinline__ float row_rs(const float* rs, int row) {
    const f32x4* p = (const f32x4*)(rs + (size_t)row * 16);
    const f32x4 a = p[0], b = p[1], c = p[2], d = p[3];
    const float s = ((a[0] + a[1]) + (a[2] + a[3])) + ((b[0] + b[1]) + (b[2] + b[3])) + ((c[0] + c[1]) + (c[2] + c[3])) + ((d[0] + d[1]) + (d[2] + d[3]));
    return 1.0f / sqrtf(s * (1.0f / 1024.0f) + 1e-6f);
}
template <int MODE> struct EpiAct {
    static constexpr bool PERM = true, AFTER_DRAIN = false;
    bf16_t* O; int ldc; int split_cols; size_t split_stride; const float* rs; float scale0; const float* aux;
    __device__ __forceinline__ void operator()(const f32x4 (&acc)[2][2][4][2], const Unit& u, int wr, int wc, int fr, int fq) const {
        const int row0 = u.pm * BM + wr * 64 + fr; int colt = u.pn * BM; bf16_t* base = O; int t = 0;
        if (split_cols) { t = colt / split_cols; base += (size_t)t * split_stride; colt -= t * split_cols; }
        const float sc = (MODE == 0 && t == 0) ? scale0 : 1.f;
        const int col0 = colt + wc * 32 + 8 * fq;
        f32x4 lbk[2][2];
#pragma unroll
        for (int bj = 0; bj < 2; ++bj)
#pragma unroll
            for (int n = 0; n < 2; ++n) lbk[bj][n] = (MODE == 2 && t == 1) ? *(const f32x4*)(aux + col0 + bj * HALF + 4 * n) : (f32x4){0.f, 0.f, 0.f, 0.f};
        float rsv[2][4];
        if (rs) {
            f32x4 part[2][4];
#pragma unroll
            for (int ai = 0; ai < 2; ++ai)
#pragma unroll
                for (int m = 0; m < 4; ++m) part[ai][m] = *(const f32x4*)(rs + (size_t)(row0 + ai * HALF + m * 16) * 16 + 4 * fq);
#pragma unroll
            for (int ai = 0; ai < 2; ++ai)
#pragma unroll
                for (int m = 0; m < 4; ++m) { float s = (part[ai][m][0] + part[ai][m][1]) + (part[ai][m][2] + part[ai][m][3]); s += __shfl_xor(s, 16); s += __shfl_xor(s, 32);
                    rsv[ai][m] = sc / sqrtf(s * (1.0f / 1024.0f) + 1e-6f); }
        } else {
#pragma unroll
            for (int ai = 0; ai < 2; ++ai)
#pragma unroll
                for (int m = 0; m < 4; ++m) rsv[ai][m] = sc;
        }
#pragma unroll
        for (int ai = 0; ai < 2; ++ai)
#pragma unroll
            for (int m = 0; m < 4; ++m) {
                const int row = row0 + ai * HALF + m * 16;
                const float r = rsv[ai][m];
                bf16_t* rowp = base + (size_t)row * ldc + col0;
#pragma unroll
                for (int bj = 0; bj < 2; ++bj) {
                    f32x4 v[2] = {acc[ai][bj][m][0] * r, acc[ai][bj][m][1] * r};
#pragma unroll
                    for (int n = 0; n < 2; ++n)
#pragma unroll
                        for (int j = 0; j < 4; ++j) {
                            float x = v[n][j];
                            if (MODE == 1) { x = fmaxf(x, 0.f); x = x * x; }
                            if (MODE == 2) {
                                if (t == 0 || t == 3) x = x * fast_sigmoid(x);
                                else if (t == 1) x = lbk[bj][n][j] * __builtin_amdgcn_rcpf(1.0f + __builtin_amdgcn_exp2f(x * LOG2E));
                            }
                            v[n][j] = x;
                        }
                    u32x4 w; w.x = cvt_pk_bf16(v[0][0], v[0][1]); w.y = cvt_pk_bf16(v[0][2], v[0][3]); w.z = cvt_pk_bf16(v[1][0], v[1][1]); w.w = cvt_pk_bf16(v[1][2], v[1][3]);
                    *(u32x4*)(rowp + bj * HALF) = w;
                }
            }
    }
};
struct EpiRw1 {
    static constexpr bool PERM = true, AFTER_DRAIN = false;
    bf16_t* RKV; size_t split_stride; bf16_t* L;
    __device__ __forceinline__ void operator()(const f32x4 (&acc)[2][2][4][2], const Unit& u, int wr, int wc, int fr, int fq) const {
        const int row0 = u.pm * BM + wr * 64 + fr;
        const bool lora = (u.pn >= 12);
        bf16_t* base = lora ? L : RKV + (size_t)(u.pn >> 2) * split_stride;
        const int ldc = lora ? 256 : 1024;
        const int col0 = (lora ? 0 : (u.pn & 3) * BM) + wc * 32 + 8 * fq;
#pragma unroll
        for (int ai = 0; ai < 2; ++ai)
#pragma unroll
            for (int m = 0; m < 4; ++m) {
                bf16_t* rowp = base + (size_t)(row0 + ai * HALF + m * 16) * ldc + col0;
#pragma unroll
                for (int bj = 0; bj < 2; ++bj) {
                    f32x4 v[2] = {acc[ai][bj][m][0], acc[ai][bj][m][1]};
                    if (lora) {
#pragma unroll
                        for (int n = 0; n < 2; ++n)
#pragma unroll
                            for (int j = 0; j < 4; ++j) {
                                float x = v[n][j];
                                if (bj == 1) x = fast_sigmoid(x);
                                else if (wc < 2) x = 1.0f - 2.0f * __builtin_amdgcn_rcpf(1.0f + __builtin_amdgcn_exp2f(fminf(x, 40.f) * (2.0f * LOG2E)));
                                v[n][j] = x;
                            }
                    }
                    u32x4 w; w.x = cvt_pk_bf16(v[0][0], v[0][1]); w.y = cvt_pk_bf16(v[0][2], v[0][3]); w.z = cvt_pk_bf16(v[1][0], v[1][1]); w.w = cvt_pk_bf16(v[1][2], v[1][3]);
                    *(u32x4*)(rowp + bj * HALF) = w;
                }
            }
    }
};
struct EpiRw2 {
    static constexpr bool PERM = true, AFTER_DRAIN = false;
    bf16_t* WM; size_t offA, offG; const float* w0; const float* a0;
    __device__ __forceinline__ void operator()(const f32x4 (&acc)[2][2][4][2], const Unit& u, int wr, int wc, int fr, int fq) const {
        const int row0 = u.pm * BM + wr * 64 + fr; const int t = u.pn >> 2;
        bf16_t* base = WM + (t == 1 ? offA : (size_t)0) + (t == 2 ? offG : (size_t)0);
        const float* bias = t == 0 ? w0 : a0;
        const int col0 = (u.pn & 3) * BM + wc * 32 + 8 * fq;
        f32x4 bv[2][2];
#pragma unroll
        for (int bj = 0; bj < 2; ++bj)
#pragma unroll
            for (int n = 0; n < 2; ++n) bv[bj][n] = (t < 2) ? *(const f32x4*)(bias + col0 + bj * HALF + 4 * n) : (f32x4){0.f, 0.f, 0.f, 0.f};
#pragma unroll
        for (int ai = 0; ai < 2; ++ai)
#pragma unroll
            for (int m = 0; m < 4; ++m) {
                bf16_t* rowp = base + (size_t)(row0 + ai * HALF + m * 16) * 1024 + col0;
#pragma unroll
                for (int bj = 0; bj < 2; ++bj) {
                    f32x4 v[2] = {acc[ai][bj][m][0], acc[ai][bj][m][1]};
                    if (t < 2) {
                        v[0] += bv[bj][0]; v[1] += bv[bj][1];
#pragma unroll
                        for (int n = 0; n < 2; ++n)
#pragma unroll
                            for (int j = 0; j < 4; ++j) {
                                float x = fast_sigmoid(v[n][j]);
                                if (t == 0) x = 1.0f - __builtin_amdgcn_exp2f(x * (-0.6065306597126334f * LOG2E));
                                v[n][j] = x;
                            }
                    }
                    u32x4 w; w.x = cvt_pk_bf16(v[0][0], v[0][1]); w.y = cvt_pk_bf16(v[0][2], v[0][3]); w.z = cvt_pk_bf16(v[1][0], v[1][1]); w.w = cvt_pk_bf16(v[1][2], v[1][3]);
                    *(u32x4*)(rowp + bj * HALF) = w;
                    asm volatile("" ::: "memory");
                }
            }
    }
};
struct EpiResid {
    static constexpr bool PERM = false, AFTER_DRAIN = false;
    const float* base; float* out; bf16_t* hb; float* rsq;
    __device__ __forceinline__ void operator()(const f32x4 (&acc)[2][2][4][2], const Unit& u, int wr, int wc, int fr, int fq) const {
        const int col0 = u.pn * BM + wc * 32 + 4 * fq;
#pragma unroll
        for (int ai = 0; ai < 2; ++ai) {
            f32x4 pre[4][2][2];
#pragma unroll
            for (int m = 0; m < 4; ++m) { const size_t off = (size_t)(u.pm * BM + ai * HALF + wr * 64 + m * 16 + fr) * 1024 + col0;
#pragma unroll
                for (int bj = 0; bj < 2; ++bj)
#pragma unroll
                    for (int n = 0; n < 2; ++n) pre[m][bj][n] = *(const f32x4*)(base + off + bj * HALF + n * 16); }
#pragma unroll
            for (int m = 0; m < 4; ++m) {
                const int row = u.pm * BM + ai * HALF + wr * 64 + m * 16 + fr; const size_t off = (size_t)row * 1024 + col0;
                float ss = 0.f;
#pragma unroll
                for (int bj = 0; bj < 2; ++bj)
#pragma unroll
                    for (int n = 0; n < 2; ++n) {
                        const f32x4 o = pre[m][bj][n] + acc[ai][bj][m][n];
                        *(f32x4*)(out + off + bj * HALF + n * 16) = o;
                        u32x2 w; w.x = cvt_pk_bf16(o[0], o[1]); w.y = cvt_pk_bf16(o[2], o[3]);
                        if (hb) *(u32x2*)(hb + off + bj * HALF + n * 16) = w;
                        ss += (o[0] * o[0] + o[1] * o[1]) + (o[2] * o[2] + o[3] * o[3]);
                    }
                ss += __shfl_xor(ss, 16); ss += __shfl_xor(ss, 32);
                if (fq == 0) rsq[(size_t)row * 16 + u.pn * 4 + wc] = ss;
            }
        }
    }
};
template <class Epi, class Sched, bool ALIGN_EPI = false, bool SP2 = false>
__device__ __forceinline__ void gemm_phase(PG8_LAS unsigned char* lds, const Gemm g, const Sched& S, const Epi& E) {
    int tid_ = threadIdx.x; asm volatile("" : "+v"(tid_)); const int tid = tid_, wid = __builtin_amdgcn_readfirstlane(tid >> 6), lane = tid & 63, wr = wid >> 2, wc = wid & 3, fr = lane & 15, fq = lane >> 4;
    const int K = g.K, nt = K / BK;
    unsigned voffA[2], voffB[2];
#pragma unroll
    for (int i = 0; i < 2; ++i) { int R, C; stage_rc(tid * 16 + i * 8192, R, C); const int Rb = Epi::PERM ? ((R & ~31) + perm32(R & 31)) : R;
        voffA[i] = (unsigned)(R * K + C) * 2u; voffB[i] = (unsigned)(Rb * K + C) * 2u; }
    const size_t kstep = (size_t)(BK * 2);
    const size_t hstep = (size_t)HALF * K * 2;
    const size_t tstep = 2 * hstep;
    const unsigned ldsw = (unsigned)wid * 1024u;
    const int aoff = lds_byte(wr * 64 + fr, fq * 8), boff = lds_byte(wc * 32 + fr, fq * 8);
#define PG8_SA(b, h) (((b) * 2 + (h)) * HTB)
#define PG8_SB(b, h) ((4 + (b) * 2 + (h)) * HTB)
#define PG8_STAGE(bufoff, gbase, voff) do { _Pragma("unroll") for (int _i = 0; _i < 2; ++_i) \
        __builtin_amdgcn_global_load_lds((const unsigned*)((const char*)(gbase) + (voff)[_i]), (PG8_LAS unsigned*)(lds + (bufoff) + ldsw + _i * 8192), 16, 0, 0); } while (0)
#define PG8_LDA(dst, b, h) do { _Pragma("unroll") for (int m = 0; m < 4; ++m) _Pragma("unroll") for (int k = 0; k < 2; ++k) dst[m][k] = *(const PG8_LAS bf16x8*)(lds + PG8_SA(b, h) + aoff + m * 2048 + k * 1024); } while (0)
#define PG8_LDB(dst, b, h) do { _Pragma("unroll") for (int n = 0; n < 2; ++n) _Pragma("unroll") for (int k = 0; k < 2; ++k) dst[n][k] = *(const PG8_LAS bf16x8*)(lds + PG8_SB(b, h) + boff + n * 2048 + k * 1024); } while (0)
#define PG8_MMA(ai, bj, At, Bt) do { __builtin_amdgcn_s_setprio(1); _Pragma("unroll") for (int m = 0; m < 4; ++m) _Pragma("unroll") for (int n = 0; n < 2; ++n) _Pragma("unroll") for (int k = 0; k < 2; ++k) \
        acc[ai][bj][m][n] = __builtin_amdgcn_mfma_f32_16x16x32_bf16(Bt[n][k], At[m][k], acc[ai][bj][m][n], 0, 0, 0); __builtin_amdgcn_s_setprio(0); } while (0)
#define PG8_WAIT_V(n) asm volatile("s_waitcnt vmcnt(" #n ")" ::: "memory")
#define PG8_WAIT_L(n) asm volatile("s_waitcnt lgkmcnt(" #n ")" ::: "memory")
#define PG8_BAR __builtin_amdgcn_s_barrier()
#define PG8_SCHED __builtin_amdgcn_sched_barrier(0)
    Unit cur, nxt; int ui = 0;
    if (!S.next(0, cur)) return;
    f32x4 acc[2][2][4][2];
#pragma unroll
    for (int a = 0; a < 2; ++a)
#pragma unroll
        for (int b = 0; b < 2; ++b)
#pragma unroll
            for (int m = 0; m < 4; ++m)
#pragma unroll
                for (int n = 0; n < 2; ++n) acc[a][b][m][n] = (f32x4){0.f, 0.f, 0.f, 0.f};
    bf16x8 At[4][2], B0[2][2], B1[2][2];
    const char* cA = (const char*)g.A + (size_t)cur.pm * tstep; const char* cB = (const char*)g.Bt + (size_t)cur.pn * tstep;
    S.a_ready(cur);
    if constexpr (SP2) {
        PG8_STAGE(PG8_SB(0, 0), cB, voffB); PG8_STAGE(PG8_SB(0, 1), cB + hstep, voffB); PG8_STAGE(PG8_SA(0, 0), cA, voffA); PG8_STAGE(PG8_SA(0, 1), cA + hstep, voffA);
        if (wr == 1) PG8_BAR;
        PG8_WAIT_V(2); PG8_BAR;
        PG8_STAGE(PG8_SB(1, 0), cB + kstep, voffB); PG8_STAGE(PG8_SA(1, 0), cA + kstep, voffA); PG8_STAGE(PG8_SB(1, 1), cB + hstep + kstep, voffB);
        PG8_WAIT_V(6); PG8_BAR;
    } else {
        PG8_STAGE(PG8_SB(0, 0), cB, voffB); PG8_STAGE(PG8_SA(0, 0), cA, voffA); PG8_STAGE(PG8_SB(0, 1), cB + hstep, voffB); PG8_STAGE(PG8_SA(0, 1), cA + hstep, voffA);
        if (wr == 1) PG8_BAR;
        PG8_WAIT_V(4); PG8_BAR;
        PG8_STAGE(PG8_SB(1, 0), cB + kstep, voffB); PG8_STAGE(PG8_SA(1, 0), cA + kstep, voffA); PG8_STAGE(PG8_SB(1, 1), cB + hstep + kstep, voffB);
        PG8_WAIT_V(6); PG8_BAR;
    }
    for (;;) {
        const bool has_next = S.next(ui + 1, nxt);
        const char* nA = has_next ? (const char*)g.A + (size_t)nxt.pm * tstep : cA; const char* nB = has_next ? (const char*)g.Bt + (size_t)nxt.pn * tstep : cB;
        for (int t = 0; t < nt; t += 2) {
            const bool last = (t == nt - 2);
            const char* a1 = cA + (size_t)(t + 1) * kstep;
            const char* a2 = last ? nA : cA + (size_t)(t + 2) * kstep; const char* b2 = last ? nB : cB + (size_t)(t + 2) * kstep;
            const char* a3 = a2 + kstep; const char* b3 = b2 + kstep;
            if (last && has_next) S.a_ready(nxt);
            if constexpr (SP2) {
            PG8_LDB(B0, 0, 0); PG8_LDB(B1, 0, 1); PG8_SCHED; PG8_LDA(At, 0, 0); PG8_STAGE(PG8_SA(1, 1), a1 + hstep, voffA);
            PG8_WAIT_V(8); PG8_WAIT_L(0); PG8_BAR; PG8_MMA(0, 0, At, B0); PG8_MMA(0, 1, At, B1); PG8_BAR; PG8_SCHED;
            PG8_LDA(At, 0, 1); PG8_STAGE(PG8_SB(0, 0), b2, voffB); PG8_STAGE(PG8_SB(0, 1), b2 + hstep, voffB); PG8_STAGE(PG8_SA(0, 0), a2, voffA);
            PG8_WAIT_V(8); PG8_WAIT_L(0); PG8_BAR; PG8_MMA(1, 0, At, B0); PG8_MMA(1, 1, At, B1); PG8_BAR; PG8_SCHED;
            PG8_LDB(B0, 1, 0); PG8_LDB(B1, 1, 1); PG8_SCHED; PG8_LDA(At, 1, 0); PG8_STAGE(PG8_SA(0, 1), a2 + hstep, voffA);
            PG8_WAIT_V(8); PG8_WAIT_L(0); PG8_BAR; PG8_MMA(0, 0, At, B0); PG8_MMA(0, 1, At, B1); PG8_BAR; PG8_SCHED;
            PG8_LDA(At, 1, 1); PG8_STAGE(PG8_SB(1, 0), b3, voffB); PG8_STAGE(PG8_SB(1, 1), b3 + hstep, voffB); PG8_STAGE(PG8_SA(1, 0), a3, voffA);
            PG8_WAIT_V(8); PG8_WAIT_L(0); PG8_BAR; PG8_MMA(1, 0, At, B0); PG8_MMA(1, 1, At, B1); PG8_BAR; PG8_SCHED;
            } else {
            PG8_LDB(B0, 0, 0); PG8_SCHED; PG8_LDA(At, 0, 0); PG8_STAGE(PG8_SA(1, 1), a1 + hstep, voffA);
            PG8_WAIT_L(8); PG8_BAR; PG8_WAIT_L(0); PG8_MMA(0, 0, At, B0); PG8_BAR; PG8_SCHED;
            PG8_LDB(B1, 0, 1); PG8_STAGE(PG8_SB(0, 0), b2, voffB);
            PG8_BAR; PG8_WAIT_L(0); PG8_MMA(0, 1, At, B1); PG8_BAR;
            PG8_LDA(At, 0, 1); PG8_STAGE(PG8_SA(0, 0), a2, voffA);
            PG8_BAR; PG8_WAIT_L(0); PG8_MMA(1, 0, At, B0); PG8_BAR; PG8_SCHED;
            PG8_STAGE(PG8_SB(0, 1), b2 + hstep, voffB);
            PG8_WAIT_V(6); PG8_BAR; PG8_MMA(1, 1, At, B1); PG8_BAR;
            PG8_LDB(B0, 1, 0); PG8_SCHED; PG8_LDA(At, 1, 0); PG8_STAGE(PG8_SA(0, 1), a2 + hstep, voffA);
            PG8_WAIT_L(8); PG8_BAR; PG8_WAIT_L(0); PG8_MMA(0, 0, At, B0); PG8_BAR; PG8_SCHED;
            PG8_LDB(B1, 1, 1); PG8_STAGE(PG8_SB(1, 0), b3, voffB);
            PG8_BAR; PG8_WAIT_L(0); PG8_MMA(0, 1, At, B1); PG8_BAR;
            PG8_LDA(At, 1, 1); PG8_STAGE(PG8_SA(1, 0), a3, voffA);
            PG8_BAR; PG8_WAIT_L(0); PG8_MMA(1, 0, At, B0); PG8_BAR; PG8_SCHED;
            PG8_STAGE(PG8_SB(1, 1), b3 + hstep, voffB);
            PG8_WAIT_V(6); PG8_BAR; PG8_MMA(1, 1, At, B1); PG8_BAR;
            }
        }
        if constexpr (ALIGN_EPI) { if (wr == 0) PG8_BAR; }
        if constexpr (!Epi::AFTER_DRAIN) { E(acc, cur, wr, wc, fr, fq); S.done(cur); }
        if (!has_next) break;
#pragma unroll
        for (int a = 0; a < 2; ++a)
#pragma unroll
            for (int b = 0; b < 2; ++b)
#pragma unroll
                for (int m = 0; m < 4; ++m)
#pragma unroll
                    for (int n = 0; n < 2; ++n) acc[a][b][m][n] = (f32x4){0.f, 0.f, 0.f, 0.f};
        cur = nxt; cA = nA; cB = nB; ++ui;
        if constexpr (ALIGN_EPI) { if (wr == 1) PG8_BAR; }
    }
    PG8_WAIT_V(0);
    if constexpr (!ALIGN_EPI) { if (wr == 0) PG8_BAR; }
    PG8_BAR;
    if constexpr (Epi::AFTER_DRAIN) { E.fused(acc, cur, wr, wc, fr, fq, lds, wid, lane); S.done(cur); }
#undef PG8_SA
#undef PG8_SB
#undef PG8_STAGE
#undef PG8_LDA
#undef PG8_LDB
#undef PG8_MMA
#undef PG8_WAIT_V
#undef PG8_WAIT_L
#undef PG8_BAR
#undef PG8_SCHED
}
}
#define GAS __attribute__((address_space(1)))
#define LAS __attribute__((address_space(3)))
typedef unsigned short bf16;
typedef unsigned v4u __attribute__((ext_vector_type(4)));
typedef unsigned v2u __attribute__((ext_vector_type(2)));
typedef float f32x4 __attribute__((ext_vector_type(4)));
typedef short bf16x8 __attribute__((ext_vector_type(8)));
#ifndef REP_HG
#define REP_HG 1
#endif
#ifndef REP_RW
#define REP_RW 1
#endif
#ifndef REP_UP
#define REP_UP 1
#endif
#ifndef REP_ATT
#define REP_ATT 1
#endif
#ifndef REP_PRO
#define REP_PRO 1
#endif
#ifndef REP_G1
#define REP_G1 1
#endif
#ifndef REP_G2
#define REP_G2 1
#endif
#ifndef REP_SC
#define REP_SC 1
#endif
#ifndef REP_DN
#define REP_DN 1
#endif
#ifndef REP_OUT
#define REP_OUT 1
#endif
#ifndef REP_HGL
#define REP_HGL 1
#endif
#ifndef REP_IN
#define REP_IN 1
#endif
#ifndef REP_SYNC
#define REP_SYNC 1
#endif
#define GRID_SYNC() do { for (int r_ = 0; r_ < REP_SYNC; ++r_) xcd_barrier(xbar); } while (0)
constexpr int NWAVES = 8, NTHR = 512;
constexpr int M = 32768, D = 1024, SEQ = 8192, FF = 4096;
constexpr size_t MiB = 1u << 20;
constexpr size_t WS_BAR = 64 * 1024, WS_BAR_BYTES = 16 * 1024;
constexpr size_t WS_LBK = 0;
constexpr size_t WS_RS = 1 * MiB;
constexpr size_t WS_WA = 4 * MiB, WS_WB = 18 * MiB, WS_WO = 20 * MiB, WS_WUP = 22 * MiB, WS_WDN = 30 * MiB;
constexpr size_t WS_HB = 38 * MiB;
constexpr size_t WS_BIG = 102 * MiB;
constexpr size_t SLOT = 64 * MiB;
constexpr size_t WS_END = 512 * MiB;
constexpr int LDS_BYTES = 163840;
constexpr float LOG2E_F = 1.4426950408889634f;

#define LDS_WAIT() asm volatile("s_waitcnt lgkmcnt(0)" ::: "memory")
typedef float f32x2_t __attribute__((ext_vector_type(2))); typedef __bf16 bf16x2_t __attribute__((ext_vector_type(2)));
__device__ __forceinline__ unsigned pk2(float lo, float hi) { const f32x2_t v = {lo, hi}; const bf16x2_t b = __builtin_convertvector(v, bf16x2_t); return __builtin_bit_cast(unsigned, b); }
__device__ __forceinline__ unsigned f2bf(float f) { return pk2(f, 0.f) & 0xffffu; }
__device__ __forceinline__ float bflo(unsigned u) { return __builtin_bit_cast(float, u << 16); }
__device__ __forceinline__ float bfhi(unsigned u) { return __builtin_bit_cast(float, u & 0xffff0000u); }
__device__ __forceinline__ float bf1(unsigned short b) { return __builtin_bit_cast(float, (unsigned)b << 16); }
__device__ __forceinline__ f32x4 bf4(v2u u) { return (f32x4){bflo(u.x), bfhi(u.x), bflo(u.y), bfhi(u.y)}; }
__device__ __forceinline__ float wave_sum(float v) {
#pragma unroll
    for (int o = 1; o < 64; o <<= 1) v += __shfl_xor(v, o);
    return v;
}
template <int CTRL> __device__ __forceinline__ float dpp_f(float x) { return __builtin_bit_cast(float, __builtin_amdgcn_update_dpp(0, __builtin_bit_cast(int, x), CTRL, 0xf, 0xf, true)); }
__device__ __forceinline__ float row16_sum(float x) { x += dpp_f<0xB1>(x); x += dpp_f<0x4E>(x); x += dpp_f<0x141>(x); x += dpp_f<0x140>(x); return x; }

__device__ __forceinline__ void wt_item(const float* W, int K, int N, bf16* WT, int ld, int row_off, int col_off, const float* sc, LAS float* scr, int item, int lane) {
    const int nblk = N / 32, kb = item / nblk, nb = item % nblk, k0 = 64 * kb, n0 = 32 * nb;
    f32x4 wv[8]; float sv[8];
#pragma unroll
    for (int i = 0; i < 8; ++i) { const int kk = 8 * i + (lane >> 3); wv[i] = *(const f32x4*)(W + (size_t)(k0 + kk) * N + n0 + 4 * (lane & 7)); sv[i] = sc ? sc[k0 + kk] : 1.f; }
#pragma unroll
    for (int i = 0; i < 8; ++i) { const int kk = 8 * i + (lane >> 3); LAS float* d = scr + kk * 33 + 4 * (lane & 7); d[0] = wv[i][0] * sv[i]; d[1] = wv[i][1] * sv[i]; d[2] = wv[i][2] * sv[i]; d[3] = wv[i][3] * sv[i]; }
    LDS_WAIT(); asm volatile("" ::: "memory");
    const int c = lane & 7;
#pragma unroll
    for (int j = 0; j < 4; ++j) { const int n = (lane >> 3) + 8 * j; const LAS float* s = scr + (8 * c) * 33 + n;
        v4u o; o.x = pk2(s[0 * 33], s[1 * 33]); o.y = pk2(s[2 * 33], s[3 * 33]); o.z = pk2(s[4 * 33], s[5 * 33]); o.w = pk2(s[6 * 33], s[7 * 33]);
        *(v4u*)(WT + (size_t)(row_off + n0 + n) * ld + col_off + k0 + 8 * c) = o; }
    LDS_WAIT(); asm volatile("" ::: "memory");
}
__device__ __forceinline__ void conv_mat(const float* W, int K, int N, bf16* WT, int ld, int row_off, int col_off, const float* sc, LAS float* scr, int gw, int ngw, int lane) {
    const int nitems = (K / 64) * (N / 32);
    for (int it = gw; it < nitems; it += ngw) wt_item(W, K, N, WT, ld, row_off, col_off, sc, scr, it, lane);
}

__device__ __forceinline__ void attn_phase(const bf16* Q, const bf16* K, const bf16* V, bf16* O, int gw, int ngw, int lane) {
    const int fr = lane & 15, fq = lane >> 4;
    for (int unit = gw; unit < (M / 16) * 16; unit += ngw) {
        const int qt = unit & 511, bh = unit >> 9, h = bh & 15, b = bh >> 4;
        const int t0 = qt * 16; const size_t rowb = (size_t)b * SEQ;
        const bf16* qp = Q + (rowb + t0 + fr) * 1024 + h * 64 + fq * 8;
        const bf16x8 qb0 = *(const bf16x8*)(qp), qb1 = *(const bf16x8*)(qp + 32);
        f32x4 o[4];
#pragma unroll
        for (int dt = 0; dt < 4; ++dt) o[dt] = (f32x4){0.f, 0.f, 0.f, 0.f};
        float carry = 1.f;
        const int tq = t0 + fr;
        bf16x8 kn0, kn1; unsigned short vn[4][4];
#define ATT_LOAD(SH) { int sk_ = (SH) - fr; sk_ = sk_ < 0 ? 0 : sk_; const bf16* kp_ = K + (rowb + sk_) * 1024 + h * 64 + fq * 8; kn0 = *(const bf16x8*)(kp_); kn1 = *(const bf16x8*)(kp_ + 32); \
            _Pragma("unroll") for (int j = 0; j < 4; ++j) { int sv_ = (SH) - (4 * fq + j); sv_ = sv_ < 0 ? 0 : sv_; const bf16* vp_ = V + (rowb + sv_) * 1024 + h * 64 + fr; \
                _Pragma("unroll") for (int dt = 0; dt < 4; ++dt) vn[dt][j] = vp_[16 * dt]; } }
        ATT_LOAD(t0 + 14)
        for (int s_hi = t0 + 14; s_hi >= 0; s_hi -= 16) {
            const bf16x8 ka0 = kn0, ka1 = kn1;
            unsigned short vv[4][4];
#pragma unroll
            for (int j = 0; j < 4; ++j)
#pragma unroll
                for (int dt = 0; dt < 4; ++dt) vv[dt][j] = vn[dt][j];
            ATT_LOAD(s_hi - 16)
            f32x4 z = (f32x4){0.f, 0.f, 0.f, 0.f};
            z = __builtin_amdgcn_mfma_f32_16x16x32_bf16(ka0, qb0, z, 0, 0, 0);
            z = __builtin_amdgcn_mfma_f32_16x16x32_bf16(ka1, qb1, z, 0, 0, 0);
            float dd[4], sg[4];
#pragma unroll
            for (int i = 0; i < 4; ++i) {
                const int s = s_hi - (4 * fq + i);
                const bool valid = (s >= 0) && (s < tq);
                const float e = __builtin_amdgcn_exp2f(fminf(z[i], 100.f));
                const float d = __builtin_amdgcn_rcpf(1.0f + e);
                dd[i] = valid ? d : 1.f; sg[i] = valid ? e * d : 0.f;
            }
            const float c1 = dd[0], c2 = c1 * dd[1], c3 = c2 * dd[2], g = c3 * dd[3];
            const float g0 = __shfl(g, fr), g1 = __shfl(g, fr + 16), g2 = __shfl(g, fr + 32), g3 = __shfl(g, fr + 48);
            float pre = carry;
            if (fq > 0) pre *= g0;
            if (fq > 1) pre *= g1;
            if (fq > 2) pre *= g2;
            carry = carry * ((g0 * g1) * (g2 * g3));
            const float p0 = sg[0] * pre, p1 = sg[1] * (pre * c1), p2 = sg[2] * (pre * c2), p3 = sg[3] * (pre * c3);
            bf16x8 pb; { const unsigned w0 = pk2(p0, p1), w1 = pk2(p2, p3); pb[0] = (short)(w0 & 0xffff); pb[1] = (short)(w0 >> 16); pb[2] = (short)(w1 & 0xffff); pb[3] = (short)(w1 >> 16); pb[4] = 0; pb[5] = 0; pb[6] = 0; pb[7] = 0; }
#pragma unroll
            for (int dt = 0; dt < 4; ++dt) {
                bf16x8 va; va[0] = (short)vv[dt][0]; va[1] = (short)vv[dt][1]; va[2] = (short)vv[dt][2]; va[3] = (short)vv[dt][3]; va[4] = 0; va[5] = 0; va[6] = 0; va[7] = 0;
                o[dt] = __builtin_amdgcn_mfma_f32_16x16x32_bf16(va, pb, o[dt], 0, 0, 0);
            }
            if (__builtin_amdgcn_ballot_w64(carry != 0.f) == 0ull) break;
        }
#undef ATT_LOAD
        bf16* op = O + (rowb + t0 + fr) * 1024 + h * 64 + fq * 4;
#pragma unroll
        for (int dt = 0; dt < 4; ++dt) { v2u w; w.x = pk2(o[dt][0], o[dt][1]); w.y = pk2(o[dt][2], o[dt][3]); *(v2u*)(op + 16 * dt) = w; }
    }
}

typedef unsigned u32x4_t __attribute__((ext_vector_type(4)));
__device__ __forceinline__ bf16x8 mk8(unsigned a, unsigned b, unsigned c, unsigned d) { const u32x4_t t = {a, b, c, d}; return __builtin_bit_cast(bf16x8, t); }
__device__ __forceinline__ void hg_prep_item(bf16* QS, bf16* KF, bf16* KT, float* DB, int chunk, int c) {
    {
        const size_t base = (size_t)chunk * 16 * 1024 + c;
        v2u kin[16], qin[16];
#pragma unroll
        for (int t = 0; t < 16; ++t) { kin[t] = *(const v2u*)(KF + base + (size_t)t * 1024); qin[t] = *(const v2u*)(QS + base + (size_t)t * 1024); }
        float b[4] = {0.f, 0.f, 0.f, 0.f};
        unsigned ktp[4][8];
#pragma unroll
        for (int t2 = 0; t2 < 8; ++t2) {
            float kt2[2][4];
#pragma unroll
            for (int u = 0; u < 2; ++u) {
                const int t = 2 * t2 + u;
                const f32x4 kf = bf4(kin[t]), q = bf4(qin[t]);
                float qt[4];
#pragma unroll
                for (int j = 0; j < 4; ++j) {
                    const float fdec = fmaxf(1.0f - kf[j], 1e-4f);
                    b[j] += __builtin_amdgcn_logf(fdec);
                    const float e = __builtin_amdgcn_exp2f(b[j]);
                    qt[j] = q[j] * e; kt2[u][j] = kf[j] * __builtin_amdgcn_rcpf(e);
                }
                v2u qo; qo.x = pk2(qt[0], qt[1]); qo.y = pk2(qt[2], qt[3]); *(v2u*)(QS + base + (size_t)t * 1024) = qo;
                v2u ko; ko.x = pk2(kt2[u][0], kt2[u][1]); ko.y = pk2(kt2[u][2], kt2[u][3]); *(v2u*)(KF + base + (size_t)t * 1024) = ko;
            }
#pragma unroll
            for (int j = 0; j < 4; ++j) ktp[j][t2] = pk2(kt2[0][j], kt2[1][j]);
        }
        f32x4 dv; dv[0] = __builtin_amdgcn_exp2f(b[0]); dv[1] = __builtin_amdgcn_exp2f(b[1]); dv[2] = __builtin_amdgcn_exp2f(b[2]); dv[3] = __builtin_amdgcn_exp2f(b[3]);
        *(f32x4*)(DB + (size_t)chunk * 1024 + c) = dv;
#pragma unroll
        for (int j = 0; j < 4; ++j) { v4u* kp = (v4u*)(KT + ((size_t)chunk * 1024 + c + j) * 16);
            kp[0] = (v4u){ktp[j][0], ktp[j][1], ktp[j][2], ktp[j][3]}; kp[1] = (v4u){ktp[j][4], ktp[j][5], ktp[j][6], ktp[j][7]}; }
    }
}
__device__ __forceinline__ void hg_local(bf16* QS, bf16* KF, bf16* KT, const bf16* IV, float* DB, float* SL, float* DT) {
    int tid_ = threadIdx.x; asm volatile("" : "+v"(tid_)); const int tid = tid_, lane = tid & 63, w = __builtin_amdgcn_readfirstlane(tid >> 6), fr = lane & 15, fq = lane >> 4;
    for (int unit = blockIdx.x; unit < 256; unit += gridDim.x) {
        const int seg = unit & 7, bh = unit >> 3, h = bh & 7, b = bh >> 3;
#pragma unroll 1
        for (int ps = 0; ps < 4; ++ps) hg_prep_item(QS, KF, KT, DB, (int)((((size_t)b * SEQ + (size_t)seg * 1024) >> 4) + 16 * ps + 2 * w + (lane >> 5)), 128 * h + 4 * (lane & 31));
        asm volatile("s_waitcnt vmcnt(0)" ::: "memory"); __syncthreads();
        if (seg == 7) continue;
        f32x4 S[8], DTt[8];
#pragma unroll
        for (int kt = 0; kt < 8; ++kt) { S[kt] = (f32x4){0.f, 0.f, 0.f, 0.f}; DTt[kt] = (f32x4){1.f, 1.f, 1.f, 1.f}; }
        const size_t m0 = (size_t)b * SEQ + (size_t)seg * 1024;
        v2u kt1[8], kt2[8]; f32x4 d1[8], d2[8]; unsigned short v1_[4], v2_[4];
#define HGL_LOAD(KTV, DV, VV, CJ) { const int cj_ = (CJ) < 64 ? (CJ) : 63; const size_t chunk_ = (m0 >> 4) + cj_, mrow_ = m0 + 16 * cj_; \
          _Pragma("unroll") for (int kt = 0; kt < 8; ++kt) { KTV[kt] = *(const v2u*)(KT + (chunk_ * 1024 + 128 * h + 16 * kt + fr) * 16 + 4 * fq); DV[kt] = *(const f32x4*)(DB + chunk_ * 1024 + 128 * h + 16 * kt + 4 * fq); } \
          const bf16* vp_ = IV + (mrow_ + 4 * fq) * 1024 + 128 * h + 16 * w + fr; VV[0] = vp_[0]; VV[1] = vp_[1024]; VV[2] = vp_[2048]; VV[3] = vp_[3072]; }
        HGL_LOAD(kt1, d1, v1_, 0) HGL_LOAD(kt2, d2, v2_, 1)
        for (int ci = 0; ci < 64; ++ci) {
            v2u ktv[8]; f32x4 dv[8];
#pragma unroll
            for (int kt = 0; kt < 8; ++kt) { ktv[kt] = kt1[kt]; dv[kt] = d1[kt]; kt1[kt] = kt2[kt]; d1[kt] = d2[kt]; }
            const unsigned v0 = v1_[0], v1 = v1_[1], v2 = v1_[2], v3 = v1_[3];
#pragma unroll
            for (int x = 0; x < 4; ++x) v1_[x] = v2_[x];
            HGL_LOAD(kt2, d2, v2_, ci + 2)
            const bf16x8 vb = mk8(v0 | (v1 << 16), v2 | (v3 << 16), 0u, 0u);
#pragma unroll
            for (int kt = 0; kt < 8; ++kt) { S[kt] = __builtin_amdgcn_mfma_f32_16x16x32_bf16(mk8(ktv[kt].x, ktv[kt].y, 0u, 0u), vb, S[kt], 0, 0, 0); S[kt] = S[kt] * dv[kt]; DTt[kt] = DTt[kt] * dv[kt]; }
        }
#undef HGL_LOAD
#pragma unroll
        for (int kt = 0; kt < 8; ++kt) {
#pragma unroll
            for (int i = 0; i < 4; ++i) SL[((size_t)(bh * 8 + seg) * 128 + 16 * kt + 4 * fq + i) * 128 + 16 * w + fr] = S[kt][i];
            if (w == 0 && fr == 0) *(f32x4*)(DT + (size_t)(bh * 8 + seg) * 128 + 16 * kt + 4 * fq) = DTt[kt];
        }
    }
}
__device__ __forceinline__ void hg_out(const bf16* QT, const bf16* KTL, const bf16* KT, const bf16* IV, const float* DB, const float* SL, const float* DT, const float* norm_g, bf16* SGO, LAS unsigned char* lds) {
    int tid_ = threadIdx.x; asm volatile("" : "+v"(tid_)); const int tid = tid_, lane = tid & 63, w = __builtin_amdgcn_readfirstlane(tid >> 6), fr = lane & 15, fq = lane >> 4;
    LAS float* ssb = (LAS float*)lds;
    for (int unit = blockIdx.x; unit < 256; unit += gridDim.x) {
        const int seg = unit & 7, bh = unit >> 3, h = bh & 7, b = bh >> 3;
        f32x4 S[8];
#pragma unroll
        for (int kt = 0; kt < 8; ++kt) S[kt] = (f32x4){0.f, 0.f, 0.f, 0.f};
        for (int j = 0; j < seg; ++j) {
#pragma unroll
            for (int kt = 0; kt < 8; ++kt) {
                const f32x4 dt = *(const f32x4*)(DT + (size_t)(bh * 8 + j) * 128 + 16 * kt + 4 * fq);
#pragma unroll
                for (int i = 0; i < 4; ++i) S[kt][i] = S[kt][i] * dt[i] + SL[((size_t)(bh * 8 + j) * 128 + 16 * kt + 4 * fq + i) * 128 + 16 * w + fr];
            }
        }
        const float ng = norm_g[128 * h + 16 * w + fr];
        const size_t m0 = (size_t)b * SEQ + (size_t)seg * 1024;
        v2u qn[8], kn[8];
        { const bf16* qp = QT + (m0 + fr) * 1024 + 128 * h + 4 * fq; const bf16* kp = KTL + (m0 + fr) * 1024 + 128 * h + 4 * fq;
#pragma unroll
          for (int x = 0; x < 8; ++x) { qn[x] = *(const v2u*)(qp + 16 * x); kn[x] = *(const v2u*)(kp + 16 * x); } }
        unsigned short vn[4], gn[4];
        { const bf16* vp = IV + (m0 + 4 * fq) * 1024 + 128 * h + 16 * w + fr; const bf16* gq = SGO + (m0 + 4 * fq) * 1024 + 128 * h + 16 * w + fr;
          vn[0] = vp[0]; vn[1] = vp[1024]; vn[2] = vp[2048]; vn[3] = vp[3072]; gn[0] = gq[0]; gn[1] = gq[1024]; gn[2] = gq[2048]; gn[3] = gq[3072]; }
        for (int ci = 0; ci < 64; ++ci) {
            const size_t chunk = (m0 >> 4) + ci, mrow = m0 + 16 * ci;
            v2u ktv[8]; f32x4 dv[8];
#pragma unroll
            for (int kt = 0; kt < 8; ++kt) { ktv[kt] = *(const v2u*)(KT + (chunk * 1024 + 128 * h + 16 * kt + fr) * 16 + 4 * fq); dv[kt] = *(const f32x4*)(DB + chunk * 1024 + 128 * h + 16 * kt + 4 * fq); }
            const unsigned v0 = vn[0], v1 = vn[1], v2 = vn[2], v3 = vn[3];
            bf16* gp = SGO + (mrow + 4 * fq) * 1024 + 128 * h + 16 * w + fr;
            const float sg0 = bf1(gn[0]), sg1 = bf1(gn[1]), sg2 = bf1(gn[2]), sg3 = bf1(gn[3]);
            { const size_t mn = m0 + 16 * (ci + 1 < 64 ? ci + 1 : ci); const bf16* vp = IV + (mn + 4 * fq) * 1024 + 128 * h + 16 * w + fr; const bf16* gq = SGO + (mn + 4 * fq) * 1024 + 128 * h + 16 * w + fr;
              if (ci + 1 < 64) { vn[0] = vp[0]; vn[1] = vp[1024]; vn[2] = vp[2048]; vn[3] = vp[3072]; gn[0] = gq[0]; gn[1] = gq[1024]; gn[2] = gq[2048]; gn[3] = gq[3072]; } }
            v2u qc[8], kc[8];
#pragma unroll
            for (int x = 0; x < 8; ++x) { qc[x] = qn[x]; kc[x] = kn[x]; }
            { const size_t mn = m0 + 16 * (ci + 1 < 64 ? ci + 1 : ci); const bf16* qp = QT + (mn + fr) * 1024 + 128 * h + 4 * fq; const bf16* kp = KTL + (mn + fr) * 1024 + 128 * h + 4 * fq;
#pragma unroll
              for (int x = 0; x < 8; ++x) { qn[x] = *(const v2u*)(qp + 16 * x); kn[x] = *(const v2u*)(kp + 16 * x); } }
            const bf16x8 vb = mk8(v0 | (v1 << 16), v2 | (v3 << 16), 0u, 0u);
            f32x4 pt = (f32x4){0.f, 0.f, 0.f, 0.f};
#pragma unroll
            for (int p = 0; p < 4; ++p) pt = __builtin_amdgcn_mfma_f32_16x16x32_bf16(mk8(kc[2 * p].x, kc[2 * p].y, kc[2 * p + 1].x, kc[2 * p + 1].y), mk8(qc[2 * p].x, qc[2 * p].y, qc[2 * p + 1].x, qc[2 * p + 1].y), pt, 0, 0, 0);
#pragma unroll
            for (int i = 0; i < 4; ++i) if (4 * fq + i > fr) pt[i] = 0.f;
            f32x4 o = (f32x4){0.f, 0.f, 0.f, 0.f};
#pragma unroll
            for (int p = 0; p < 4; ++p) {
                const bf16x8 sb = mk8(pk2(S[2 * p][0], S[2 * p][1]), pk2(S[2 * p][2], S[2 * p][3]), pk2(S[2 * p + 1][0], S[2 * p + 1][1]), pk2(S[2 * p + 1][2], S[2 * p + 1][3]));
                o = __builtin_amdgcn_mfma_f32_16x16x32_bf16(mk8(qc[2 * p].x, qc[2 * p].y, qc[2 * p + 1].x, qc[2 * p + 1].y), sb, o, 0, 0, 0);
            }
            o = __builtin_amdgcn_mfma_f32_16x16x32_bf16(mk8(pk2(pt[0], pt[1]), pk2(pt[2], pt[3]), 0u, 0u), vb, o, 0, 0, 0);
#pragma unroll
            for (int kt = 0; kt < 8; ++kt) { S[kt] = __builtin_amdgcn_mfma_f32_16x16x32_bf16(mk8(ktv[kt].x, ktv[kt].y, 0u, 0u), vb, S[kt], 0, 0, 0); S[kt] = S[kt] * dv[kt]; }
            LAS float* sb_ = ssb + (ci & 1) * 128;
#pragma unroll
            for (int i = 0; i < 4; ++i) { const float ss = row16_sum(o[i] * o[i]); if (fr == 0) sb_[(4 * fq + i) * 8 + w] = ss; }
            __syncthreads();
            const float sgv[4] = {sg0, sg1, sg2, sg3};
#pragma unroll
            for (int i = 0; i < 4; ++i) {
                const f32x4 a0 = *(const LAS f32x4*)(sb_ + (4 * fq + i) * 8), a1 = *(const LAS f32x4*)(sb_ + (4 * fq + i) * 8 + 4);
                const float tot = ((a0[0] + a0[1]) + (a0[2] + a0[3])) + ((a1[0] + a1[1]) + (a1[2] + a1[3]));
                const float r = 1.0f / sqrtf(tot * (1.0f / 128.0f) + 1e-6f);
                gp[(size_t)i * 1024] = (bf16)f2bf(o[i] * r * ng * sgv[i]);
            }
        }
        __syncthreads();
    }
}

__device__ __forceinline__ void rw_prep(const float* h, const float* rs, const float* g, bf16* A2, int gw, int ngw, int lane) {
    for (int it = gw; it < M / 2; it += ngw) {
        const int m = 2 * it, t = m & (SEQ - 1);
        const int mp = t ? m - 1 : m;
        f32x4 x[3][4], pr[3];
#pragma unroll
        for (int u = 0; u < 3; ++u) { const int mm = u == 0 ? mp : m + u - 1; pr[u] = *(const f32x4*)(rs + (size_t)mm * 16 + 4 * (lane & 3));
#pragma unroll
            for (int j = 0; j < 4; ++j) x[u][j] = *(const f32x4*)(h + (size_t)mm * 1024 + 4 * lane + 256 * j); }
        float r3[3];
#pragma unroll
        for (int u = 0; u < 3; ++u) { float s = (pr[u][0] + pr[u][1]) + (pr[u][2] + pr[u][3]); s += dpp_f<0xB1>(s); s += dpp_f<0x4E>(s); r3[u] = 1.0f / sqrtf(s * (1.0f / 1024.0f) + 1e-6f); }
        if (t == 0) r3[0] = 0.f;
#pragma unroll
        for (int j = 0; j < 4; ++j) {
            const int c = 4 * lane + 256 * j;
            const f32x4 gc = *(const f32x4*)(g + c);
            const f32x4 xp = x[0][j] * gc * r3[0], x0 = x[1][j] * gc * r3[1], x1 = x[2][j] * gc * r3[2];
            const f32x4 d0 = xp - x0, d1 = x0 - x1;
            v2u o;
            o.x = pk2(x0[0], x0[1]); o.y = pk2(x0[2], x0[3]); *(v2u*)(A2 + (size_t)m * 2048 + c) = o;
            o.x = pk2(d0[0], d0[1]); o.y = pk2(d0[2], d0[3]); *(v2u*)(A2 + (size_t)m * 2048 + 1024 + c) = o;
            o.x = pk2(x1[0], x1[1]); o.y = pk2(x1[2], x1[3]); *(v2u*)(A2 + (size_t)(m + 1) * 2048 + c) = o;
            o.x = pk2(d1[0], d1[1]); o.y = pk2(d1[2], d1[3]); *(v2u*)(A2 + (size_t)(m + 1) * 2048 + 1024 + c) = o;
        }
    }
}
constexpr int RWS_AH = 0, RWS_RB = 2048, RWS_KGT = 4096, RWS_BGT = 6144, RWS_G15 = 8192, RWS_KNI = 8448, RWS_WVI = 9472, RWS_VCI = 10496, RWS_SLOT = 11264;
constexpr int RWT_AB = 0, RWT_BT = 2048, RWT_KT = 4096, RWT_ABT = 6144, RWT_NM = 0  , RWT_TM = 2048  , RWT_BYTES = 8192;
__device__ __forceinline__ int rwz(int k) { return (k & ~7) | ((k & 7) ^ ((k >> 3) & 7)); }
constexpr int RW_NSLOT = 9, RW_NPROD = 7, RW_RING = RW_NSLOT * RWS_SLOT, RW_FLAGS = RW_RING + RW_NPROD * RWT_BYTES;
struct RwRaw4 { v2u r[4], k[4], wm[4], a[4]; unsigned short v[4]; };
__device__ __forceinline__ void rw_load4(RwRaw4& x, const bf16* R, const bf16* K, const bf16* V, const bf16* WM, const bf16* A, size_t m, int ch, int vch) {
#pragma unroll
    for (int j = 0; j < 4; ++j) { const size_t off = (m + j) * 1024 + ch;
        x.r[j] = *(const v2u*)(R + off); x.k[j] = *(const v2u*)(K + off); x.wm[j] = *(const v2u*)(WM + off); x.a[j] = *(const v2u*)(A + off); x.v[j] = V[(m + j) * 1024 + vch]; }
}
__device__ __forceinline__ bf16x8 lds_op16(const LAS unsigned char* mtx, int row, int kbyte) { return *(const LAS bf16x8*)(mtx + row * 128 + kbyte); }
__device__ __forceinline__ v2u lds_8(const LAS unsigned char* p) { return *(const LAS v2u*)p; }
__device__ __forceinline__ void rw_scan(const bf16* R, const bf16* K, const bf16* V, const bf16* WM, const bf16* A, const float* k_k, const float* k_a, bf16* Y, LAS unsigned char* lds) {
    int tid_ = threadIdx.x; asm volatile("" : "+v"(tid_)); const int tid = tid_, lane = tid & 63, w = __builtin_amdgcn_readfirstlane(tid >> 6);
    const int fr = lane & 15, fq = lane >> 4;
    constexpr int NCH = SEQ / 16;
    for (int unit = blockIdx.x; unit < 256; unit += gridDim.x) {
        const int rg = unit & 3, h = (unit >> 2) & 15, b = unit >> 6;
        const size_t row0 = (size_t)b * SEQ;
        volatile LAS unsigned* flg = (volatile LAS unsigned*)(lds + RW_FLAGS);
        if (tid < 16) flg[tid] = 0u;
        __syncthreads();
        if (w >= 1) {
            const int pw = w - 1, ch = 64 * h + 4 * fr, vch = 64 * h + 16 * rg + fr;
            LAS unsigned char* tmp = lds + RW_RING + pw * RWT_BYTES;
            const f32x4 kkc = *(const f32x4*)(k_k + ch), kac = *(const f32x4*)(k_a + ch);
            RwRaw4 nx; rw_load4(nx, R, K, V, WM, A, row0 + 16 * pw + 4 * fq, ch, vch);
            for (int cj = pw; cj < NCH; cj += RW_NPROD) {
                {
                    const RwRaw4 cu = nx;
                    { const int cn = cj + RW_NPROD < NCH ? cj + RW_NPROD : cj; rw_load4(nx, R, K, V, WM, A, row0 + 16 * (size_t)cn + 4 * fq, ch, vch); }
                    while ((int)flg[RW_NSLOT] < cj - (RW_NSLOT - 1)) __builtin_amdgcn_s_sleep(2);
                    asm volatile("" ::: "memory");
                    LAS unsigned char* slot = lds + (cj % RW_NSLOT) * RWS_SLOT;
                    f32x4 wv[4], kk[4], km[4], be[4], rr[4];
#pragma unroll
                    for (int j = 0; j < 4; ++j) {
                        const f32x4 r = bf4(cu.r[j]), k = bf4(cu.k[j]), wm = bf4(cu.wm[j]), a = bf4(cu.a[j]);
                        const f32x4 kr = k * kkc;
                        const float n2 = row16_sum((kr[0] * kr[0] + kr[1] * kr[1]) + (kr[2] * kr[2] + kr[3] * kr[3]));
                        const float inv = 1.0f / fmaxf(sqrtf(n2), 1e-12f);
                        kk[j] = kr * inv; be[j] = kk[j] * a; km[j] = k * (1.0f + (a - 1.0f) * kac); wv[j] = 1.0f - wm; rr[j] = r;
                    }
                    f32x4 g[4]; g[0] = wv[0]; g[1] = g[0] * wv[1]; g[2] = g[1] * wv[2]; g[3] = g[2] * wv[3];
                    f32x4 pre = (f32x4){1.f, 1.f, 1.f, 1.f}, all = (f32x4){1.f, 1.f, 1.f, 1.f};
#pragma unroll
                    for (int x = 0; x < 4; ++x) {
                        const float t0 = __shfl(g[3][x], fr), t1 = __shfl(g[3][x], 16 + fr), t2 = __shfl(g[3][x], 32 + fr), t3 = __shfl(g[3][x], 48 + fr);
                        float p = 1.f; if (fq > 0) p *= t0; if (fq > 1) p *= t1; if (fq > 2) p *= t2;
                        pre[x] = p; all[x] = (t0 * t1) * (t2 * t3);
                    }
                    unsigned kgp[4][2], bgp[4][2], abp[4][2];
                    float kgt[4][4], bgt[4][4], abt[4][4];
#pragma unroll
                    for (int j = 0; j < 4; ++j) {
                        const f32x4 Gs = pre * g[j], Gm = j ? pre * g[j - 1] : pre;
                        f32x4 ginv; ginv[0] = __builtin_amdgcn_rcpf(Gs[0]); ginv[1] = __builtin_amdgcn_rcpf(Gs[1]); ginv[2] = __builtin_amdgcn_rcpf(Gs[2]); ginv[3] = __builtin_amdgcn_rcpf(Gs[3]);
                        const f32x4 alb = kk[j] * Gm, rb = rr[j] * Gs, bet = be[j] * ginv, ktl = km[j] * ginv;
                        const int s = 4 * fq + j;
                        v2u o;
                        o.x = pk2(alb[0], alb[1]); o.y = pk2(alb[2], alb[3]); *(LAS v2u*)(tmp + RWT_AB + s * 128 + 8 * fr) = o;
                        o.x = pk2(bet[0], bet[1]); o.y = pk2(bet[2], bet[3]); *(LAS v2u*)(tmp + RWT_BT + s * 128 + 8 * fr) = o;
                        o.x = pk2(ktl[0], ktl[1]); o.y = pk2(ktl[2], ktl[3]); *(LAS v2u*)(tmp + RWT_KT + s * 128 + 8 * fr) = o;
                        o.x = pk2(rb[0], rb[1]); o.y = pk2(rb[2], rb[3]); *(LAS v2u*)(slot + RWS_RB + s * 128 + 8 * fr) = o;
#pragma unroll
                        for (int x = 0; x < 4; ++x) { kgt[x][j] = ktl[x] * all[x]; bgt[x][j] = -(bet[x] * all[x]); abt[x][j] = alb[x]; }
                    }
#pragma unroll
                    for (int x = 0; x < 4; ++x) {
                        const int kch = 4 * fr + x;
                        v2u o;
                        o.x = pk2(kgt[x][0], kgt[x][1]); o.y = pk2(kgt[x][2], kgt[x][3]); *(LAS v2u*)(slot + RWS_KGT + rwz(kch) * 32 + 8 * fq) = o;
                        o.x = pk2(bgt[x][0], bgt[x][1]); o.y = pk2(bgt[x][2], bgt[x][3]); *(LAS v2u*)(slot + RWS_BGT + rwz(kch) * 32 + 8 * fq) = o;
                        o.x = pk2(abt[x][0], abt[x][1]); o.y = pk2(abt[x][2], abt[x][3]); *(LAS v2u*)(tmp + RWT_ABT + rwz(kch) * 32 + 8 * fq) = o;
                    }
                    if (fq == 0) *(LAS f32x4*)(slot + RWS_G15 + 16 * fr) = all;
                    const unsigned vlo = (unsigned)cu.v[0] | ((unsigned)cu.v[1] << 16), vhi = (unsigned)cu.v[2] | ((unsigned)cu.v[3] << 16);
                    { v2u o; o.x = vlo; o.y = vhi; *(LAS v2u*)(slot + RWS_VCI + 8 * lane) = o; }
                    LDS_WAIT(); asm volatile("" ::: "memory");
                    f32x4 nac = (f32x4){0.f, 0.f, 0.f, 0.f}, kat = nac, krt = nac, nrt = nac;
#pragma unroll
                    for (int p = 0; p < 2; ++p) {
                        const int kb = (32 * p + 8 * fq) * 2;
                        const bf16x8 oAB = lds_op16(tmp + RWT_AB, fr, kb), oBT = lds_op16(tmp + RWT_BT, fr, kb), oKT = lds_op16(tmp + RWT_KT, fr, kb), oRB = lds_op16(slot + RWS_RB, fr, kb);
                        nac = __builtin_amdgcn_mfma_f32_16x16x32_bf16(oBT, oAB, nac, 0, 0, 0);
                        kat = __builtin_amdgcn_mfma_f32_16x16x32_bf16(oKT, oAB, kat, 0, 0, 0);
                        krt = __builtin_amdgcn_mfma_f32_16x16x32_bf16(oKT, oRB, krt, 0, 0, 0);
                        nrt = __builtin_amdgcn_mfma_f32_16x16x32_bf16(oBT, oRB, nrt, 0, 0, 0);
                    }
#pragma unroll
                    for (int i = 0; i < 4; ++i) { const int rr_ = 4 * fq + i;
                        if (rr_ >= fr) { nac[i] = 0.f; kat[i] = 0.f; }
                        if (rr_ > fr) { krt[i] = 0.f; nrt[i] = 0.f; } }
                    { u32x4_t o; o.x = pk2(krt[0], krt[1]); o.y = pk2(krt[2], krt[3]); o.z = pk2(-nrt[0], -nrt[1]); o.w = pk2(-nrt[2], -nrt[3]); *(LAS u32x4_t*)(slot + RWS_KNI + 16 * lane) = o; }
                    LDS_WAIT(); asm volatile("" ::: "memory");
                    *(LAS f32x4*)(tmp + RWT_NM + (fr * 16 + 4 * fq) * 4) = nac;
                    LDS_WAIT(); asm volatile("" ::: "memory");
                    float Tc[16];
                    f32x4 nvv[16][4];
#define RW_LD_ROWS(lo, hi) _Pragma("unroll") for (int s = lo; s <= hi; ++s) _Pragma("unroll") for (int r4 = 0; r4 < (s + 3) / 4; ++r4) nvv[s][r4] = *(const LAS f32x4*)(tmp + RWT_NM + (s * 16 + 4 * r4) * 4);
#define RW_DO_ROWS(lo, hi) _Pragma("unroll") for (int s = lo; s <= hi; ++s) { float acc_ = (s == fr) ? 1.f : 0.f; \
                        _Pragma("unroll") for (int r4 = 0; r4 < (s + 3) / 4; ++r4) _Pragma("unroll") for (int e = 0; e < 4; ++e) if (4 * r4 + e < s) acc_ -= nvv[s][r4][e] * Tc[4 * r4 + e]; \
                        Tc[s] = acc_; }
                    RW_LD_ROWS(1, 8) RW_LD_ROWS(9, 12)
                    asm volatile("" ::: "memory");
                    RW_DO_ROWS(0, 8)
                    RW_LD_ROWS(13, 15)
                    asm volatile("" ::: "memory");
                    RW_DO_ROWS(9, 12)
                    RW_DO_ROWS(13, 15)
#undef RW_LD_ROWS
#undef RW_DO_ROWS
#pragma unroll
                    for (int e = 0; e < 4; ++e) {
                        float tv = Tc[0];
#pragma unroll
                        for (int s = 0; s < 16; ++s) if (s == 4 * fq + e) tv = Tc[s];
                        *(LAS unsigned short*)(tmp + RWT_TM + ((4 * fq + e) * 16 + fr) * 2) = (unsigned short)f2bf(tv);
                    }
                    LDS_WAIT(); asm volatile("" ::: "memory");
                    const v2u tq = lds_8(tmp + RWT_TM + (fr * 16 + 4 * fq) * 2);
                    const bf16x8 opT = mk8(tq.x, tq.y, 0u, 0u);
                    f32x4 xac = __builtin_amdgcn_mfma_f32_16x16x32_bf16(mk8(pk2(kat[0], kat[1]), pk2(kat[2], kat[3]), 0u, 0u), mk8(vlo, vhi, 0u, 0u), (f32x4){0.f, 0.f, 0.f, 0.f}, 0, 0, 0);
                    const f32x4 wvv = __builtin_amdgcn_mfma_f32_16x16x32_bf16(opT, mk8(pk2(xac[0], xac[1]), pk2(xac[2], xac[3]), 0u, 0u), (f32x4){0.f, 0.f, 0.f, 0.f}, 0, 0, 0);
                    *(LAS f32x4*)(slot + RWS_WVI + 16 * lane) = wvv;
                    f32x4 aht[4];
#pragma unroll
                    for (int nt = 0; nt < 4; ++nt) {
                        const v2u ab = lds_8(tmp + RWT_ABT + rwz(16 * nt + fr) * 32 + 8 * fq);
                        aht[nt] = __builtin_amdgcn_mfma_f32_16x16x32_bf16(mk8(ab.x, ab.y, 0u, 0u), opT, (f32x4){0.f, 0.f, 0.f, 0.f}, 0, 0, 0);
                    }
#pragma unroll
                    for (int p = 0; p < 2; ++p) { u32x4_t o; o.x = pk2(aht[2 * p][0], aht[2 * p][1]); o.y = pk2(aht[2 * p][2], aht[2 * p][3]); o.z = pk2(aht[2 * p + 1][0], aht[2 * p + 1][1]); o.w = pk2(aht[2 * p + 1][2], aht[2 * p + 1][3]);
                        *(LAS u32x4_t*)(slot + RWS_AH + (p * 64 + lane) * 16) = o; }
                    LDS_WAIT(); asm volatile("" ::: "memory");
                    if (lane == 0) flg[cj % RW_NSLOT] = (unsigned)(cj + 1);
                }
            }
        } else {
            f32x4 St[4];
#pragma unroll
            for (int kt = 0; kt < 4; ++kt) St[kt] = (f32x4){0.f, 0.f, 0.f, 0.f};
            {
#pragma unroll 1
                for (int c = 0; c < NCH; ++c) {
                    const LAS unsigned char* slot = lds + (c % RW_NSLOT) * RWS_SLOT;
                    while (flg[c % RW_NSLOT] != (unsigned)(c + 1)) __builtin_amdgcn_s_sleep(1);
                    asm volatile("" ::: "memory");
                    f32x4 zt = *(const LAS f32x4*)(slot + RWS_WVI + 16 * lane);
                    f32x4 y = (f32x4){0.f, 0.f, 0.f, 0.f};
#pragma unroll
                    for (int p = 0; p < 2; ++p) {
                        const bf16x8 sb = mk8(pk2(St[2 * p][0], St[2 * p][1]), pk2(St[2 * p][2], St[2 * p][3]), pk2(St[2 * p + 1][0], St[2 * p + 1][1]), pk2(St[2 * p + 1][2], St[2 * p + 1][3]));
                        const v2u r0 = lds_8(slot + RWS_RB + fr * 128 + (32 * p + 4 * fq) * 2), r1 = lds_8(slot + RWS_RB + fr * 128 + (32 * p + 16 + 4 * fq) * 2);
                        zt = __builtin_amdgcn_mfma_f32_16x16x32_bf16(*(const LAS bf16x8*)(slot + RWS_AH + (p * 64 + lane) * 16), sb, zt, 0, 0, 0);
                        y = __builtin_amdgcn_mfma_f32_16x16x32_bf16(mk8(r0.x, r0.y, r1.x, r1.y), sb, y, 0, 0, 0);
                    }
                    const v2u vc = lds_8(slot + RWS_VCI + 8 * lane);
                    const bf16x8 b2 = mk8(vc.x, vc.y, pk2(zt[0], zt[1]), pk2(zt[2], zt[3]));
                    y = __builtin_amdgcn_mfma_f32_16x16x32_bf16(*(const LAS bf16x8*)(slot + RWS_KNI + 16 * lane), b2, y, 0, 0, 0);
#pragma unroll
                    for (int kt = 0; kt < 4; ++kt) {
                        const v2u kg = lds_8(slot + RWS_KGT + rwz(16 * kt + fr) * 32 + 8 * fq), bg = lds_8(slot + RWS_BGT + rwz(16 * kt + fr) * 32 + 8 * fq);
                        const f32x4 g15 = *(const LAS f32x4*)(slot + RWS_G15 + (16 * kt + 4 * fq) * 4);
                        St[kt] = __builtin_amdgcn_mfma_f32_16x16x32_bf16(mk8(kg.x, kg.y, bg.x, bg.y), b2, St[kt] * g15, 0, 0, 0);
                    }
                    bf16* yp = Y + (row0 + 16 * (size_t)c + 4 * fq) * 1024 + 64 * h + 16 * rg + fr;
#pragma unroll
                    for (int i = 0; i < 4; ++i) yp[(size_t)i * 1024] = (bf16)f2bf(y[i]);
                    LDS_WAIT(); asm volatile("" ::: "memory");
                    if (lane == 0) flg[RW_NSLOT] = (unsigned)(c + 1);
                }
            }
        }
        __syncthreads();
    }
}
__device__ __forceinline__ void rw_post(const bf16* Y, bf16* R, const bf16* K, const bf16* V, const bf16* A, const bf16* G, const float* k_a, const float* r_k, const float* ln_g, const float* ln_b, int gw, int ngw, int lane) {
    const int c = (gw & 3) * 256 + 4 * lane;
    const f32x4 ka = *(const f32x4*)(k_a + c), rk = *(const f32x4*)(r_k + c), lg = *(const f32x4*)(ln_g + c), lb = *(const f32x4*)(ln_b + c);
    for (int it = gw; it < M * 4; it += 2 * ngw) {
        const int it2 = (it + ngw < M * 4) ? it + ngw : it;
        const size_t off[2] = {(size_t)(it >> 2) * 1024 + c, (size_t)(it2 >> 2) * 1024 + c};
        v2u yv[2], rv[2], kv[2], vv[2], av[2], gv[2];
#pragma unroll
        for (int u = 0; u < 2; ++u) { yv[u] = *(const v2u*)(Y + off[u]); rv[u] = *(const v2u*)(R + off[u]); kv[u] = *(const v2u*)(K + off[u]); vv[u] = *(const v2u*)(V + off[u]); av[u] = *(const v2u*)(A + off[u]); gv[u] = *(const v2u*)(G + off[u]); }
#pragma unroll
        for (int u = 0; u < 2; ++u) {
            const f32x4 y = bf4(yv[u]), r = bf4(rv[u]), k = bf4(kv[u]), v = bf4(vv[u]), a = bf4(av[u]), g = bf4(gv[u]);
            const float mu = row16_sum((y[0] + y[1]) + (y[2] + y[3])) * (1.0f / 64.0f);
            const f32x4 yc = y - mu;
            const float var = row16_sum((yc[0] * yc[0] + yc[1] * yc[1]) + (yc[2] * yc[2] + yc[3] * yc[3])) * (1.0f / 64.0f);
            const float rstd = 1.0f / sqrtf(var + 64e-5f);
            const f32x4 km = k * (1.0f + (a - 1.0f) * ka);
            const f32x4 pr = r * km * rk;
            const float cs = row16_sum((pr[0] + pr[1]) + (pr[2] + pr[3]));
            const f32x4 o = (yc * rstd * lg + lb + v * cs) * g;
            v2u wv; wv.x = pk2(o[0], o[1]); wv.y = pk2(o[2], o[3]);
            if (u == 0 || it2 != it) *(v2u*)(R + off[u]) = wv;
        }
    }
}

__device__ __forceinline__ void sc_conv(const bf16* BG, const bf16* CG, const bf16* HX, const float* cw, const float* cb, bf16* O3, int gt, int ngt) {
    const int c = (gt & 127) * 8;
    float w0[8], w1[8], w2[8], bb[8];
#pragma unroll
    for (int j = 0; j < 8; ++j) { w0[j] = cw[c + j]; w1[j] = cw[1024 + c + j]; w2[j] = cw[2048 + c + j]; bb[j] = cb[c + j]; }
    for (int idx = gt; idx < M * 128; idx += 2 * ngt) {
        const int idx2 = idx + ngt < M * 128 ? idx + ngt : idx;
        v4u cv[2][3], hv[2][3], bv[2]; int tt[2]; size_t offs[2];
#pragma unroll
        for (int u = 0; u < 2; ++u) {
            const int m = (u ? idx2 : idx) >> 7; tt[u] = m & (SEQ - 1); offs[u] = (size_t)m * 1024 + c;
#pragma unroll
            for (int dt = 0; dt < 3; ++dt) { const size_t o2 = offs[u] - (size_t)((tt[u] - 2 + dt >= 0) ? (2 - dt) : 0) * 1024; cv[u][dt] = *(const v4u*)(CG + o2); hv[u][dt] = *(const v4u*)(HX + o2); }
            bv[u] = *(const v4u*)(BG + offs[u]);
        }
#pragma unroll
        for (int u = 0; u < 2; ++u) {
            float y[8];
#pragma unroll
            for (int j = 0; j < 8; ++j) y[j] = bb[j];
#pragma unroll
            for (int dt = 0; dt < 3; ++dt) {
                const float on = (tt[u] - 2 + dt >= 0) ? 1.f : 0.f;
                const float* wp = dt == 0 ? w0 : (dt == 1 ? w1 : w2);
                const v4u cq = cv[u][dt], hq = hv[u][dt];
                y[0] += on * wp[0] * (bflo(cq.x) * bflo(hq.x)); y[1] += on * wp[1] * (bfhi(cq.x) * bfhi(hq.x));
                y[2] += on * wp[2] * (bflo(cq.y) * bflo(hq.y)); y[3] += on * wp[3] * (bfhi(cq.y) * bfhi(hq.y));
                y[4] += on * wp[4] * (bflo(cq.z) * bflo(hq.z)); y[5] += on * wp[5] * (bfhi(cq.z) * bfhi(hq.z));
                y[6] += on * wp[6] * (bflo(cq.w) * bflo(hq.w)); y[7] += on * wp[7] * (bfhi(cq.w) * bfhi(hq.w));
            }
            const v4u bq = bv[u];
            v4u w; w.x = pk2(y[0] * bflo(bq.x), y[1] * bfhi(bq.x)); w.y = pk2(y[2] * bflo(bq.y), y[3] * bfhi(bq.y)); w.z = pk2(y[4] * bflo(bq.z), y[5] * bfhi(bq.z)); w.w = pk2(y[6] * bflo(bq.w), y[7] * bfhi(bq.w));
            if (u == 0 || idx2 != idx) *(v4u*)(O3 + offs[u]) = w;
        }
    }
}

#define XB_TMO      128
#define XB_XCNT(j)  (256  + 64 * (j))
#define XB_XSUB(j)  (1280 + 64 * (j))
#define XB_XGEN(j)  (2304 + 64 * (j))
#define XB_TOP      3328
#define XB_TOPGEN   3392
#define XCD_BAR_WORDS 3456
#define XB_SPIN_CAP (1u << 18)

__device__ __forceinline__ unsigned xb_ld(unsigned* p)              { return __hip_atomic_load(p, __ATOMIC_RELAXED, __HIP_MEMORY_SCOPE_AGENT); }
__device__ __forceinline__ unsigned xb_add(unsigned* p, unsigned v) { return __hip_atomic_fetch_add(p, v, __ATOMIC_RELAXED, __HIP_MEMORY_SCOPE_AGENT); }
__device__ __forceinline__ unsigned xb_xcc_id() { return (unsigned)__builtin_amdgcn_s_getreg((3 << 11) | 20) & 0xFu; }
#define XB_SPIN(cond, bar) do { unsigned _sp = 0; while (cond) { __builtin_amdgcn_s_sleep(1); \
    if ((++_sp & 255u) == 0u) { if (xb_ld(&(bar)[XB_TMO])) break; if (_sp > XB_SPIN_CAP) { atomicAdd(&(bar)[XB_TMO], 1u); break; } } } } while (0)

struct XcdBarrier {
    unsigned* bar; unsigned x;
    volatile LAS unsigned* st;
};

__device__ __forceinline__ XcdBarrier xcd_barrier_post(unsigned* bar, volatile LAS unsigned* st) {
    XcdBarrier b; b.bar = bar; b.x = xb_xcc_id(); b.st = st;
    if (threadIdx.x == 0) (void)xb_add(&bar[XB_XCNT(b.x)], 1u);
    return b;
}
__device__ __forceinline__ void xcd_barrier_complete(unsigned* bar, unsigned x, unsigned& nloc, unsigned& nx) {
    const unsigned G = gridDim.x * gridDim.y * gridDim.z;
    unsigned sum, cnt, mine, sp = 0u;
    for (;;) {
        sum = 0u; cnt = 0u; mine = 0u;
#pragma unroll
        for (unsigned j = 0; j < 16; ++j) { const unsigned c = xb_ld(&bar[XB_XCNT(j)]); sum += c; cnt += (c > 0u) ? 1u : 0u; mine = (j == x) ? c : mine; }
        if (sum == G) break;
        __builtin_amdgcn_s_sleep(1);
        if ((++sp & 255u) == 0u) { if (xb_ld(&bar[XB_TMO])) break; if (sp > XB_SPIN_CAP) { atomicAdd(&bar[XB_TMO], 1u); break; } }
    }
    nloc = mine > 0u ? mine : 1u; nx = cnt > 0u ? cnt : 1u;
}

__device__ __forceinline__ void xcd_barrier(const XcdBarrier& b) {
    asm volatile("s_waitcnt vmcnt(0)" ::: "memory");
    __syncthreads();
    if (threadIdx.x == 0) {
        unsigned* bar = b.bar;
        __builtin_amdgcn_s_waitcnt(0);
        unsigned nloc = b.st[0], nx = b.st[1];
        if (nloc == 0u) { xcd_barrier_complete(bar, b.x, nloc, nx); b.st[0] = nloc; b.st[1] = nx; }
        const unsigned old = xb_add(&bar[XB_XSUB(b.x)], 1u);
        const unsigned gen = old / nloc;
        if (old + 1u == (gen + 1u) * nloc) {
            __builtin_amdgcn_fence(__ATOMIC_RELEASE, "agent");
            asm volatile("s_waitcnt vmcnt(0)" ::: "memory");
            const unsigned og = xb_add(&bar[XB_TOP], 1u);
            const unsigned tg = og / nx;
            if (og + 1u == (tg + 1u) * nx) xb_add(&bar[XB_TOPGEN], 1u);
            else XB_SPIN(xb_ld(&bar[XB_TOPGEN]) == tg, bar);
            __builtin_amdgcn_fence(__ATOMIC_ACQUIRE, "agent");
            xb_add(&bar[XB_XGEN(b.x)], 1u);
            asm volatile("s_waitcnt vmcnt(0)" ::: "memory");
        } else {
            XB_SPIN(xb_ld(&bar[XB_XGEN(b.x)]) == gen, bar);
            __builtin_amdgcn_fence(__ATOMIC_ACQUIRE, "agent");
            asm volatile("s_waitcnt vmcnt(0)" ::: "memory");
        }
    }
    __syncthreads();
}

struct Args { const float* in[32]; float* out; unsigned char* ws; };
#define PHASE_VARS \
    unsigned char* ws = a.ws; float* out = a.out; asm volatile("" : "+s"(ws), "+s"(out)); \
    int tid = threadIdx.x; asm volatile("" : "+v"(tid)); \
    const int lane = tid & 63, wave = __builtin_amdgcn_readfirstlane(tid >> 6); \
    const int G = gridDim.x, gw = blockIdx.x * NWAVES + wave, ngw = G * NWAVES, gt = blockIdx.x * NTHR + tid, ngt = G * NTHR; \
    float* RS = (float*)(ws + WS_RS); float* LBK = (float*)(ws + WS_LBK); \
    bf16* WA = (bf16*)(ws + WS_WA); bf16* WB = (bf16*)(ws + WS_WB); bf16* WO = (bf16*)(ws + WS_WO); bf16* WUP = (bf16*)(ws + WS_WUP); bf16* WDN = (bf16*)(ws + WS_WDN); \
    bf16* HB = (bf16*)(ws + WS_HB); \
    bf16* B0 = (bf16*)(ws + WS_BIG); bf16* B1 = (bf16*)(ws + WS_BIG + SLOT); bf16* B2 = (bf16*)(ws + WS_BIG + 2 * SLOT); bf16* B3 = (bf16*)(ws + WS_BIG + 3 * SLOT); \
    bf16* B4 = (bf16*)(ws + WS_BIG + 4 * SLOT); bf16* B5 = (bf16*)(ws + WS_BIG + 5 * SLOT); bf16* B5b = (bf16*)(ws + WS_BIG + 5 * SLOT + 16 * MiB); \
    LAS float* scr = (LAS float*)(lds + wave * 16384); \
    (void)lane; (void)gw; (void)ngw; (void)gt; (void)ngt; (void)RS; (void)LBK; (void)WA; (void)WB; (void)WO; (void)WUP; (void)WDN; (void)HB; (void)B0; (void)B1; (void)B2; (void)B3; (void)B4; (void)B5; (void)B5b; (void)scr; (void)out; (void)G;
constexpr size_t SLOT_E = SLOT / 2;

__global__ void __launch_bounds__(NTHR, 2) fwd_megakernel(Args a) {
    extern __shared__ __attribute__((aligned(16))) unsigned char lds_raw[];
    cg::grid_group grid = cg::this_grid();
    LAS unsigned char* lds = (LAS unsigned char*)lds_raw;
    volatile LAS unsigned* xb_st = (volatile LAS unsigned*)(lds + LDS_BYTES - 64);
    if (threadIdx.x < 2) xb_st[threadIdx.x] = 0u;
    __syncthreads();
    const XcdBarrier xbar = xcd_barrier_post((unsigned*)(a.ws + WS_BAR), xb_st);

#pragma nounroll
    for (int layer = 0; layer < 4; ++layer) {
        for (int rp_ = 0; rp_ < REP_PRO; ++rp_) { PHASE_VARS
        const float* gmix = a.in[1] + layer * 1024; const float* gffn = a.in[2] + layer * 1024;
        conv_mat(a.in[3] + (size_t)layer * D * FF, D, FF, WUP, D, 0, 0, gffn, scr, gw, ngw, lane);
        conv_mat(a.in[4] + (size_t)layer * D * FF, FF, D, WDN, FF, 0, 0, nullptr, scr, gw, ngw, lane);
        if (layer == 0) {
            conv_mat(a.in[6], D, 3 * D, WA, D, 0, 0, gmix, scr, gw, ngw, lane);
            conv_mat(a.in[7], D, D, WO, D, 0, 0, nullptr, scr, gw, ngw, lane);
            for (int m0 = gw; m0 < M; m0 += 4 * ngw) {
                f32x4 v[4][4];
#pragma unroll
                for (int u = 0; u < 4; ++u) { const int ml = m0 + u * ngw < M ? m0 + u * ngw : m0; const f32x4* xr = (const f32x4*)(a.in[0] + (size_t)ml * 1024) + lane;
#pragma unroll
                    for (int j = 0; j < 4; ++j) v[u][j] = xr[64 * j]; }
#pragma unroll
                for (int u = 0; u < 4; ++u) { const int m = m0 + u * ngw; if (m >= M) break; float ss = 0.f;
#pragma unroll
                    for (int j = 0; j < 4; ++j) { ss += (v[u][j][0] * v[u][j][0] + v[u][j][1] * v[u][j][1]) + (v[u][j][2] * v[u][j][2] + v[u][j][3] * v[u][j][3]);
                        v2u w; w.x = pk2(v[u][j][0], v[u][j][1]); w.y = pk2(v[u][j][2], v[u][j][3]); *(v2u*)(HB + (size_t)m * 1024 + 4 * lane + 256 * j) = w; }
                    ss = wave_sum(ss);
                    if (lane < 16) RS[(size_t)m * 16 + lane] = lane == 0 ? ss : 0.f; }
            }
        } else if (layer == 1) {
            conv_mat(a.in[8], D, 4 * D, WA, D, 0, 0, gmix, scr, gw, ngw, lane);
            conv_mat(a.in[11], D, D, WO, D, 0, 0, nullptr, scr, gw, ngw, lane);
            for (int c = gt; c < 1024; c += ngt) {
                const float* tb = a.in[9]; const float t0 = tb[c], t1 = tb[1024 + c], t2 = tb[2048 + c], t3 = tb[3072 + c];
                const float mx = fmaxf(fmaxf(t0, t1), fmaxf(t2, t3));
                const float e0 = expf(t0 - mx), e1 = expf(t1 - mx), e2 = expf(t2 - mx), e3 = expf(t3 - mx);
                LBK[c] = 1.0f - e1 / (e0 + e1 + e2 + e3);
            }
        } else if (layer == 2) {
            const float* mix = a.in[12];
#pragma nounroll
            for (int j = 0; j < 3; ++j) {
                conv_mat(a.in[13] + (size_t)j * D * D, D, D, WA, 2048, 1024 * j, 0, nullptr, scr, gw, ngw, lane);
                conv_mat(a.in[13] + (size_t)j * D * D, D, D, WA, 2048, 1024 * j, 1024, mix + 1024 * j, scr, gw, ngw, lane);
            }
            conv_mat(a.in[15], D, 64, WA, 2048, 3072, 0, nullptr, scr, gw, ngw, lane); conv_mat(a.in[15], D, 64, WA, 2048, 3072, 1024, mix + 3 * 1024, scr, gw, ngw, lane);
            conv_mat(a.in[18], D, 64, WA, 2048, 3136, 0, nullptr, scr, gw, ngw, lane); conv_mat(a.in[18], D, 64, WA, 2048, 3136, 1024, mix + 4 * 1024, scr, gw, ngw, lane);
            conv_mat(a.in[20], D, 128, WA, 2048, 3200, 0, nullptr, scr, gw, ngw, lane); conv_mat(a.in[20], D, 128, WA, 2048, 3200, 1024, mix + 5 * 1024, scr, gw, ngw, lane);
            conv_mat(a.in[27], D, D, WO, D, 0, 0, nullptr, scr, gw, ngw, lane);
            for (int idx = gt; idx < 256 * 3072; idx += ngt) {
                const int k = idx / 3072, n = idx - k * 3072, grp = n >> 10, nn = n & 1023; float v = 0.f;
                if (grp == 0) { if (k < 64) v = a.in[16][k * 1024 + nn]; }
                else if (grp == 1) { if (k >= 64 && k < 128) v = a.in[19][(k - 64) * 1024 + nn]; }
                else { if (k >= 128) v = a.in[21][(k - 128) * 1024 + nn]; }
                WB[(size_t)n * 256 + k] = (bf16)f2bf(v);
            }
            rw_prep(out, RS, gmix, B0, gw, ngw, lane);
        } else {
            conv_mat(a.in[28], D, 3 * D, WA, D, 0, 0, gmix, scr, gw, ngw, lane);
            conv_mat(a.in[31], D, D, WO, D, 0, 0, nullptr, scr, gw, ngw, lane);
        }
        }
        if (layer == 0) grid.sync();
        else GRID_SYNC();

        if (layer == 0 || layer == 3) {
            { PHASE_VARS
            pg8::Gemm g{HB, WA, M, 3 * D, D}; pg8::StaticOrder S; S.init(M, 3 * D, G, (int)blockIdx.x);
            pg8::EpiAct<0> E{B0, 1024, 1024, SLOT_E, RS, layer == 0 ? 0.125f * LOG2E_F : 1.0f, nullptr};
            for (int r_ = 0; r_ < REP_IN; ++r_) pg8::gemm_phase<pg8::EpiAct<0>, pg8::StaticOrder, true, true>(lds, g, S, E); }
            GRID_SYNC();
            { PHASE_VARS
            if (layer == 0) { for (int r_ = 0; r_ < REP_ATT; ++r_) attn_phase(B0, B1, B2, B3, gw, ngw, lane); }
            else { for (int r_ = 0; r_ < REP_SC; ++r_) sc_conv(B0, B1, B2, a.in[29], a.in[30], B3, gt, ngt); } }
        } else if (layer == 1) {
            { PHASE_VARS
            pg8::Gemm g{HB, WA, M, 4 * D, D}; pg8::StaticOrder S; S.init(M, 4 * D, G, (int)blockIdx.x);
            pg8::EpiAct<2> E{B0, 1024, 1024, SLOT_E, RS, 1.0f, LBK};
            for (int r_ = 0; r_ < REP_IN; ++r_) pg8::gemm_phase<pg8::EpiAct<2>, pg8::StaticOrder, true, true>(lds, g, S, E); }
            GRID_SYNC();
            { PHASE_VARS
            hg_local(B0, B1, B4, B2, (float*)B5, (float*)(ws + WS_BIG + 5 * SLOT + 8 * MiB), (float*)(ws + WS_BIG + 5 * SLOT + 24 * MiB)); }
            GRID_SYNC();
            { PHASE_VARS
            hg_out(B0, B1, B4, B2, (const float*)B5, (const float*)(ws + WS_BIG + 5 * SLOT + 8 * MiB), (const float*)(ws + WS_BIG + 5 * SLOT + 24 * MiB), a.in[10], B3, lds); }
        } else {
            { PHASE_VARS
              pg8::Gemm g{B0, WA, M, 3328, 2048}; pg8::StaticOrder S; S.init(M, 3328, G, (int)blockIdx.x);
              pg8::EpiRw1 E{B2, SLOT_E, B5};
              for (int r_ = 0; r_ < REP_G1; ++r_) pg8::gemm_phase<pg8::EpiRw1, pg8::StaticOrder, true, true>(lds, g, S, E); }
            GRID_SYNC();
            { PHASE_VARS
              int k256 = 256; asm volatile("" : "+s"(k256));
              pg8::Gemm g{B5, WB, M, 3 * D, k256}; pg8::StaticOrder S; S.init(M, 3 * D, G, (int)blockIdx.x);
              pg8::EpiRw2 E{B0, SLOT_E, 5 * SLOT_E + 8 * MiB, a.in[14], a.in[17]};
              for (int r_ = 0; r_ < REP_G2; ++r_) pg8::gemm_phase<pg8::EpiRw2, pg8::StaticOrder, true, true>(lds, g, S, E); }
            GRID_SYNC();
            { PHASE_VARS
            for (int r_ = 0; r_ < REP_RW; ++r_) rw_scan(B2, B3, B4, B0, B1, a.in[22], a.in[23], HB, lds); }
            GRID_SYNC();
            { PHASE_VARS
            rw_post(HB, B2, B3, B4, B1, B5b, a.in[23], a.in[24], a.in[25], a.in[26], gw, ngw, lane); }
        }
        GRID_SYNC();
        { PHASE_VARS
          const bf16* mix_out = (layer == 2) ? B2 : B3;
          pg8::Gemm g{mix_out, WO, M, D, D}; pg8::StaticOrder S; S.init(M, D, G, (int)blockIdx.x);
#pragma nounroll
          for (int r_ = 0; r_ < REP_OUT; ++r_) {
          pg8::EpiResid E{layer == 0 ? a.in[0] : out, r_ + 1 < REP_OUT ? (float*)B4 : out, HB, RS};
          pg8::gemm_phase<pg8::EpiResid, pg8::StaticOrder, true, true>(lds, g, S, E); } }
        GRID_SYNC();
        { PHASE_VARS
          pg8::Gemm g{HB, WUP, M, FF, D}; pg8::StaticOrder S; S.init(M, FF, G, (int)blockIdx.x);
          pg8::EpiAct<1> E{B0, FF, 0, 0, RS, 1.0f, nullptr};
#pragma nounroll
          for (int r_ = 0; r_ < REP_UP; ++r_) pg8::gemm_phase<pg8::EpiAct<1>, pg8::StaticOrder, true, true>(lds, g, S, E); }
        GRID_SYNC();
        { PHASE_VARS
          pg8::Gemm g{B0, WDN, M, D, FF}; pg8::StaticOrder S; S.init(M, D, G, (int)blockIdx.x);
#pragma nounroll
          for (int r_ = 0; r_ < REP_DN; ++r_) {
          pg8::EpiResid E{out, r_ + 1 < REP_DN ? (float*)B4 : out, (layer == 1 || layer == 3) ? (bf16*)nullptr : HB, RS};
          pg8::gemm_phase<pg8::EpiResid, pg8::StaticOrder, true, true>(lds, g, S, E); } }
        GRID_SYNC();
    }
    { PHASE_VARS
    const f32x4* gr = (const f32x4*)(a.in[5]) + lane;
    const f32x4 g0 = gr[0], g1 = gr[64], g2 = gr[128], g3 = gr[192];
    for (int m0 = gw; m0 < M; m0 += 4 * ngw) {
        f32x4 v[4][4]; f32x4 pr[4];
#pragma unroll
        for (int u = 0; u < 4; ++u) { const int m = m0 + u * ngw < M ? m0 + u * ngw : m0; const f32x4* xr = (const f32x4*)(out + (size_t)m * 1024) + lane;
            pr[u] = *(const f32x4*)(RS + (size_t)m * 16 + 4 * (lane & 3));
#pragma unroll
            for (int j = 0; j < 4; ++j) v[u][j] = xr[64 * j]; }
#pragma unroll
        for (int u = 0; u < 4; ++u) { const int m = m0 + u * ngw; if (m >= M) break; f32x4* xr = (f32x4*)(out + (size_t)m * 1024) + lane;
            float s = (pr[u][0] + pr[u][1]) + (pr[u][2] + pr[u][3]); s += dpp_f<0xB1>(s); s += dpp_f<0x4E>(s);
            const float r = 1.0f / sqrtf(s * (1.0f / 1024.0f) + 1e-6f);
            xr[0] = v[u][0] * r * g0; xr[64] = v[u][1] * r * g1; xr[128] = v[u][2] * r * g2; xr[192] = v[u][3] * r * g3; }
    } }
}

extern "C" void kernel_launch(void* const* d_in, const int* in_sizes, int n_in, void* d_out, int out_size, void* d_ws, size_t ws_size, hipStream_t stream) {
    static int grid = 0;
    if (grid == 0) {
        if (n_in != 32 || out_size != M * D || ws_size < WS_END) { fprintf(stderr, "kernel_launch: unexpected shapes (n_in %d out %d ws %zu)\n", n_in, out_size, ws_size); grid = -1; return; }
        int dev = 0, cus = 0, per_cu = 0;
        hipGetDevice(&dev); hipDeviceGetAttribute(&cus, hipDeviceAttributeMultiprocessorCount, dev);
        hipFuncSetAttribute((const void*)fwd_megakernel, hipFuncAttributeMaxDynamicSharedMemorySize, LDS_BYTES);
        hipOccupancyMaxActiveBlocksPerMultiprocessor(&per_cu, (const void*)fwd_megakernel, NTHR, LDS_BYTES);
        if (per_cu < 1) { fprintf(stderr, "kernel_launch: occupancy query says %d blocks per CU\n", per_cu); per_cu = 1; }
        (void)hipGetLastError();
        grid = cus * per_cu;
    }
    if (grid < 0) return;
    if (hipMemsetAsync((char*)d_ws + WS_BAR, 0, WS_BAR_BYTES, stream) != hipSuccess) { fprintf(stderr, "kernel_launch: memset of the barrier words failed\n"); return; }
    Args a{};
    for (int i = 0; i < 32; ++i) a.in[i] = (const float*)d_in[i];
    a.out = (float*)d_out; a.ws = (unsigned char*)d_ws;
    void* args[] = {&a};
    hipError_t e = hipLaunchCooperativeKernel((const void*)fwd_megakernel, dim3(grid), dim3(NTHR), args, LDS_BYTES, stream);
    if (e != hipSuccess) fprintf(stderr, "cooperative launch failed: %s (grid %d)\n", hipGetErrorString(e), grid);
}
```

```cpp
#include <hip/hip_runtime.h>
#include <hip/hip_cooperative_groups.h>
#include <cstdio>
#include <cstdint>
namespace cg = cooperative_groups;
namespace pg8 {
#define PG8_LAS __attribute__((address_space(3)))
typedef unsigned short bf16_t;
typedef short bf16x8 __attribute__((ext_vector_type(8)));
typedef float f32x4 __attribute__((ext_vector_type(4)));
typedef unsigned u32x4 __attribute__((ext_vector_type(4)));
constexpr int BM = 256, BK = 64, HALF = 128, HTB = HALF * BK * 2  , STAGE_BYTES = 8 * HTB, NXCD = 8, WGM = 8;

__host__ __device__ __forceinline__ int lds_byte(int r, int c) { const int st = (r >> 4) * 2 + (c >> 5), rr = r & 15, cc = c & 31, ob = rr * 64 + cc * 2; return st * 1024 + (ob ^ (((ob >> 9) & 1) << 5)); }
__host__ __device__ __forceinline__ void stage_rc(int b, int& R, int& C) { const int st = b / 1024, sb = b % 1024, swz = sb ^ (((sb >> 9) & 1) << 5); R = (st >> 1) * 16 + swz / 64; C = (st & 1) * 32 + (swz % 64) / 2; }
__host__ __device__ __forceinline__ int perm32(int rho) { const int n = rho >> 4, i = rho & 15; return 8 * (i >> 2) + 4 * n + (i & 3); }

struct Unit { int pm, pn; };
struct Gemm { const bf16_t* A; const bf16_t* Bt; int M, N, K; };

struct StaticOrder {
    int nM, nN, nwg, G, c;
    __host__ __device__ void init(int M, int N, int G_, int c_) { nM = M / BM; nN = N / BM; nwg = nM * nN; G = G_; c = c_; }
    __host__ __device__ bool next(int i, Unit& u) const {
        const long L = (long)i * G + c; if (L >= nwg) return false;
        int wgid = (int)L; { const int q = nwg / NXCD, r = nwg % NXCD, xcd = wgid % NXCD, off = wgid / NXCD; wgid = (xcd < r ? xcd * (q + 1) : r * (q + 1) + (xcd - r) * q) + off; }
        const int wgm = nN >= 8 ? 4 : WGM; const int nig = wgm * nN, gid = wgid / nig, fm = gid * wgm, gsz = (nM - fm) < wgm ? (nM - fm) : wgm;
        u.pm = fm + ((wgid % nig) % gsz); u.pn = (wgid % nig) / gsz; return true;
    }
    __device__ __forceinline__ void a_ready(const Unit&) const {}
    __device__ __forceinline__ void done(const Unit&) const {}
};

__device__ __forceinline__ unsigned cvt_pk_bf16(float lo, float hi) { unsigned r; asm volatile("v_cvt_pk_bf16_f32 %0, %1, %2" : "=v"(r) : "v"(lo), "v"(hi)); return r; }
typedef unsigned u32x4 __attribute__((ext_vector_type(4)));
typedef unsigned u32x2 __attribute__((ext_vector_type(2)));
constexpr float LOG2E = 1.4426950408889634f;
__device__ __forceinline__ float fast_sigmoid(float x) { return __builtin_amdgcn_rcpf(1.0f + __builtin_amdgcn_exp2f(-x * LOG2E)); }
__device__ __forceinline__ float row_rs(const float* rs, int row) {
    const f32x4* p = (const f32x4*)(rs + (size_t)row * 16);
    const f32x4 a = p[0], b = p[1], c = p[2], d = p[3];
    const float s = ((a[0] + a[1]) + (a[2] + a[3])) + ((b[0] + b[1]) + (b[2] + b[3])) + ((c[0] + c[1]) + (c[2] + c[3])) + ((d[0] + d[1]) + (d[2] + d[3]));
    return 1.0f / sqrtf(s * (1.0f / 1024.0f) + 1e-6f);
}
template <int MODE> struct EpiAct {
    static constexpr bool PERM = true, AFTER_DRAIN = false;
    bf16_t* O; int ldc; int split_cols; size_t split_stride; const float* rs; float scale0; const float* aux;
    __device__ __forceinline__ void operator()(const f32x4 (&acc)[2][2][4][2], const Unit& u, int wr, int wc, int fr, int fq) const {
        const int row0 = u.pm * BM + wr * 64 + fr; int colt = u.pn * BM; bf16_t* base = O; int t = 0;
        if (split_cols) { t = colt / split_cols; base += (size_t)t * split_stride; colt -= t * split_cols; }
        const float sc = (MODE == 0 && t == 0) ? scale0 : 1.f;
        const int col0 = colt + wc * 32 + 8 * fq;
        f32x4 lbk[2][2];
#pragma unroll
        for (int bj = 0; bj < 2; ++bj)
#pragma unroll
            for (int n = 0; n < 2; ++n) lbk[bj][n] = (MODE == 2 && t == 1) ? *(const f32x4*)(aux + col0 + bj * HALF + 4 * n) : (f32x4){0.f, 0.f, 0.f, 0.f};
        float rsv[2][4];
        if (rs) {
            f32x4 part[2][4];
#pragma unroll
            for (int ai = 0; ai < 2; ++ai)
#pragma unroll
                for (int m = 0; m < 4; ++m) part[ai][m] = *(const f32x4*)(rs + (size_t)(row0 + ai * HALF + m * 16) * 16 + 4 * fq);
#pragma unroll
            for (int ai = 0; ai < 2; ++ai)
#pragma unroll
                for (int m = 0; m < 4; ++m) { float s = (part[ai][m][0] + part[ai][m][1]) + (part[ai][m][2] + part[ai][m][3]); s += __shfl_xor(s, 16); s += __shfl_xor(s, 32);
                    rsv[ai][m] = sc / sqrtf(s * (1.0f / 1024.0f) + 1e-6f); }
        } else {
#pragma unroll
            for (int ai = 0; ai < 2; ++ai)
#pragma unroll
                for (int m = 0; m < 4; ++m) rsv[ai][m] = sc;
        }
#pragma unroll
        for (int ai = 0; ai < 2; ++ai)
#pragma unroll
            for (int m = 0; m < 4; ++m) {
                const int row = row0 + ai * HALF + m * 16;
                const float r = rsv[ai][m];
                bf16_t* rowp = base + (size_t)row * ldc + col0;
#pragma unroll
                for (int bj = 0; bj < 2; ++bj) {
                    f32x4 v[2] = {acc[ai][bj][m][0] * r, acc[ai][bj][m][1] * r};
#pragma unroll
                    for (int n = 0; n < 2; ++n)
#pragma unroll
                        for (int j = 0; j < 4; ++j) {
                            float x = v[n][j];
                            if (MODE == 1) { x = fmaxf(x, 0.f); x = x * x; }
                            if (MODE == 2) {
                                if (t == 0 || t == 3) x = x * fast_sigmoid(x);
                                else if (t == 1) x = lbk[bj][n][j] * __builtin_amdgcn_rcpf(1.0f + __builtin_amdgcn_exp2f(x * LOG2E));
                            }
                            v[n][j] = x;
                        }
                    u32x4 w; w.x = cvt_pk_bf16(v[0][0], v[0][1]); w.y = cvt_pk_bf16(v[0][2], v[0][3]); w.z = cvt_pk_bf16(v[1][0], v[1][1]); w.w = cvt_pk_bf16(v[1][2], v[1][3]);
                    *(u32x4*)(rowp + bj * HALF) = w;
                }
            }
    }
};
struct EpiRw1 {
    static constexpr bool PERM = true, AFTER_DRAIN = false;
    bf16_t* RKV; size_t split_stride; bf16_t* L;
    __device__ __forceinline__ void operator()(const f32x4 (&acc)[2][2][4][2], const Unit& u, int wr, int wc, int fr, int fq) const {
        const int row0 = u.pm * BM + wr * 64 + fr;
        const bool lora = (u.pn >= 12);
        bf16_t* base = lora ? L : RKV + (size_t)(u.pn >> 2) * split_stride;
        const int ldc = lora ? 256 : 1024;
        const int col0 = (lora ? 0 : (u.pn & 3) * BM) + wc * 32 + 8 * fq;
#pragma unroll
        for (int ai = 0; ai < 2; ++ai)
#pragma unroll
            for (int m = 0; m < 4; ++m) {
                bf16_t* rowp = base + (size_t)(row0 + ai * HALF + m * 16) * ldc + col0;
#pragma unroll
                for (int bj = 0; bj < 2; ++bj) {
                    f32x4 v[2] = {acc[ai][bj][m][0], acc[ai][bj][m][1]};
                    if (lora) {
#pragma unroll
                        for (int n = 0; n < 2; ++n)
#pragma unroll
                            for (int j = 0; j < 4; ++j) {
                                float x = v[n][j];
                                if (bj == 1) x = fast_sigmoid(x);
                                else if (wc < 2) x = 1.0f - 2.0f * __builtin_amdgcn_rcpf(1.0f + __builtin_amdgcn_exp2f(fminf(x, 40.f) * (2.0f * LOG2E)));
                                v[n][j] = x;
                            }
                    }
                    u32x4 w; w.x = cvt_pk_bf16(v[0][0], v[0][1]); w.y = cvt_pk_bf16(v[0][2], v[0][3]); w.z = cvt_pk_bf16(v[1][0], v[1][1]); w.w = cvt_pk_bf16(v[1][2], v[1][3]);
                    *(u32x4*)(rowp + bj * HALF) = w;
                }
            }
    }
};
struct EpiRw2 {
    static constexpr bool PERM = true, AFTER_DRAIN = false;
    bf16_t* WM; size_t offA, offG; const float* w0; const float* a0;
    __device__ __forceinline__ void operator()(const f32x4 (&acc)[2][2][4][2], const Unit& u, int wr, int wc, int fr, int fq) const {
        const int row0 = u.pm * BM + wr * 64 + fr; const int t = u.pn >> 2;
        bf16_t* base = WM + (t == 1 ? offA : (size_t)0) + (t == 2 ? offG : (size_t)0);
        const float* bias = t == 0 ? w0 : a0;
        const int col0 = (u.pn & 3) * BM + wc * 32 + 8 * fq;
        f32x4 bv[2][2];
#pragma unroll
        for (int bj = 0; bj < 2; ++bj)
#pragma unroll
            for (int n = 0; n < 2; ++n) bv[bj][n] = (t < 2) ? *(const f32x4*)(bias + col0 + bj * HALF + 4 * n) : (f32x4){0.f, 0.f, 0.f, 0.f};
#pragma unroll
        for (int ai = 0; ai < 2; ++ai)
#pragma unroll
            for (int m = 0; m < 4; ++m) {
                bf16_t* rowp = base + (size_t)(row0 + ai * HALF + m * 16) * 1024 + col0;
#pragma unroll
                for (int bj = 0; bj < 2; ++bj) {
                    f32x4 v[2] = {acc[ai][bj][m][0], acc[ai][bj][m][1]};
                    if (t < 2) {
                        v[0] += bv[bj][0]; v[1] += bv[bj][1];
#pragma unroll
                        for (int n = 0; n < 2; ++n)
#pragma unroll
                            for (int j = 0; j < 4; ++j) {
                                float x = fast_sigmoid(v[n][j]);
                                if (t == 0) x = 1.0f - __builtin_amdgcn_exp2f(x * (-0.6065306597126334f * LOG2E));
                                v[n][j] = x;
                            }
                    }
                    u32x4 w; w.x = cvt_pk_bf16(v[0][0], v[0][1]); w.y = cvt_pk_bf16(v[0][2], v[0][3]); w.z = cvt_pk_bf16(v[1][0], v[1][1]); w.w = cvt_pk_bf16(v[1][2], v[1][3]);
                    *(u32x4*)(rowp + bj * HALF) = w;
                    asm volatile("" ::: "memory");
                }
            }
    }
};
struct EpiResid {
    static constexpr bool PERM = false, AFTER_DRAIN = false;
    const float* base; float* out; bf16_t* hb; float* rsq;
    __device__ __forceinline__ void operator()(const f32x4 (&acc)[2][2][4][2], const Unit& u, int wr, int wc, int fr, int fq) const {
        const int col0 = u.pn * BM + wc * 32 + 4 * fq;
#pragma unroll
        for (int ai = 0; ai < 2; ++ai) {
            f32x4 pre[4][2][2];
#pragma unroll
            for (int m = 0; m < 4; ++m) { const size_t off = (size_t)(u.pm * BM + ai * HALF + wr * 64 + m * 16 + fr) * 1024 + col0;
#pragma unroll
                for (int bj = 0; bj < 2; ++bj)
#pragma unroll
                    for (int n = 0; n < 2; ++n) pre[m][bj][n] = *(const f32x4*)(base + off + bj * HALF + n * 16); }
#pragma unroll
            for (int m = 0; m < 4; ++m) {
                const int row = u.pm * BM + ai * HALF + wr * 64 + m * 16 + fr; const size_t off = (size_t)row * 1024 + col0;
                float ss = 0.f;
#pragma unroll
                for (int bj = 0; bj < 2; ++bj)
#pragma unroll
                    for (int n = 0; n < 2; ++n) {
                        const f32x4 o = pre[m][bj][n] + acc[ai][bj][m][n];
                        *(f32x4*)(out + off + bj * HALF + n * 16) = o;
                        u32x2 w; w.x = cvt_pk_bf16(o[0], o[1]); w.y = cvt_pk_bf16(o[2], o[3]);
                        if (hb) *(u32x2*)(hb + off + bj * HALF + n * 16) = w;
                        ss += (o[0] * o[0] + o[1] * o[1]) + (o[2] * o[2] + o[3] * o[3]);
                    }
                ss += __shfl_xor(ss, 16); ss += __shfl_xor(ss, 32);
                if (fq == 0) rsq[(size_t)row * 16 + u.pn * 4 + wc] = ss;
            }
        }
    }
};

struct EpiResidB {
    static constexpr bool PERM = false, AFTER_DRAIN = false;
    bf16_t* hb; float* rsq;
    __device__ __forceinline__ void operator()(const f32x4 (&acc)[2][2][4][2], const Unit& u, int wr, int wc, int fr, int fq) const {
        const int col0 = u.pn * BM + wc * 32 + 4 * fq;
#pragma unroll
        for (int ai = 0; ai < 2; ++ai) {
            u32x2 pre[2][4][2][2];
#pragma unroll
            for (int m = 0; m < 4; ++m) { const size_t off = (size_t)(u.pm * BM + ai * HALF + wr * 64 + m * 16 + fr) * 1024 + col0;
#pragma unroll
                for (int bj = 0; bj < 2; ++bj)
#pragma unroll
                    for (int n = 0; n < 2; ++n) pre[ai][m][bj][n] = *(const u32x2*)(hb + off + bj * HALF + n * 16); }
#pragma unroll
            for (int m = 0; m < 4; ++m) {
                const int row = u.pm * BM + ai * HALF + wr * 64 + m * 16 + fr; const size_t off = (size_t)row * 1024 + col0;
                float ss = 0.f;
#pragma unroll
                for (int bj = 0; bj < 2; ++bj)
#pragma unroll
                    for (int n = 0; n < 2; ++n) {
                        const u32x2 p = pre[ai][m][bj][n];
                        f32x4 o; o[0] = __builtin_bit_cast(float, p.x << 16); o[1] = __builtin_bit_cast(float, p.x & 0xffff0000u); o[2] = __builtin_bit_cast(float, p.y << 16); o[3] = __builtin_bit_cast(float, p.y & 0xffff0000u);
                        o = o + acc[ai][bj][m][n];
                        u32x2 w; w.x = cvt_pk_bf16(o[0], o[1]); w.y = cvt_pk_bf16(o[2], o[3]);
                        *(u32x2*)(hb + off + bj * HALF + n * 16) = w;
                        ss += (o[0] * o[0] + o[1] * o[1]) + (o[2] * o[2] + o[3] * o[3]);
                    }
                ss += __shfl_xor(ss, 16); ss += __shfl_xor(ss, 32);
                if (fq == 0) rsq[(size_t)row * 16 + u.pn * 4 + wc] = ss;
            }
        }
    }
};
template <class Epi, class Sched, bool ALIGN_EPI = false, bool SP2 = false>
__device__ __forceinline__ void gemm_phase(PG8_LAS unsigned char* lds, const Gemm g, const Sched& S, const Epi& E) {
    int tid_ = threadIdx.x; asm volatile("" : "+v"(tid_)); const int tid = tid_, wid = __builtin_amdgcn_readfirstlane(tid >> 6), lane = tid & 63, wr = wid >> 2, wc = wid & 3, fr = lane & 15, fq = lane >> 4;
    const int K = g.K, nt = K / BK;
    unsigned voffA[2], voffB[2];
#pragma unroll
    for (int i = 0; i < 2; ++i) { int R, C; stage_rc(tid * 16 + i * 8192, R, C); const int Rb = Epi::PERM ? ((R & ~31) + perm32(R & 31)) : R;
        voffA[i] = (unsigned)(R * K + C) * 2u; voffB[i] = (unsigned)(Rb * K + C) * 2u; }
    const size_t kstep = (size_t)(BK * 2);
    const size_t hstep = (size_t)HALF * K * 2;
    const size_t tstep = 2 * hstep;
    const unsigned ldsw = (unsigned)wid * 1024u;
    const int aoff = lds_byte(wr * 64 + fr, fq * 8), boff = lds_byte(wc * 32 + fr, fq * 8);
#define PG8_SA(b, h) (((b) * 2 + (h)) * HTB)
#define PG8_SB(b, h) ((4 + (b) * 2 + (h)) * HTB)
#define PG8_STAGE(bufoff, gbase, voff) do { _Pragma("unroll") for (int _i = 0; _i < 2; ++_i) \
        __builtin_amdgcn_global_load_lds((const unsigned*)((const char*)(gbase) + (voff)[_i]), (PG8_LAS unsigned*)(lds + (bufoff) + ldsw + _i * 8192), 16, 0, 0); } while (0)
#define PG8_LDA(dst, b, h) do { _Pragma("unroll") for (int m = 0; m < 4; ++m) _Pragma("unroll") for (int k = 0; k < 2; ++k) dst[m][k] = *(const PG8_LAS bf16x8*)(lds + PG8_SA(b, h) + aoff + m * 2048 + k * 1024); } while (0)
#define PG8_LDB(dst, b, h) do { _Pragma("unroll") for (int n = 0; n < 2; ++n) _Pragma("unroll") for (int k = 0; k < 2; ++k) dst[n][k] = *(const PG8_LAS bf16x8*)(lds + PG8_SB(b, h) + boff + n * 2048 + k * 1024); } while (0)
#define PG8_MMA(ai, bj, At, Bt) do { __builtin_amdgcn_s_setprio(1); _Pragma("unroll") for (int m = 0; m < 4; ++m) _Pragma("unroll") for (int n = 0; n < 2; ++n) _Pragma("unroll") for (int k = 0; k < 2; ++k) \
        acc[ai][bj][m][n] = __builtin_amdgcn_mfma_f32_16x16x32_bf16(Bt[n][k], At[m][k], acc[ai][bj][m][n], 0, 0, 0); __builtin_amdgcn_s_setprio(0); } while (0)
#define PG8_WAIT_V(n) asm volatile("s_waitcnt vmcnt(" #n ")" ::: "memory")
#define PG8_WAIT_L(n) asm volatile("s_waitcnt lgkmcnt(" #n ")" ::: "memory")
#define PG8_BAR __builtin_amdgcn_s_barrier()
#define PG8_SCHED __builtin_amdgcn_sched_barrier(0)
    Unit cur, nxt; int ui = 0;
    if (!S.next(0, cur)) return;
    f32x4 acc[2][2][4][2];
#pragma unroll
    for (int a = 0; a < 2; ++a)
#pragma unroll
        for (int b = 0; b < 2; ++b)
#pragma unroll
            for (int m = 0; m < 4; ++m)
#pragma unroll
                for (int n = 0; n < 2; ++n) acc[a][b][m][n] = (f32x4){0.f, 0.f, 0.f, 0.f};
    bf16x8 At[4][2], B0[2][2], B1[2][2];
    const char* cA = (const char*)g.A + (size_t)cur.pm * tstep; const char* cB = (const char*)g.Bt + (size_t)cur.pn * tstep;
    S.a_ready(cur);
    if constexpr (SP2) {
        PG8_STAGE(PG8_SB(0, 0), cB, voffB); PG8_STAGE(PG8_SB(0, 1), cB + hstep, voffB); PG8_STAGE(PG8_SA(0, 0), cA, voffA); PG8_STAGE(PG8_SA(0, 1), cA + hstep, voffA);
        if (wr == 1) PG8_BAR;
        PG8_WAIT_V(2); PG8_BAR;
        PG8_STAGE(PG8_SB(1, 0), cB + kstep, voffB); PG8_STAGE(PG8_SA(1, 0), cA + kstep, voffA); PG8_STAGE(PG8_SB(1, 1), cB + hstep + kstep, voffB);
        PG8_WAIT_V(6); PG8_BAR;
    } else {
        PG8_STAGE(PG8_SB(0, 0), cB, voffB); PG8_STAGE(PG8_SA(0, 0), cA, voffA); PG8_STAGE(PG8_SB(0, 1), cB + hstep, voffB); PG8_STAGE(PG8_SA(0, 1), cA + hstep, voffA);
        if (wr == 1) PG8_BAR;
        PG8_WAIT_V(4); PG8_BAR;
        PG8_STAGE(PG8_SB(1, 0), cB + kstep, voffB); PG8_STAGE(PG8_SA(1, 0), cA + kstep, voffA); PG8_STAGE(PG8_SB(1, 1), cB + hstep + kstep, voffB);
        PG8_WAIT_V(6); PG8_BAR;
    }
    for (;;) {
        const bool has_next = S.next(ui + 1, nxt);
        const char* nA = has_next ? (const char*)g.A + (size_t)nxt.pm * tstep : cA; const char* nB = has_next ? (const char*)g.Bt + (size_t)nxt.pn * tstep : cB;
        for (int t = 0; t < nt; t += 2) {
            const bool last = (t == nt - 2);
            const char* a1 = cA + (size_t)(t + 1) * kstep;
            const char* a2 = last ? nA : cA + (size_t)(t + 2) * kstep; const char* b2 = last ? nB : cB + (size_t)(t + 2) * kstep;
            const char* a3 = a2 + kstep; const char* b3 = b2 + kstep;
            if (last && has_next) S.a_ready(nxt);
            if constexpr (SP2) {
            PG8_LDB(B0, 0, 0); PG8_LDB(B1, 0, 1); PG8_SCHED; PG8_LDA(At, 0, 0); PG8_STAGE(PG8_SA(1, 1), a1 + hstep, voffA);
            PG8_WAIT_V(8); PG8_WAIT_L(0); PG8_BAR; PG8_MMA(0, 0, At, B0); PG8_MMA(0, 1, At, B1); PG8_BAR; PG8_SCHED;
            PG8_LDA(At, 0, 1); PG8_STAGE(PG8_SB(0, 0), b2, voffB); PG8_STAGE(PG8_SB(0, 1), b2 + hstep, voffB); PG8_STAGE(PG8_SA(0, 0), a2, voffA);
            PG8_WAIT_V(8); PG8_WAIT_L(0); PG8_BAR; PG8_MMA(1, 0, At, B0); PG8_MMA(1, 1, At, B1); PG8_BAR; PG8_SCHED;
            PG8_LDB(B0, 1, 0); PG8_LDB(B1, 1, 1); PG8_SCHED; PG8_LDA(At, 1, 0); PG8_STAGE(PG8_SA(0, 1), a2 + hstep, voffA);
            PG8_WAIT_V(8); PG8_WAIT_L(0); PG8_BAR; PG8_MMA(0, 0, At, B0); PG8_MMA(0, 1, At, B1); PG8_BAR; PG8_SCHED;
            PG8_LDA(At, 1, 1); PG8_STAGE(PG8_SB(1, 0), b3, voffB); PG8_STAGE(PG8_SB(1, 1), b3 + hstep, voffB); PG8_STAGE(PG8_SA(1, 0), a3, voffA);
            PG8_WAIT_V(8); PG8_WAIT_L(0); PG8_BAR; PG8_MMA(1, 0, At, B0); PG8_MMA(1, 1, At, B1); PG8_BAR; PG8_SCHED;
            } else {
            PG8_LDB(B0, 0, 0); PG8_SCHED; PG8_LDA(At, 0, 0); PG8_STAGE(PG8_SA(1, 1), a1 + hstep, voffA);
            PG8_WAIT_L(8); PG8_BAR; PG8_WAIT_L(0); PG8_MMA(0, 0, At, B0); PG8_BAR; PG8_SCHED;
            PG8_LDB(B1, 0, 1); PG8_STAGE(PG8_SB(0, 0), b2, voffB);
            PG8_BAR; PG8_WAIT_L(0); PG8_MMA(0, 1, At, B1); PG8_BAR;
            PG8_LDA(At, 0, 1); PG8_STAGE(PG8_SA(0, 0), a2, voffA);
            PG8_BAR; PG8_WAIT_L(0); PG8_MMA(1, 0, At, B0); PG8_BAR; PG8_SCHED;
            PG8_STAGE(PG8_SB(0, 1), b2 + hstep, voffB);
            PG8_WAIT_V(6); PG8_BAR; PG8_MMA(1, 1, At, B1); PG8_BAR;
            PG8_LDB(B0, 1, 0); PG8_SCHED; PG8_LDA(At, 1, 0); PG8_STAGE(PG8_SA(0, 1), a2 + hstep, voffA);
            PG8_WAIT_L(8); PG8_BAR; PG8_WAIT_L(0); PG8_MMA(0, 0, At, B0); PG8_BAR; PG8_SCHED;
            PG8_LDB(B1, 1, 1); PG8_STAGE(PG8_SB(1, 0), b3, voffB);
            PG8_BAR; PG8_WAIT_L(0); PG8_MMA(0, 1, At, B1); PG8_BAR;
            PG8_LDA(At, 1, 1); PG8_STAGE(PG8_SA(1, 0), a3, voffA);
            PG8_BAR; PG8_WAIT_L(0); PG8_MMA(1, 0, At, B0); PG8_BAR; PG8_SCHED;
            PG8_STAGE(PG8_SB(1, 1), b3 + hstep, voffB);
            PG8_WAIT_V(6); PG8_BAR; PG8_MMA(1, 1, At, B1); PG8_BAR;
            }
        }
        if constexpr (ALIGN_EPI) { if (wr == 0) PG8_BAR; }
        if constexpr (!Epi::AFTER_DRAIN) { E(acc, cur, wr, wc, fr, fq); S.done(cur); }
        if (!has_next) break;
#pragma unroll
        for (int a = 0; a < 2; ++a)
#pragma unroll
            for (int b = 0; b < 2; ++b)
#pragma unroll
                for (int m = 0; m < 4; ++m)
#pragma unroll
                    for (int n = 0; n < 2; ++n) acc[a][b][m][n] = (f32x4){0.f, 0.f, 0.f, 0.f};
        cur = nxt; cA = nA; cB = nB; ++ui;
        if constexpr (ALIGN_EPI) { if (wr == 1) PG8_BAR; }
    }
    PG8_WAIT_V(0);
    if constexpr (!ALIGN_EPI) { if (wr == 0) PG8_BAR; }
    PG8_BAR;
    if constexpr (Epi::AFTER_DRAIN) { E.fused(acc, cur, wr, wc, fr, fq, lds, wid, lane); S.done(cur); }
#undef PG8_SA
#undef PG8_SB
#undef PG8_STAGE
#undef PG8_LDA
#undef PG8_LDB
#undef PG8_MMA
#undef PG8_WAIT_V
#undef PG8_WAIT_L
#undef PG8_BAR
#undef PG8_SCHED
}
}
#define GAS __attribute__((address_space(1)))
#define LAS __attribute__((address_space(3)))
typedef unsigned short bf16;
typedef unsigned v4u __attribute__((ext_vector_type(4)));
typedef unsigned v2u __attribute__((ext_vector_type(2)));
typedef float f32x4 __attribute__((ext_vector_type(4)));
typedef short bf16x8 __attribute__((ext_vector_type(8)));
#ifndef REP_HG
#define REP_HG 1
#endif
#ifndef REP_RW
#define REP_RW 1
#endif
#ifndef REP_UP
#define REP_UP 1
#endif
#ifndef REP_ATT
#define REP_ATT 1
#endif
#ifndef REP_PRO
#define REP_PRO 1
#endif
#ifndef REP_G1
#define REP_G1 1
#endif
#ifndef REP_G2
#define REP_G2 1
#endif
#ifndef REP_SC
#define REP_SC 1
#endif
#ifndef REP_DN
#define REP_DN 1
#endif
#ifndef REP_OUT
#define REP_OUT 1
#endif
#ifndef REP_HGL
#define REP_HGL 1
#endif
#ifndef REP_IN
#define REP_IN 1
#endif
#ifndef REP_SYNC
#define REP_SYNC 1
#endif
#define GRID_SYNC() do { for (int r_ = 0; r_ < REP_SYNC; ++r_) xcd_barrier(xbar); } while (0)
constexpr int NWAVES = 8, NTHR = 512;
constexpr int M = 32768, D = 1024, SEQ = 8192, FF = 4096;
constexpr size_t MiB = 1u << 20;
constexpr size_t WS_BAR = 64 * 1024, WS_BAR_BYTES = 16 * 1024;
constexpr size_t WS_LBK = 0;
constexpr size_t WS_RS = 1 * MiB;
constexpr size_t WS_WA = 4 * MiB, WS_WB = 18 * MiB, WS_WO = 20 * MiB, WS_WUP = 22 * MiB, WS_WDN = 30 * MiB;
constexpr size_t WS_HB = 38 * MiB;
constexpr size_t WS_BIG = 102 * MiB;
constexpr size_t SLOT = 64 * MiB;
constexpr size_t WS_END = 512 * MiB;
constexpr int LDS_BYTES = 163840;
constexpr float LOG2E_F = 1.4426950408889634f;

#define LDS_WAIT() asm volatile("s_waitcnt lgkmcnt(0)" ::: "memory")
typedef float f32x2_t __attribute__((ext_vector_type(2))); typedef __bf16 bf16x2_t __attribute__((ext_vector_type(2)));
__device__ __forceinline__ unsigned pk2(float lo, float hi) { const f32x2_t v = {lo, hi}; const bf16x2_t b = __builtin_convertvector(v, bf16x2_t); return __builtin_bit_cast(unsigned, b); }
__device__ __forceinline__ unsigned f2bf(float f) { return pk2(f, 0.f) & 0xffffu; }
__device__ __forceinline__ float bflo(unsigned u) { return __builtin_bit_cast(float, u << 16); }
__device__ __forceinline__ float bfhi(unsigned u) { return __builtin_bit_cast(float, u & 0xffff0000u); }
__device__ __forceinline__ float bf1(unsigned short b) { return __builtin_bit_cast(float, (unsigned)b << 16); }
__device__ __forceinline__ f32x4 bf4(v2u u) { return (f32x4){bflo(u.x), bfhi(u.x), bflo(u.y), bfhi(u.y)}; }
__device__ __forceinline__ float wave_sum(float v) {
#pragma unroll
    for (int o = 1; o < 64; o <<= 1) v += __shfl_xor(v, o);
    return v;
}
template <int CTRL> __device__ __forceinline__ float dpp_f(float x) { return __builtin_bit_cast(float, __builtin_amdgcn_update_dpp(0, __builtin_bit_cast(int, x), CTRL, 0xf, 0xf, true)); }
__device__ __forceinline__ float row16_sum(float x) { x += dpp_f<0xB1>(x); x += dpp_f<0x4E>(x); x += dpp_f<0x141>(x); x += dpp_f<0x140>(x); return x; }

__device__ __forceinline__ void wt_item(const float* W, int K, int N, bf16* WT, int ld, int row_off, int col_off, const float* sc, LAS float* scr, int item, int lane) {
    const int nblk = N / 32, kb = item / nblk, nb = item % nblk, k0 = 64 * kb, n0 = 32 * nb;
    f32x4 wv[8]; float sv[8];
#pragma unroll
    for (int i = 0; i < 8; ++i) { const int kk = 8 * i + (lane >> 3); wv[i] = *(const f32x4*)(W + (size_t)(k0 + kk) * N + n0 + 4 * (lane & 7)); sv[i] = sc ? sc[k0 + kk] : 1.f; }
#pragma unroll
    for (int i = 0; i < 8; ++i) { const int kk = 8 * i + (lane >> 3); LAS float* d = scr + kk * 33 + 4 * (lane & 7); d[0] = wv[i][0] * sv[i]; d[1] = wv[i][1] * sv[i]; d[2] = wv[i][2] * sv[i]; d[3] = wv[i][3] * sv[i]; }
    LDS_WAIT(); asm volatile("" ::: "memory");
    const int c = lane & 7;
#pragma unroll
    for (int j = 0; j < 4; ++j) { const int n = (lane >> 3) + 8 * j; const LAS float* s = scr + (8 * c) * 33 + n;
        v4u o; o.x = pk2(s[0 * 33], s[1 * 33]); o.y = pk2(s[2 * 33], s[3 * 33]); o.z = pk2(s[4 * 33], s[5 * 33]); o.w = pk2(s[6 * 33], s[7 * 33]);
        *(v4u*)(WT + (size_t)(row_off + n0 + n) * ld + col_off + k0 + 8 * c) = o; }
    LDS_WAIT(); asm volatile("" ::: "memory");
}
__device__ __forceinline__ void conv_mat(const float* W, int K, int N, bf16* WT, int ld, int row_off, int col_off, const float* sc, LAS float* scr, int gw, int ngw, int lane) {
    const int nitems = (K / 64) * (N / 32);
    for (int it = gw; it < nitems; it += ngw) wt_item(W, K, N, WT, ld, row_off, col_off, sc, scr, it, lane);
}

__device__ __forceinline__ void attn_phase(const bf16* Q, const bf16* K, const bf16* V, bf16* O, int gw, int ngw, int lane) {
    const int fr = lane & 15, fq = lane >> 4;
    for (int unit = gw; unit < (M / 16) * 16; unit += ngw) {
        const int qt = unit & 511, bh = unit >> 9, h = bh & 15, b = bh >> 4;
        const int t0 = qt * 16; const size_t rowb = (size_t)b * SEQ;
        const bf16* qp = Q + (rowb + t0 + fr) * 1024 + h * 64 + fq * 8;
        const bf16x8 qb0 = *(const bf16x8*)(qp), qb1 = *(const bf16x8*)(qp + 32);
        f32x4 o[4];
#pragma unroll
        for (int dt = 0; dt < 4; ++dt) o[dt] = (f32x4){0.f, 0.f, 0.f, 0.f};
        float carry = 1.f;
        const int tq = t0 + fr;
        bf16x8 kn0, kn1; unsigned short vn[4][4];
#define ATT_LOAD(SH) { int sk_ = (SH) - fr; sk_ = sk_ < 0 ? 0 : sk_; const bf16* kp_ = K + (rowb + sk_) * 1024 + h * 64 + fq * 8; kn0 = *(const bf16x8*)(kp_); kn1 = *(const bf16x8*)(kp_ + 32); \
            _Pragma("unroll") for (int j = 0; j < 4; ++j) { int sv_ = (SH) - (4 * fq + j); sv_ = sv_ < 0 ? 0 : sv_; const bf16* vp_ = V + (rowb + sv_) * 1024 + h * 64 + fr; \
                _Pragma("unroll") for (int dt = 0; dt < 4; ++dt) vn[dt][j] = vp_[16 * dt]; } }
        ATT_LOAD(t0 + 14)
        for (int s_hi = t0 + 14; s_hi >= 0; s_hi -= 16) {
            const bf16x8 ka0 = kn0, ka1 = kn1;
            unsigned short vv[4][4];
#pragma unroll
            for (int j = 0; j < 4; ++j)
#pragma unroll
                for (int dt = 0; dt < 4; ++dt) vv[dt][j] = vn[dt][j];
            ATT_LOAD(s_hi - 16)
            f32x4 z = (f32x4){0.f, 0.f, 0.f, 0.f};
            z = __builtin_amdgcn_mfma_f32_16x16x32_bf16(ka0, qb0, z, 0, 0, 0);
            z = __builtin_amdgcn_mfma_f32_16x16x32_bf16(ka1, qb1, z, 0, 0, 0);
            float dd[4], sg[4];
#pragma unroll
            for (int i = 0; i < 4; ++i) {
                const int s = s_hi - (4 * fq + i);
                const bool valid = (s >= 0) && (s < tq);
                const float e = __builtin_amdgcn_exp2f(fminf(z[i], 100.f));
                const float d = __builtin_amdgcn_rcpf(1.0f + e);
                dd[i] = valid ? d : 1.f; sg[i] = valid ? e * d : 0.f;
            }
            const float c1 = dd[0], c2 = c1 * dd[1], c3 = c2 * dd[2], g = c3 * dd[3];
            const float g0 = __shfl(g, fr), g1 = __shfl(g, fr + 16), g2 = __shfl(g, fr + 32), g3 = __shfl(g, fr + 48);
            float pre = carry;
            if (fq > 0) pre *= g0;
            if (fq > 1) pre *= g1;
            if (fq > 2) pre *= g2;
            carry = carry * ((g0 * g1) * (g2 * g3));
            const float p0 = sg[0] * pre, p1 = sg[1] * (pre * c1), p2 = sg[2] * (pre * c2), p3 = sg[3] * (pre * c3);
            bf16x8 pb; { const unsigned w0 = pk2(p0, p1), w1 = pk2(p2, p3); pb[0] = (short)(w0 & 0xffff); pb[1] = (short)(w0 >> 16); pb[2] = (short)(w1 & 0xffff); pb[3] = (short)(w1 >> 16); pb[4] = 0; pb[5] = 0; pb[6] = 0; pb[7] = 0; }
#pragma unroll
            for (int dt = 0; dt < 4; ++dt) {
                bf16x8 va; va[0] = (short)vv[dt][0]; va[1] = (short)vv[dt][1]; va[2] = (short)vv[dt][2]; va[3] = (short)vv[dt][3]; va[4] = 0; va[5] = 0; va[6] = 0; va[7] = 0;
                o[dt] = __builtin_amdgcn_mfma_f32_16x16x32_bf16(va, pb, o[dt], 0, 0, 0);
            }
            if (__builtin_amdgcn_ballot_w64(carry != 0.f) == 0ull) break;
        }
#undef ATT_LOAD
        bf16* op = O + (rowb + t0 + fr) * 1024 + h * 64 + fq * 4;
#pragma unroll
        for (int dt = 0; dt < 4; ++dt) { v2u w; w.x = pk2(o[dt][0], o[dt][1]); w.y = pk2(o[dt][2], o[dt][3]); *(v2u*)(op + 16 * dt) = w; }
    }
}

typedef unsigned u32x4_t __attribute__((ext_vector_type(4)));
__device__ __forceinline__ bf16x8 mk8(unsigned a, unsigned b, unsigned c, unsigned d) { const u32x4_t t = {a, b, c, d}; return __builtin_bit_cast(bf16x8, t); }
__device__ __forceinline__ void hg_prep_item(bf16* QS, bf16* KF, bf16* KT, float* DB, int chunk, int c) {
    {
        const size_t base = (size_t)chunk * 16 * 1024 + c;
        v2u kin[16], qin[16];
#pragma unroll
        for (int t = 0; t < 16; ++t) { kin[t] = *(const v2u*)(KF + base + (size_t)t * 1024); qin[t] = *(const v2u*)(QS + base + (size_t)t * 1024); }
        float b[4] = {0.f, 0.f, 0.f, 0.f};
        unsigned ktp[4][8];
#pragma unroll
        for (int t2 = 0; t2 < 8; ++t2) {
            float kt2[2][4];
#pragma unroll
            for (int u = 0; u < 2; ++u) {
                const int t = 2 * t2 + u;
                const f32x4 kf = bf4(kin[t]), q = bf4(qin[t]);
                float qt[4];
#pragma unroll
                for (int j = 0; j < 4; ++j) {
                    const float fdec = fmaxf(1.0f - kf[j], 1e-4f);
                    b[j] += __builtin_amdgcn_logf(fdec);
                    const float e = __builtin_amdgcn_exp2f(b[j]);
                    qt[j] = q[j] * e; kt2[u][j] = kf[j] * __builtin_amdgcn_rcpf(e);
                }
                v2u qo; qo.x = pk2(qt[0], qt[1]); qo.y = pk2(qt[2], qt[3]); *(v2u*)(QS + base + (size_t)t * 1024) = qo;
                v2u ko; ko.x = pk2(kt2[u][0], kt2[u][1]); ko.y = pk2(kt2[u][2], kt2[u][3]); *(v2u*)(KF + base + (size_t)t * 1024) = ko;
            }
#pragma unroll
            for (int j = 0; j < 4; ++j) ktp[j][t2] = pk2(kt2[0][j], kt2[1][j]);
        }
        f32x4 dv; dv[0] = __builtin_amdgcn_exp2f(b[0]); dv[1] = __builtin_amdgcn_exp2f(b[1]); dv[2] = __builtin_amdgcn_exp2f(b[2]); dv[3] = __builtin_amdgcn_exp2f(b[3]);
        *(f32x4*)(DB + (size_t)chunk * 1024 + c) = dv;
#pragma unroll
        for (int j = 0; j < 4; ++j) { v4u* kp = (v4u*)(KT + ((size_t)chunk * 1024 + c + j) * 16);
            kp[0] = (v4u){ktp[j][0], ktp[j][1], ktp[j][2], ktp[j][3]}; kp[1] = (v4u){ktp[j][4], ktp[j][5], ktp[j][6], ktp[j][7]}; }
    }
}
__device__ __forceinline__ void hg_local(bf16* QS, bf16* KF, bf16* KT, const bf16* IV, float* DB, float* SL, float* DT) {
    int tid_ = threadIdx.x; asm volatile("" : "+v"(tid_)); const int tid = tid_, lane = tid & 63, w = __builtin_amdgcn_readfirstlane(tid >> 6), fr = lane & 15, fq = lane >> 4;
    for (int unit = blockIdx.x; unit < 256; unit += gridDim.x) {
        const int seg = unit & 7, bh = unit >> 3, h = bh & 7, b = bh >> 3;
#pragma unroll 1
        for (int ps = 0; ps < 4; ++ps) hg_prep_item(QS, KF, KT, DB, (int)((((size_t)b * SEQ + (size_t)seg * 1024) >> 4) + 16 * ps + 2 * w + (lane >> 5)), 128 * h + 4 * (lane & 31));
        asm volatile("s_waitcnt vmcnt(0)" ::: "memory"); __syncthreads();
        if (seg == 7) continue;
        f32x4 S[8], DTt[8];
#pragma unroll
        for (int kt = 0; kt < 8; ++kt) { S[kt] = (f32x4){0.f, 0.f, 0.f, 0.f}; DTt[kt] = (f32x4){1.f, 1.f, 1.f, 1.f}; }
        const size_t m0 = (size_t)b * SEQ + (size_t)seg * 1024;
        v2u kt1[8], kt2[8]; f32x4 d1[8], d2[8]; unsigned short v1_[4], v2_[4];
#define HGL_LOAD(KTV, DV, VV, CJ) { const int cj_ = (CJ) < 64 ? (CJ) : 63; const size_t chunk_ = (m0 >> 4) + cj_, mrow_ = m0 + 16 * cj_; \
          _Pragma("unroll") for (int kt = 0; kt < 8; ++kt) { KTV[kt] = *(const v2u*)(KT + (chunk_ * 1024 + 128 * h + 16 * kt + fr) * 16 + 4 * fq); DV[kt] = *(const f32x4*)(DB + chunk_ * 1024 + 128 * h + 16 * kt + 4 * fq); } \
          const bf16* vp_ = IV + (mrow_ + 4 * fq) * 1024 + 128 * h + 16 * w + fr; VV[0] = vp_[0]; VV[1] = vp_[1024]; VV[2] = vp_[2048]; VV[3] = vp_[3072]; }
        HGL_LOAD(kt1, d1, v1_, 0) HGL_LOAD(kt2, d2, v2_, 1)
        for (int ci = 0; ci < 64; ++ci) {
            v2u ktv[8]; f32x4 dv[8];
#pragma unroll
            for (int kt = 0; kt < 8; ++kt) { ktv[kt] = kt1[kt]; dv[kt] = d1[kt]; kt1[kt] = kt2[kt]; d1[kt] = d2[kt]; }
            const unsigned v0 = v1_[0], v1 = v1_[1], v2 = v1_[2], v3 = v1_[3];
#pragma unroll
            for (int x = 0; x < 4; ++x) v1_[x] = v2_[x];
            HGL_LOAD(kt2, d2, v2_, ci + 2)
            const bf16x8 vb = mk8(v0 | (v1 << 16), v2 | (v3 << 16), 0u, 0u);
#pragma unroll
            for (int kt = 0; kt < 8; ++kt) { S[kt] = __builtin_amdgcn_mfma_f32_16x16x32_bf16(mk8(ktv[kt].x, ktv[kt].y, 0u, 0u), vb, S[kt], 0, 0, 0); S[kt] = S[kt] * dv[kt]; DTt[kt] = DTt[kt] * dv[kt]; }
        }
#undef HGL_LOAD
#pragma unroll
        for (int kt = 0; kt < 8; ++kt) {
#pragma unroll
            for (int i = 0; i < 4; ++i) SL[((size_t)(bh * 8 + seg) * 128 + 16 * kt + 4 * fq + i) * 128 + 16 * w + fr] = S[kt][i];
            if (w == 0 && fr == 0) *(f32x4*)(DT + (size_t)(bh * 8 + seg) * 128 + 16 * kt + 4 * fq) = DTt[kt];
        }
    }
}
__device__ __forceinline__ void hg_out(const bf16* QT, const bf16* KTL, const bf16* KT, const bf16* IV, const float* DB, const float* SL, const float* DT, const float* norm_g, bf16* SGO, LAS unsigned char* lds) {
    int tid_ = threadIdx.x; asm volatile("" : "+v"(tid_)); const int tid = tid_, lane = tid & 63, w = __builtin_amdgcn_readfirstlane(tid >> 6), fr = lane & 15, fq = lane >> 4;
    LAS float* ssb = (LAS float*)lds;
    for (int unit = blockIdx.x; unit < 256; unit += gridDim.x) {
        const int seg = unit & 7, bh = unit >> 3, h = bh & 7, b = bh >> 3;
        f32x4 S[8];
#pragma unroll
        for (int kt = 0; kt < 8; ++kt) S[kt] = (f32x4){0.f, 0.f, 0.f, 0.f};
        for (int j = 0; j < seg; ++j) {
#pragma unroll
            for (int kt = 0; kt < 8; ++kt) {
                const f32x4 dt = *(const f32x4*)(DT + (size_t)(bh * 8 + j) * 128 + 16 * kt + 4 * fq);
#pragma unroll
                for (int i = 0; i < 4; ++i) S[kt][i] = S[kt][i] * dt[i] + SL[((size_t)(bh * 8 + j) * 128 + 16 * kt + 4 * fq + i) * 128 + 16 * w + fr];
            }
        }
        const float ng = norm_g[128 * h + 16 * w + fr];
        const size_t m0 = (size_t)b * SEQ + (size_t)seg * 1024;
        v2u qn[8], kn[8];
        { const bf16* qp = QT + (m0 + fr) * 1024 + 128 * h + 4 * fq; const bf16* kp = KTL + (m0 + fr) * 1024 + 128 * h + 4 * fq;
#pragma unroll
          for (int x = 0; x < 8; ++x) { qn[x] = *(const v2u*)(qp + 16 * x); kn[x] = *(const v2u*)(kp + 16 * x); } }
        unsigned short vn[4], gn[4];
        { const bf16* vp = IV + (m0 + 4 * fq) * 1024 + 128 * h + 16 * w + fr; const bf16* gq = SGO + (m0 + 4 * fq) * 1024 + 128 * h + 16 * w + fr;
          vn[0] = vp[0]; vn[1] = vp[1024]; vn[2] = vp[2048]; vn[3] = vp[3072]; gn[0] = gq[0]; gn[1] = gq[1024]; gn[2] = gq[2048]; gn[3] = gq[3072]; }
        for (int ci = 0; ci < 64; ++ci) {
            const size_t chunk = (m0 >> 4) + ci, mrow = m0 + 16 * ci;
            v2u ktv[8]; f32x4 dv[8];
#pragma unroll
            for (int kt = 0; kt < 8; ++kt) { ktv[kt] = *(const v2u*)(KT + (chunk * 1024 + 128 * h + 16 * kt + fr) * 16 + 4 * fq); dv[kt] = *(const f32x4*)(DB + chunk * 1024 + 128 * h + 16 * kt + 4 * fq); }
            const unsigned v0 = vn[0], v1 = vn[1], v2 = vn[2], v3 = vn[3];
            bf16* gp = SGO + (mrow + 4 * fq) * 1024 + 128 * h + 16 * w + fr;
            const float sg0 = bf1(gn[0]), sg1 = bf1(gn[1]), sg2 = bf1(gn[2]), sg3 = bf1(gn[3]);
            { const size_t mn = m0 + 16 * (ci + 1 < 64 ? ci + 1 : ci); const bf16* vp = IV + (mn + 4 * fq) * 1024 + 128 * h + 16 * w + fr; const bf16* gq = SGO + (mn + 4 * fq) * 1024 + 128 * h + 16 * w + fr;
              if (ci + 1 < 64) { vn[0] = vp[0]; vn[1] = vp[1024]; vn[2] = vp[2048]; vn[3] = vp[3072]; gn[0] = gq[0]; gn[1] = gq[1024]; gn[2] = gq[2048]; gn[3] = gq[3072]; } }
            v2u qc[8], kc[8];
#pragma unroll
            for (int x = 0; x < 8; ++x) { qc[x] = qn[x]; kc[x] = kn[x]; }
            { const size_t mn = m0 + 16 * (ci + 1 < 64 ? ci + 1 : ci); const bf16* qp = QT + (mn + fr) * 1024 + 128 * h + 4 * fq; const bf16* kp = KTL + (mn + fr) * 1024 + 128 * h + 4 * fq;
#pragma unroll
              for (int x = 0; x < 8; ++x) { qn[x] = *(const v2u*)(qp + 16 * x); kn[x] = *(const v2u*)(kp + 16 * x); } }
            const bf16x8 vb = mk8(v0 | (v1 << 16), v2 | (v3 << 16), 0u, 0u);
            f32x4 pt = (f32x4){0.f, 0.f, 0.f, 0.f};
#pragma unroll
            for (int p = 0; p < 4; ++p) pt = __builtin_amdgcn_mfma_f32_16x16x32_bf16(mk8(kc[2 * p].x, kc[2 * p].y, kc[2 * p + 1].x, kc[2 * p + 1].y), mk8(qc[2 * p].x, qc[2 * p].y, qc[2 * p + 1].x, qc[2 * p + 1].y), pt, 0, 0, 0);
#pragma unroll
            for (int i = 0; i < 4; ++i) if (4 * fq + i > fr) pt[i] = 0.f;
            f32x4 o = (f32x4){0.f, 0.f, 0.f, 0.f};
#pragma unroll
            for (int p = 0; p < 4; ++p) {
                const bf16x8 sb = mk8(pk2(S[2 * p][0], S[2 * p][1]), pk2(S[2 * p][2], S[2 * p][3]), pk2(S[2 * p + 1][0], S[2 * p + 1][1]), pk2(S[2 * p + 1][2], S[2 * p + 1][3]));
                o = __builtin_amdgcn_mfma_f32_16x16x32_bf16(mk8(qc[2 * p].x, qc[2 * p].y, qc[2 * p + 1].x, qc[2 * p + 1].y), sb, o, 0, 0, 0);
            }
            o = __builtin_amdgcn_mfma_f32_16x16x32_bf16(mk8(pk2(pt[0], pt[1]), pk2(pt[2], pt[3]), 0u, 0u), vb, o, 0, 0, 0);
#pragma unroll
            for (int kt = 0; kt < 8; ++kt) { S[kt] = __builtin_amdgcn_mfma_f32_16x16x32_bf16(mk8(ktv[kt].x, ktv[kt].y, 0u, 0u), vb, S[kt], 0, 0, 0); S[kt] = S[kt] * dv[kt]; }
            LAS float* sb_ = ssb + (ci & 1) * 128;
#pragma unroll
            for (int i = 0; i < 4; ++i) { const float ss = row16_sum(o[i] * o[i]); if (fr == 0) sb_[(4 * fq + i) * 8 + w] = ss; }
            __syncthreads();
            const float sgv[4] = {sg0, sg1, sg2, sg3};
#pragma unroll
            for (int i = 0; i < 4; ++i) {
                const f32x4 a0 = *(const LAS f32x4*)(sb_ + (4 * fq + i) * 8), a1 = *(const LAS f32x4*)(sb_ + (4 * fq + i) * 8 + 4);
                const float tot = ((a0[0] + a0[1]) + (a0[2] + a0[3])) + ((a1[0] + a1[1]) + (a1[2] + a1[3]));
                const float r = 1.0f / sqrtf(tot * (1.0f / 128.0f) + 1e-6f);
                gp[(size_t)i * 1024] = (bf16)f2bf(o[i] * r * ng * sgv[i]);
            }
        }
        __syncthreads();
    }
}

__device__ __forceinline__ void rw_prep(const bf16* h, const float* rs, const float* g, bf16* A2, int gw, int ngw, int lane) {
    for (int it = gw; it < M / 2; it += ngw) {
        const int m = 2 * it, t = m & (SEQ - 1);
        const int mp = t ? m - 1 : m;
        f32x4 x[3][4], pr[3];
#pragma unroll
        for (int u = 0; u < 3; ++u) { const int mm = u == 0 ? mp : m + u - 1; pr[u] = *(const f32x4*)(rs + (size_t)mm * 16 + 4 * (lane & 3));
#pragma unroll
            for (int j = 0; j < 4; ++j) x[u][j] = bf4(*(const v2u*)(h + (size_t)mm * 1024 + 4 * lane + 256 * j)); }
        float r3[3];
#pragma unroll
        for (int u = 0; u < 3; ++u) { float s = (pr[u][0] + pr[u][1]) + (pr[u][2] + pr[u][3]); s += dpp_f<0xB1>(s); s += dpp_f<0x4E>(s); r3[u] = 1.0f / sqrtf(s * (1.0f / 1024.0f) + 1e-6f); }
        if (t == 0) r3[0] = 0.f;
#pragma unroll
        for (int j = 0; j < 4; ++j) {
            const int c = 4 * lane + 256 * j;
            const f32x4 gc = *(const f32x4*)(g + c);
            const f32x4 xp = x[0][j] * gc * r3[0], x0 = x[1][j] * gc * r3[1], x1 = x[2][j] * gc * r3[2];
            const f32x4 d0 = xp - x0, d1 = x0 - x1;
            v2u o;
            o.x = pk2(x0[0], x0[1]); o.y = pk2(x0[2], x0[3]); *(v2u*)(A2 + (size_t)m * 2048 + c) = o;
            o.x = pk2(d0[0], d0[1]); o.y = pk2(d0[2], d0[3]); *(v2u*)(A2 + (size_t)m * 2048 + 1024 + c) = o;
            o.x = pk2(x1[0], x1[1]); o.y = pk2(x1[2], x1[3]); *(v2u*)(A2 + (size_t)(m + 1) * 2048 + c) = o;
            o.x = pk2(d1[0], d1[1]); o.y = pk2(d1[2], d1[3]); *(v2u*)(A2 + (size_t)(m + 1) * 2048 + 1024 + c) = o;
        }
    }
}
constexpr int RWS_AH = 0, RWS_RB = 2048, RWS_KGT = 4096, RWS_BGT = 6144, RWS_G15 = 8192, RWS_KNI = 8448, RWS_WVI = 9472, RWS_VCI = 10496, RWS_SLOT = 11264;
constexpr int RWT_AB = 0, RWT_BT = 2048, RWT_KT = 4096, RWT_ABT = 6144, RWT_NM = 0  , RWT_TM = 2048  , RWT_BYTES = 8192;
__device__ __forceinline__ int rwz(int k) { return (k & ~7) | ((k & 7) ^ ((k >> 3) & 7)); }
constexpr int RW_NSLOT = 9, RW_NPROD = 7, RW_RING = RW_NSLOT * RWS_SLOT, RW_FLAGS = RW_RING + RW_NPROD * RWT_BYTES;
struct RwRaw4 { v2u r[4], k[4], wm[4], a[4]; unsigned short v[4]; };
__device__ __forceinline__ void rw_load4(RwRaw4& x, const bf16* R, const bf16* K, const bf16* V, const bf16* WM, const bf16* A, size_t m, int ch, int vch) {
#pragma unroll
    for (int j = 0; j < 4; ++j) { const size_t off = (m + j) * 1024 + ch;
        x.r[j] = *(const v2u*)(R + off); x.k[j] = *(const v2u*)(K + off); x.wm[j] = *(const v2u*)(WM + off); x.a[j] = *(const v2u*)(A + off); x.v[j] = V[(m + j) * 1024 + vch]; }
}
__device__ __forceinline__ bf16x8 lds_op16(const LAS unsigned char* mtx, int row, int kbyte) { return *(const LAS bf16x8*)(mtx + row * 128 + kbyte); }
__device__ __forceinline__ v2u lds_8(const LAS unsigned char* p) { return *(const LAS v2u*)p; }
__device__ __forceinline__ void rw_scan(const bf16* R, const bf16* K, const bf16* V, const bf16* WM, const bf16* A, const float* k_k, const float* k_a, bf16* Y, LAS unsigned char* lds) {
    int tid_ = threadIdx.x; asm volatile("" : "+v"(tid_)); const int tid = tid_, lane = tid & 63, w = __builtin_amdgcn_readfirstlane(tid >> 6);
    const int fr = lane & 15, fq = lane >> 4;
    constexpr int NCH = SEQ / 16;
    for (int unit = blockIdx.x; unit < 256; unit += gridDim.x) {
        const int rg = unit & 3, h = (unit >> 2) & 15, b = unit >> 6;
        const size_t row0 = (size_t)b * SEQ;
        volatile LAS unsigned* flg = (volatile LAS unsigned*)(lds + RW_FLAGS);
        if (tid < 16) flg[tid] = 0u;
        __syncthreads();
        if (w >= 1) {
            const int pw = w - 1, ch = 64 * h + 4 * fr, vch = 64 * h + 16 * rg + fr;
            LAS unsigned char* tmp = lds + RW_RING + pw * RWT_BYTES;
            const f32x4 kkc = *(const f32x4*)(k_k + ch), kac = *(const f32x4*)(k_a + ch);
            RwRaw4 nx; rw_load4(nx, R, K, V, WM, A, row0 + 16 * pw + 4 * fq, ch, vch);
            for (int cj = pw; cj < NCH; cj += RW_NPROD) {
                {
                    const RwRaw4 cu = nx;
                    { const int cn = cj + RW_NPROD < NCH ? cj + RW_NPROD : cj; rw_load4(nx, R, K, V, WM, A, row0 + 16 * (size_t)cn + 4 * fq, ch, vch); }
                    while ((int)flg[RW_NSLOT] < cj - (RW_NSLOT - 1)) __builtin_amdgcn_s_sleep(2);
                    asm volatile("" ::: "memory");
                    LAS unsigned char* slot = lds + (cj % RW_NSLOT) * RWS_SLOT;
                    f32x4 wv[4], kk[4], km[4], be[4], rr[4];
#pragma unroll
                    for (int j = 0; j < 4; ++j) {
                        const f32x4 r = bf4(cu.r[j]), k = bf4(cu.k[j]), wm = bf4(cu.wm[j]), a = bf4(cu.a[j]);
                        const f32x4 kr = k * kkc;
                        const float n2 = row16_sum((kr[0] * kr[0] + kr[1] * kr[1]) + (kr[2] * kr[2] + kr[3] * kr[3]));
                        const float inv = 1.0f / fmaxf(sqrtf(n2), 1e-12f);
                        kk[j] = kr * inv; be[j] = kk[j] * a; km[j] = k * (1.0f + (a - 1.0f) * kac); wv[j] = 1.0f - wm; rr[j] = r;
                    }
                    f32x4 g[4]; g[0] = wv[0]; g[1] = g[0] * wv[1]; g[2] = g[1] * wv[2]; g[3] = g[2] * wv[3];
                    f32x4 pre = (f32x4){1.f, 1.f, 1.f, 1.f}, all = (f32x4){1.f, 1.f, 1.f, 1.f};
#pragma unroll
                    for (int x = 0; x < 4; ++x) {
                        const float t0 = __shfl(g[3][x], fr), t1 = __shfl(g[3][x], 16 + fr), t2 = __shfl(g[3][x], 32 + fr), t3 = __shfl(g[3][x], 48 + fr);
                        float p = 1.f; if (fq > 0) p *= t0; if (fq > 1) p *= t1; if (fq > 2) p *= t2;
                        pre[x] = p; all[x] = (t0 * t1) * (t2 * t3);
                    }
                    unsigned kgp[4][2], bgp[4][2], abp[4][2];
                    float kgt[4][4], bgt[4][4], abt[4][4];
#pragma unroll
                    for (int j = 0; j < 4; ++j) {
                        const f32x4 Gs = pre * g[j], Gm = j ? pre * g[j - 1] : pre;
                        f32x4 ginv; ginv[0] = __builtin_amdgcn_rcpf(Gs[0]); ginv[1] = __builtin_amdgcn_rcpf(Gs[1]); ginv[2] = __builtin_amdgcn_rcpf(Gs[2]); ginv[3] = __builtin_amdgcn_rcpf(Gs[3]);
                        const f32x4 alb = kk[j] * Gm, rb = rr[j] * Gs, bet = be[j] * ginv, ktl = km[j] * ginv;
                        const int s = 4 * fq + j;
                        v2u o;
                        o.x = pk2(alb[0], alb[1]); o.y = pk2(alb[2], alb[3]); *(LAS v2u*)(tmp + RWT_AB + s * 128 + 8 * fr) = o;
                        o.x = pk2(bet[0], bet[1]); o.y = pk2(bet[2], bet[3]); *(LAS v2u*)(tmp + RWT_BT + s * 128 + 8 * fr) = o;
                        o.x = pk2(ktl[0], ktl[1]); o.y = pk2(ktl[2], ktl[3]); *(LAS v2u*)(tmp + RWT_KT + s * 128 + 8 * fr) = o;
                        o.x = pk2(rb[0], rb[1]); o.y = pk2(rb[2], rb[3]); *(LAS v2u*)(slot + RWS_RB + s * 128 + 8 * fr) = o;
#pragma unroll
                        for (int x = 0; x < 4; ++x) { kgt[x][j] = ktl[x] * all[x]; bgt[x][j] = -(bet[x] * all[x]); abt[x][j] = alb[x]; }
                    }
#pragma unroll
                    for (int x = 0; x < 4; ++x) {
                        const int kch = 4 * fr + x;
                        v2u o;
                        o.x = pk2(kgt[x][0], kgt[x][1]); o.y = pk2(kgt[x][2], kgt[x][3]); *(LAS v2u*)(slot + RWS_KGT + rwz(kch) * 32 + 8 * fq) = o;
                        o.x = pk2(bgt[x][0], bgt[x][1]); o.y = pk2(bgt[x][2], bgt[x][3]); *(LAS v2u*)(slot + RWS_BGT + rwz(kch) * 32 + 8 * fq) = o;
                        o.x = pk2(abt[x][0], abt[x][1]); o.y = pk2(abt[x][2], abt[x][3]); *(LAS v2u*)(tmp + RWT_ABT + rwz(kch) * 32 + 8 * fq) = o;
                    }
                    if (fq == 0) *(LAS f32x4*)(slot + RWS_G15 + 16 * fr) = all;
                    const unsigned vlo = (unsigned)cu.v[0] | ((unsigned)cu.v[1] << 16), vhi = (unsigned)cu.v[2] | ((unsigned)cu.v[3] << 16);
                    { v2u o; o.x = vlo; o.y = vhi; *(LAS v2u*)(slot + RWS_VCI + 8 * lane) = o; }
                    LDS_WAIT(); asm volatile("" ::: "memory");
                    f32x4 nac = (f32x4){0.f, 0.f, 0.f, 0.f}, kat = nac, krt = nac, nrt = nac;
#pragma unroll
                    for (int p = 0; p < 2; ++p) {
                        const int kb = (32 * p + 8 * fq) * 2;
                        const bf16x8 oAB = lds_op16(tmp + RWT_AB, fr, kb), oBT = lds_op16(tmp + RWT_BT, fr, kb), oKT = lds_op16(tmp + RWT_KT, fr, kb), oRB = lds_op16(slot + RWS_RB, fr, kb);
                        nac = __builtin_amdgcn_mfma_f32_16x16x32_bf16(oBT, oAB, nac, 0, 0, 0);
                        kat = __builtin_amdgcn_mfma_f32_16x16x32_bf16(oKT, oAB, kat, 0, 0, 0);
                        krt = __builtin_amdgcn_mfma_f32_16x16x32_bf16(oKT, oRB, krt, 0, 0, 0);
                        nrt = __builtin_amdgcn_mfma_f32_16x16x32_bf16(oBT, oRB, nrt, 0, 0, 0);
                    }
#pragma unroll
                    for (int i = 0; i < 4; ++i) { const int rr_ = 4 * fq + i;
                        if (rr_ >= fr) { nac[i] = 0.f; kat[i] = 0.f; }
                        if (rr_ > fr) { krt[i] = 0.f; nrt[i] = 0.f; } }
                    { u32x4_t o; o.x = pk2(krt[0], krt[1]); o.y = pk2(krt[2], krt[3]); o.z = pk2(-nrt[0], -nrt[1]); o.w = pk2(-nrt[2], -nrt[3]); *(LAS u32x4_t*)(slot + RWS_KNI + 16 * lane) = o; }
                    LDS_WAIT(); asm volatile("" ::: "memory");
                    *(LAS f32x4*)(tmp + RWT_NM + (fr * 16 + 4 * fq) * 4) = nac;
                    LDS_WAIT(); asm volatile("" ::: "memory");
                    float Tc[16];
                    f32x4 nvv[16][4];
#define RW_LD_ROWS(lo, hi) _Pragma("unroll") for (int s = lo; s <= hi; ++s) _Pragma("unroll") for (int r4 = 0; r4 < (s + 3) / 4; ++r4) nvv[s][r4] = *(const LAS f32x4*)(tmp + RWT_NM + (s * 16 + 4 * r4) * 4);
#define RW_DO_ROWS(lo, hi) _Pragma("unroll") for (int s = lo; s <= hi; ++s) { float acc_ = (s == fr) ? 1.f : 0.f; \
                        _Pragma("unroll") for (int r4 = 0; r4 < (s + 3) / 4; ++r4) _Pragma("unroll") for (int e = 0; e < 4; ++e) if (4 * r4 + e < s) acc_ -= nvv[s][r4][e] * Tc[4 * r4 + e]; \
                        Tc[s] = acc_; }
                    RW_LD_ROWS(1, 8) RW_LD_ROWS(9, 12)
                    asm volatile("" ::: "memory");
                    RW_DO_ROWS(0, 8)
                    RW_LD_ROWS(13, 15)
                    asm volatile("" ::: "memory");
                    RW_DO_ROWS(9, 12)
                    RW_DO_ROWS(13, 15)
#undef RW_LD_ROWS
#undef RW_DO_ROWS
#pragma unroll
                    for (int e = 0; e < 4; ++e) {
                        float tv = Tc[0];
#pragma unroll
                        for (int s = 0; s < 16; ++s) if (s == 4 * fq + e) tv = Tc[s];
                        *(LAS unsigned short*)(tmp + RWT_TM + ((4 * fq + e) * 16 + fr) * 2) = (unsigned short)f2bf(tv);
                    }
                    LDS_WAIT(); asm volatile("" ::: "memory");
                    const v2u tq = lds_8(tmp + RWT_TM + (fr * 16 + 4 * fq) * 2);
                    const bf16x8 opT = mk8(tq.x, tq.y, 0u, 0u);
                    f32x4 xac = __builtin_amdgcn_mfma_f32_16x16x32_bf16(mk8(pk2(kat[0], kat[1]), pk2(kat[2], kat[3]), 0u, 0u), mk8(vlo, vhi, 0u, 0u), (f32x4){0.f, 0.f, 0.f, 0.f}, 0, 0, 0);
                    const f32x4 wvv = __builtin_amdgcn_mfma_f32_16x16x32_bf16(opT, mk8(pk2(xac[0], xac[1]), pk2(xac[2], xac[3]), 0u, 0u), (f32x4){0.f, 0.f, 0.f, 0.f}, 0, 0, 0);
                    *(LAS f32x4*)(slot + RWS_WVI + 16 * lane) = wvv;
                    f32x4 aht[4];
#pragma unroll
                    for (int nt = 0; nt < 4; ++nt) {
                        const v2u ab = lds_8(tmp + RWT_ABT + rwz(16 * nt + fr) * 32 + 8 * fq);
                        aht[nt] = __builtin_amdgcn_mfma_f32_16x16x32_bf16(mk8(ab.x, ab.y, 0u, 0u), opT, (f32x4){0.f, 0.f, 0.f, 0.f}, 0, 0, 0);
                    }
#pragma unroll
                    for (int p = 0; p < 2; ++p) { u32x4_t o; o.x = pk2(aht[2 * p][0], aht[2 * p][1]); o.y = pk2(aht[2 * p][2], aht[2 * p][3]); o.z = pk2(aht[2 * p + 1][0], aht[2 * p + 1][1]); o.w = pk2(aht[2 * p + 1][2], aht[2 * p + 1][3]);
                        *(LAS u32x4_t*)(slot + RWS_AH + (p * 64 + lane) * 16) = o; }
                    LDS_WAIT(); asm volatile("" ::: "memory");
                    if (lane == 0) flg[cj % RW_NSLOT] = (unsigned)(cj + 1);
                }
            }
        } else {
            f32x4 St[4];
#pragma unroll
            for (int kt = 0; kt < 4; ++kt) St[kt] = (f32x4){0.f, 0.f, 0.f, 0.f};
            {
#pragma unroll 1
                for (int c = 0; c < NCH; ++c) {
                    const LAS unsigned char* slot = lds + (c % RW_NSLOT) * RWS_SLOT;
                    while (flg[c % RW_NSLOT] != (unsigned)(c + 1)) __builtin_amdgcn_s_sleep(1);
                    asm volatile("" ::: "memory");
                    f32x4 zt = *(const LAS f32x4*)(slot + RWS_WVI + 16 * lane);
                    f32x4 y = (f32x4){0.f, 0.f, 0.f, 0.f};
#pragma unroll
                    for (int p = 0; p < 2; ++p) {
                        const bf16x8 sb = mk8(pk2(St[2 * p][0], St[2 * p][1]), pk2(St[2 * p][2], St[2 * p][3]), pk2(St[2 * p + 1][0], St[2 * p + 1][1]), pk2(St[2 * p + 1][2], St[2 * p + 1][3]));
                        const v2u r0 = lds_8(slot + RWS_RB + fr * 128 + (32 * p + 4 * fq) * 2), r1 = lds_8(slot + RWS_RB + fr * 128 + (32 * p + 16 + 4 * fq) * 2);
                        zt = __builtin_amdgcn_mfma_f32_16x16x32_bf16(*(const LAS bf16x8*)(slot + RWS_AH + (p * 64 + lane) * 16), sb, zt, 0, 0, 0);
                        y = __builtin_amdgcn_mfma_f32_16x16x32_bf16(mk8(r0.x, r0.y, r1.x, r1.y), sb, y, 0, 0, 0);
                    }
                    const v2u vc = lds_8(slot + RWS_VCI + 8 * lane);
                    const bf16x8 b2 = mk8(vc.x, vc.y, pk2(zt[0], zt[1]), pk2(zt[2], zt[3]));
                    y = __builtin_amdgcn_mfma_f32_16x16x32_bf16(*(const LAS bf16x8*)(slot + RWS_KNI + 16 * lane), b2, y, 0, 0, 0);
#pragma unroll
                    for (int kt = 0; kt < 4; ++kt) {
                        const v2u kg = lds_8(slot + RWS_KGT + rwz(16 * kt + fr) * 32 + 8 * fq), bg = lds_8(slot + RWS_BGT + rwz(16 * kt + fr) * 32 + 8 * fq);
                        const f32x4 g15 = *(const LAS f32x4*)(slot + RWS_G15 + (16 * kt + 4 * fq) * 4);
                        St[kt] = __builtin_amdgcn_mfma_f32_16x16x32_bf16(mk8(kg.x, kg.y, bg.x, bg.y), b2, St[kt] * g15, 0, 0, 0);
                    }
                    bf16* yp = Y + (row0 + 16 * (size_t)c + 4 * fq) * 1024 + 64 * h + 16 * rg + fr;
#pragma unroll
                    for (int i = 0; i < 4; ++i) yp[(size_t)i * 1024] = (bf16)f2bf(y[i]);
                    LDS_WAIT(); asm volatile("" ::: "memory");
                    if (lane == 0) flg[RW_NSLOT] = (unsigned)(c + 1);
                }
            }
        }
        __syncthreads();
    }
}
__device__ __forceinline__ void rw_post(const bf16* Y, bf16* R, const bf16* K, const bf16* V, const bf16* A, const bf16* G, const float* k_a, const float* r_k, const float* ln_g, const float* ln_b, int gw, int ngw, int lane) {
    const int c = (gw & 3) * 256 + 4 * lane;
    const f32x4 ka = *(const f32x4*)(k_a + c), rk = *(const f32x4*)(r_k + c), lg = *(const f32x4*)(ln_g + c), lb = *(const f32x4*)(ln_b + c);
    for (int it = gw; it < M * 4; it += 2 * ngw) {
        const int it2 = (it + ngw < M * 4) ? it + ngw : it;
        const size_t off[2] = {(size_t)(it >> 2) * 1024 + c, (size_t)(it2 >> 2) * 1024 + c};
        v2u yv[2], rv[2], kv[2], vv[2], av[2], gv[2];
#pragma unroll
        for (int u = 0; u < 2; ++u) { yv[u] = *(const v2u*)(Y + off[u]); rv[u] = *(const v2u*)(R + off[u]); kv[u] = *(const v2u*)(K + off[u]); vv[u] = *(const v2u*)(V + off[u]); av[u] = *(const v2u*)(A + off[u]); gv[u] = *(const v2u*)(G + off[u]); }
#pragma unroll
        for (int u = 0; u < 2; ++u) {
            const f32x4 y = bf4(yv[u]), r = bf4(rv[u]), k = bf4(kv[u]), v = bf4(vv[u]), a = bf4(av[u]), g = bf4(gv[u]);
            const float mu = row16_sum((y[0] + y[1]) + (y[2] + y[3])) * (1.0f / 64.0f);
            const f32x4 yc = y - mu;
            const float var = row16_sum((yc[0] * yc[0] + yc[1] * yc[1]) + (yc[2] * yc[2] + yc[3] * yc[3])) * (1.0f / 64.0f);
            const float rstd = 1.0f / sqrtf(var + 64e-5f);
            const f32x4 km = k * (1.0f + (a - 1.0f) * ka);
            const f32x4 pr = r * km * rk;
            const float cs = row16_sum((pr[0] + pr[1]) + (pr[2] + pr[3]));
            const f32x4 o = (yc * rstd * lg + lb + v * cs) * g;
            v2u wv; wv.x = pk2(o[0], o[1]); wv.y = pk2(o[2], o[3]);
            if (u == 0 || it2 != it) *(v2u*)(R + off[u]) = wv;
        }
    }
}

__device__ __forceinline__ void sc_conv(const bf16* BG, const bf16* CG, const bf16* HX, const float* cw, const float* cb, bf16* O3, int gt, int ngt) {
    const int c = (gt & 127) * 8;
    float w0[8], w1[8], w2[8], bb[8];
#pragma unroll
    for (int j = 0; j < 8; ++j) { w0[j] = cw[c + j]; w1[j] = cw[1024 + c + j]; w2[j] = cw[2048 + c + j]; bb[j] = cb[c + j]; }
    for (int idx = gt; idx < M * 128; idx += 2 * ngt) {
        const int idx2 = idx + ngt < M * 128 ? idx + ngt : idx;
        v4u cv[2][3], hv[2][3], bv[2]; int tt[2]; size_t offs[2];
#pragma unroll
        for (int u = 0; u < 2; ++u) {
            const int m = (u ? idx2 : idx) >> 7; tt[u] = m & (SEQ - 1); offs[u] = (size_t)m * 1024 + c;
#pragma unroll
            for (int dt = 0; dt < 3; ++dt) { const size_t o2 = offs[u] - (size_t)((tt[u] - 2 + dt >= 0) ? (2 - dt) : 0) * 1024; cv[u][dt] = *(const v4u*)(CG + o2); hv[u][dt] = *(const v4u*)(HX + o2); }
            bv[u] = *(const v4u*)(BG + offs[u]);
        }
#pragma unroll
        for (int u = 0; u < 2; ++u) {
            float y[8];
#pragma unroll
            for (int j = 0; j < 8; ++j) y[j] = bb[j];
#pragma unroll
            for (int dt = 0; dt < 3; ++dt) {
                const float on = (tt[u] - 2 + dt >= 0) ? 1.f : 0.f;
                const float* wp = dt == 0 ? w0 : (dt == 1 ? w1 : w2);
                const v4u cq = cv[u][dt], hq = hv[u][dt];
                y[0] += on * wp[0] * (bflo(cq.x) * bflo(hq.x)); y[1] += on * wp[1] * (bfhi(cq.x) * bfhi(hq.x));
                y[2] += on * wp[2] * (bflo(cq.y) * bflo(hq.y)); y[3] += on * wp[3] * (bfhi(cq.y) * bfhi(hq.y));
                y[4] += on * wp[4] * (bflo(cq.z) * bflo(hq.z)); y[5] += on * wp[5] * (bfhi(cq.z) * bfhi(hq.z));
                y[6] += on * wp[6] * (bflo(cq.w) * bflo(hq.w)); y[7] += on * wp[7] * (bfhi(cq.w) * bfhi(hq.w));
            }
            const v4u bq = bv[u];
            v4u w; w.x = pk2(y[0] * bflo(bq.x), y[1] * bfhi(bq.x)); w.y = pk2(y[2] * bflo(bq.y), y[3] * bfhi(bq.y)); w.z = pk2(y[4] * bflo(bq.z), y[5] * bfhi(bq.z)); w.w = pk2(y[6] * bflo(bq.w), y[7] * bfhi(bq.w));
            if (u == 0 || idx2 != idx) *(v4u*)(O3 + offs[u]) = w;
        }
    }
}

#define XB_TMO      128
#define XB_XCNT(j)  (256  + 64 * (j))
#define XB_XSUB(j)  (1280 + 64 * (j))
#define XB_XGEN(j)  (2304 + 64 * (j))
#define XB_TOP      3328
#define XB_TOPGEN   3392
#define XCD_BAR_WORDS 3456
#define XB_SPIN_CAP (1u << 18)

__device__ __forceinline__ unsigned xb_ld(unsigned* p)              { return __hip_atomic_load(p, __ATOMIC_RELAXED, __HIP_MEMORY_SCOPE_AGENT); }
__device__ __forceinline__ unsigned xb_add(unsigned* p, unsigned v) { return __hip_atomic_fetch_add(p, v, __ATOMIC_RELAXED, __HIP_MEMORY_SCOPE_AGENT); }
__device__ __forceinline__ unsigned xb_xcc_id() { return (unsigned)__builtin_amdgcn_s_getreg((3 << 11) | 20) & 0xFu; }
#define XB_SPIN(cond, bar) do { unsigned _sp = 0; while (cond) { __builtin_amdgcn_s_sleep(1); \
    if ((++_sp & 255u) == 0u) { if (xb_ld(&(bar)[XB_TMO])) break; if (_sp > XB_SPIN_CAP) { atomicAdd(&(bar)[XB_TMO], 1u); break; } } } } while (0)

struct XcdBarrier {
    unsigned* bar; unsigned x;
    volatile LAS unsigned* st;
};

__device__ __forceinline__ XcdBarrier xcd_barrier_post(unsigned* bar, volatile LAS unsigned* st) {
    XcdBarrier b; b.bar = bar; b.x = xb_xcc_id(); b.st = st;
    if (threadIdx.x == 0) (void)xb_add(&bar[XB_XCNT(b.x)], 1u);
    return b;
}
__device__ __forceinline__ void xcd_barrier_complete(unsigned* bar, unsigned x, unsigned& nloc, unsigned& nx) {
    const unsigned G = gridDim.x * gridDim.y * gridDim.z;
    unsigned sum, cnt, mine, sp = 0u;
    for (;;) {
        sum = 0u; cnt = 0u; mine = 0u;
#pragma unroll
        for (unsigned j = 0; j < 16; ++j) { const unsigned c = xb_ld(&bar[XB_XCNT(j)]); sum += c; cnt += (c > 0u) ? 1u : 0u; mine = (j == x) ? c : mine; }
        if (sum == G) break;
        __builtin_amdgcn_s_sleep(1);
        if ((++sp & 255u) == 0u) { if (xb_ld(&bar[XB_TMO])) break; if (sp > XB_SPIN_CAP) { atomicAdd(&bar[XB_TMO], 1u); break; } }
    }
    nloc = mine > 0u ? mine : 1u; nx = cnt > 0u ? cnt : 1u;
}

__device__ __forceinline__ void xcd_barrier(const XcdBarrier& b) {
    asm volatile("s_waitcnt vmcnt(0)" ::: "memory");
    __syncthreads();
    if (threadIdx.x == 0) {
        unsigned* bar = b.bar;
        __builtin_amdgcn_s_waitcnt(0);
        unsigned nloc = b.st[0], nx = b.st[1];
        if (nloc == 0u) { xcd_barrier_complete(bar, b.x, nloc, nx); b.st[0] = nloc; b.st[1] = nx; }
        const unsigned old = xb_add(&bar[XB_XSUB(b.x)], 1u);
        const unsigned gen = old / nloc;
        if (old + 1u == (gen + 1u) * nloc) {
            __builtin_amdgcn_fence(__ATOMIC_RELEASE, "agent");
            asm volatile("s_waitcnt vmcnt(0)" ::: "memory");
            const unsigned og = xb_add(&bar[XB_TOP], 1u);
            const unsigned tg = og / nx;
            if (og + 1u == (tg + 1u) * nx) xb_add(&bar[XB_TOPGEN], 1u);
            else XB_SPIN(xb_ld(&bar[XB_TOPGEN]) == tg, bar);
            __builtin_amdgcn_fence(__ATOMIC_ACQUIRE, "agent");
            xb_add(&bar[XB_XGEN(b.x)], 1u);
            asm volatile("s_waitcnt vmcnt(0)" ::: "memory");
        } else {
            XB_SPIN(xb_ld(&bar[XB_XGEN(b.x)]) == gen, bar);
            __builtin_amdgcn_fence(__ATOMIC_ACQUIRE, "agent");
            asm volatile("s_waitcnt vmcnt(0)" ::: "memory");
        }
    }
    __syncthreads();
}

struct Args { const float* in[32]; float* out; unsigned char* ws; };
#define PHASE_VARS \
    unsigned char* ws = a.ws; float* out = a.out; asm volatile("" : "+s"(ws), "+s"(out)); \
    int tid = threadIdx.x; asm volatile("" : "+v"(tid)); \
    const int lane = tid & 63, wave = __builtin_amdgcn_readfirstlane(tid >> 6); \
    const int G = gridDim.x, gw = blockIdx.x * NWAVES + wave, ngw = G * NWAVES, gt = blockIdx.x * NTHR + tid, ngt = G * NTHR; \
    float* RS = (float*)(ws + WS_RS); float* LBK = (float*)(ws + WS_LBK); \
    bf16* WA = (bf16*)(ws + WS_WA); bf16* WB = (bf16*)(ws + WS_WB); bf16* WO = (bf16*)(ws + WS_WO); bf16* WUP = (bf16*)(ws + WS_WUP); bf16* WDN = (bf16*)(ws + WS_WDN); \
    bf16* HB = (bf16*)(ws + WS_HB); \
    bf16* B0 = (bf16*)(ws + WS_BIG); bf16* B1 = (bf16*)(ws + WS_BIG + SLOT); bf16* B2 = (bf16*)(ws + WS_BIG + 2 * SLOT); bf16* B3 = (bf16*)(ws + WS_BIG + 3 * SLOT); \
    bf16* B4 = (bf16*)(ws + WS_BIG + 4 * SLOT); bf16* B5 = (bf16*)(ws + WS_BIG + 5 * SLOT); bf16* B5b = (bf16*)(ws + WS_BIG + 5 * SLOT + 16 * MiB); \
    LAS float* scr = (LAS float*)(lds + wave * 16384); \
    (void)lane; (void)gw; (void)ngw; (void)gt; (void)ngt; (void)RS; (void)LBK; (void)WA; (void)WB; (void)WO; (void)WUP; (void)WDN; (void)HB; (void)B0; (void)B1; (void)B2; (void)B3; (void)B4; (void)B5; (void)B5b; (void)scr; (void)out; (void)G;
constexpr size_t SLOT_E = SLOT / 2;

__global__ void __launch_bounds__(NTHR, 2) fwd_megakernel(Args a) {
    extern __shared__ __attribute__((aligned(16))) unsigned char lds_raw[];
    cg::grid_group grid = cg::this_grid();
    LAS unsigned char* lds = (LAS unsigned char*)lds_raw;
    volatile LAS unsigned* xb_st = (volatile LAS unsigned*)(lds + LDS_BYTES - 64);
    if (threadIdx.x < 2) xb_st[threadIdx.x] = 0u;
    __syncthreads();
    const XcdBarrier xbar = xcd_barrier_post((unsigned*)(a.ws + WS_BAR), xb_st);

#pragma nounroll
    for (int layer = 0; layer < 4; ++layer) {
        for (int rp_ = 0; rp_ < REP_PRO; ++rp_) { PHASE_VARS
        const float* gmix = a.in[1] + layer * 1024; const float* gffn = a.in[2] + layer * 1024;
        conv_mat(a.in[3] + (size_t)layer * D * FF, D, FF, WUP, D, 0, 0, gffn, scr, gw, ngw, lane);
        conv_mat(a.in[4] + (size_t)layer * D * FF, FF, D, WDN, FF, 0, 0, nullptr, scr, gw, ngw, lane);
        if (layer == 0) {
            conv_mat(a.in[6], D, 3 * D, WA, D, 0, 0, gmix, scr, gw, ngw, lane);
            conv_mat(a.in[7], D, D, WO, D, 0, 0, nullptr, scr, gw, ngw, lane);
            for (int m0 = gw; m0 < M; m0 += 4 * ngw) {
                f32x4 v[4][4];
#pragma unroll
                for (int u = 0; u < 4; ++u) { const int ml = m0 + u * ngw < M ? m0 + u * ngw : m0; const f32x4* xr = (const f32x4*)(a.in[0] + (size_t)ml * 1024) + lane;
#pragma unroll
                    for (int j = 0; j < 4; ++j) v[u][j] = xr[64 * j]; }
#pragma unroll
                for (int u = 0; u < 4; ++u) { const int m = m0 + u * ngw; if (m >= M) break; float ss = 0.f;
#pragma unroll
                    for (int j = 0; j < 4; ++j) { ss += (v[u][j][0] * v[u][j][0] + v[u][j][1] * v[u][j][1]) + (v[u][j][2] * v[u][j][2] + v[u][j][3] * v[u][j][3]);
                        v2u w; w.x = pk2(v[u][j][0], v[u][j][1]); w.y = pk2(v[u][j][2], v[u][j][3]); *(v2u*)(HB + (size_t)m * 1024 + 4 * lane + 256 * j) = w; }
                    ss = wave_sum(ss);
                    if (lane < 16) RS[(size_t)m * 16 + lane] = lane == 0 ? ss : 0.f; }
            }
        } else if (layer == 1) {
            conv_mat(a.in[8], D, 4 * D, WA, D, 0, 0, gmix, scr, gw, ngw, lane);
            conv_mat(a.in[11], D, D, WO, D, 0, 0, nullptr, scr, gw, ngw, lane);
            for (int c = gt; c < 1024; c += ngt) {
                const float* tb = a.in[9]; const float t0 = tb[c], t1 = tb[1024 + c], t2 = tb[2048 + c], t3 = tb[3072 + c];
                const float mx = fmaxf(fmaxf(t0, t1), fmaxf(t2, t3));
                const float e0 = expf(t0 - mx), e1 = expf(t1 - mx), e2 = expf(t2 - mx), e3 = expf(t3 - mx);
                LBK[c] = 1.0f - e1 / (e0 + e1 + e2 + e3);
            }
        } else if (layer == 2) {
            const float* mix = a.in[12];
#pragma nounroll
            for (int j = 0; j < 3; ++j) {
                conv_mat(a.in[13] + (size_t)j * D * D, D, D, WA, 2048, 1024 * j, 0, nullptr, scr, gw, ngw, lane);
                conv_mat(a.in[13] + (size_t)j * D * D, D, D, WA, 2048, 1024 * j, 1024, mix + 1024 * j, scr, gw, ngw, lane);
            }
            conv_mat(a.in[15], D, 64, WA, 2048, 3072, 0, nullptr, scr, gw, ngw, lane); conv_mat(a.in[15], D, 64, WA, 2048, 3072, 1024, mix + 3 * 1024, scr, gw, ngw, lane);
            conv_mat(a.in[18], D, 64, WA, 2048, 3136, 0, nullptr, scr, gw, ngw, lane); conv_mat(a.in[18], D, 64, WA, 2048, 3136, 1024, mix + 4 * 1024, scr, gw, ngw, lane);
            conv_mat(a.in[20], D, 128, WA, 2048, 3200, 0, nullptr, scr, gw, ngw, lane); conv_mat(a.in[20], D, 128, WA, 2048, 3200, 1024, mix + 5 * 1024, scr, gw, ngw, lane);
            conv_mat(a.in[27], D, D, WO, D, 0, 0, nullptr, scr, gw, ngw, lane);
            for (int idx = gt; idx < 256 * 3072; idx += ngt) {
                const int k = idx / 3072, n = idx - k * 3072, grp = n >> 10, nn = n & 1023; float v = 0.f;
                if (grp == 0) { if (k < 64) v = a.in[16][k * 1024 + nn]; }
                else if (grp == 1) { if (k >= 64 && k < 128) v = a.in[19][(k - 64) * 1024 + nn]; }
                else { if (k >= 128) v = a.in[21][(k - 128) * 1024 + nn]; }
                WB[(size_t)n * 256 + k] = (bf16)f2bf(v);
            }
            rw_prep(HB, RS, gmix, B0, gw, ngw, lane);
        } else {
            conv_mat(a.in[28], D, 3 * D, WA, D, 0, 0, gmix, scr, gw, ngw, lane);
            conv_mat(a.in[31], D, D, WO, D, 0, 0, nullptr, scr, gw, ngw, lane);
        }
        }
        if (layer == 0) grid.sync();
        else GRID_SYNC();

        if (layer == 0 || layer == 3) {
            { PHASE_VARS
            pg8::Gemm g{HB, WA, M, 3 * D, D}; pg8::StaticOrder S; S.init(M, 3 * D, G, (int)blockIdx.x);
            pg8::EpiAct<0> E{B0, 1024, 1024, SLOT_E, RS, layer == 0 ? 0.125f * LOG2E_F : 1.0f, nullptr};
            for (int r_ = 0; r_ < REP_IN; ++r_) pg8::gemm_phase<pg8::EpiAct<0>, pg8::StaticOrder, true, true>(lds, g, S, E); }
            GRID_SYNC();
            { PHASE_VARS
            if (layer == 0) { for (int r_ = 0; r_ < REP_ATT; ++r_) attn_phase(B0, B1, B2, B3, gw, ngw, lane); }
            else { for (int r_ = 0; r_ < REP_SC; ++r_) sc_conv(B0, B1, B2, a.in[29], a.in[30], B3, gt, ngt); } }
        } else if (layer == 1) {
            { PHASE_VARS
            pg8::Gemm g{HB, WA, M, 4 * D, D}; pg8::StaticOrder S; S.init(M, 4 * D, G, (int)blockIdx.x);
            pg8::EpiAct<2> E{B0, 1024, 1024, SLOT_E, RS, 1.0f, LBK};
            for (int r_ = 0; r_ < REP_IN; ++r_) pg8::gemm_phase<pg8::EpiAct<2>, pg8::StaticOrder, true, true>(lds, g, S, E); }
            GRID_SYNC();
            { PHASE_VARS
            hg_local(B0, B1, B4, B2, (float*)B5, (float*)(ws + WS_BIG + 5 * SLOT + 8 * MiB), (float*)(ws + WS_BIG + 5 * SLOT + 24 * MiB)); }
            GRID_SYNC();
            { PHASE_VARS
            hg_out(B0, B1, B4, B2, (const float*)B5, (const float*)(ws + WS_BIG + 5 * SLOT + 8 * MiB), (const float*)(ws + WS_BIG + 5 * SLOT + 24 * MiB), a.in[10], B3, lds); }
        } else {
            { PHASE_VARS
              pg8::Gemm g{B0, WA, M, 3328, 2048}; pg8::StaticOrder S; S.init(M, 3328, G, (int)blockIdx.x);
              pg8::EpiRw1 E{B2, SLOT_E, B5};
              for (int r_ = 0; r_ < REP_G1; ++r_) pg8::gemm_phase<pg8::EpiRw1, pg8::StaticOrder, true, true>(lds, g, S, E); }
            GRID_SYNC();
            { PHASE_VARS
              int k256 = 256; asm volatile("" : "+s"(k256));
              pg8::Gemm g{B5, WB, M, 3 * D, k256}; pg8::StaticOrder S; S.init(M, 3 * D, G, (int)blockIdx.x);
              pg8::EpiRw2 E{B0, SLOT_E, 5 * SLOT_E + 8 * MiB, a.in[14], a.in[17]};
              for (int r_ = 0; r_ < REP_G2; ++r_) pg8::gemm_phase<pg8::EpiRw2, pg8::StaticOrder, true, true>(lds, g, S, E); }
            GRID_SYNC();
            { PHASE_VARS
            for (int r_ = 0; r_ < REP_RW; ++r_) rw_scan(B2, B3, B4, B0, B1, a.in[22], a.in[23], (bf16*)out, lds); }
            GRID_SYNC();
            { PHASE_VARS
            rw_post((const bf16*)out, B2, B3, B4, B1, B5b, a.in[23], a.in[24], a.in[25], a.in[26], gw, ngw, lane); }
        }
        GRID_SYNC();
        { PHASE_VARS
          const bf16* mix_out = (layer == 2) ? B2 : B3;
          pg8::Gemm g{mix_out, WO, M, D, D}; pg8::StaticOrder S; S.init(M, D, G, (int)blockIdx.x);
          pg8::EpiResidB E{HB, RS};
          pg8::gemm_phase<pg8::EpiResidB, pg8::StaticOrder, true, true>(lds, g, S, E); }
        GRID_SYNC();
        { PHASE_VARS
          pg8::Gemm g{HB, WUP, M, FF, D}; pg8::StaticOrder S; S.init(M, FF, G, (int)blockIdx.x);
          pg8::EpiAct<1> E{B0, FF, 0, 0, RS, 1.0f, nullptr};
#pragma nounroll
          for (int r_ = 0; r_ < REP_UP; ++r_) pg8::gemm_phase<pg8::EpiAct<1>, pg8::StaticOrder, true, true>(lds, g, S, E); }
        GRID_SYNC();
        { PHASE_VARS
          pg8::Gemm g{B0, WDN, M, D, FF}; pg8::StaticOrder S; S.init(M, D, G, (int)blockIdx.x);
          pg8::EpiResidB E{HB, RS};
          pg8::gemm_phase<pg8::EpiResidB, pg8::StaticOrder, true, true>(lds, g, S, E); }
        GRID_SYNC();
    }
    { PHASE_VARS
    const f32x4* gr = (const f32x4*)(a.in[5]) + lane;
    const f32x4 g0 = gr[0], g1 = gr[64], g2 = gr[128], g3 = gr[192];
    for (int m0 = gw; m0 < M; m0 += 4 * ngw) {
        f32x4 v[4][4]; f32x4 pr[4];
#pragma unroll
        for (int u = 0; u < 4; ++u) { const int m = m0 + u * ngw < M ? m0 + u * ngw : m0;
            pr[u] = *(const f32x4*)(RS + (size_t)m * 16 + 4 * (lane & 3));
#pragma unroll
            for (int j = 0; j < 4; ++j) v[u][j] = bf4(*(const v2u*)(HB + (size_t)m * 1024 + 4 * lane + 256 * j)); }
#pragma unroll
        for (int u = 0; u < 4; ++u) { const int m = m0 + u * ngw; if (m >= M) break; f32x4* xr = (f32x4*)(out + (size_t)m * 1024) + lane;
            float s = (pr[u][0] + pr[u][1]) + (pr[u][2] + pr[u][3]); s += dpp_f<0xB1>(s); s += dpp_f<0x4E>(s);
            const float r = 1.0f / sqrtf(s * (1.0f / 1024.0f) + 1e-6f);
            xr[0] = v[u][0] * r * g0; xr[64] = v[u][1] * r * g1; xr[128] = v[u][2] * r * g2; xr[192] = v[u][3] * r * g3; }
    } }
}

extern "C" void kernel_launch(void* const* d_in, const int* in_sizes, int n_in, void* d_out, int out_size, void* d_ws, size_t ws_size, hipStream_t stream) {
    static int grid = 0;
    if (grid == 0) {
        if (n_in != 32 || out_size != M * D || ws_size < WS_END) { fprintf(stderr, "kernel_launch: unexpected shapes (n_in %d out %d ws %zu)\n", n_in, out_size, ws_size); grid = -1; return; }
        int dev = 0, cus = 0, per_cu = 0;
        hipGetDevice(&dev); hipDeviceGetAttribute(&cus, hipDeviceAttributeMultiprocessorCount, dev);
        hipFuncSetAttribute((const void*)fwd_megakernel, hipFuncAttributeMaxDynamicSharedMemorySize, LDS_BYTES);
        hipOccupancyMaxActiveBlocksPerMultiprocessor(&per_cu, (const void*)fwd_megakernel, NTHR, LDS_BYTES);
        if (per_cu < 1) { fprintf(stderr, "kernel_launch: occupancy query says %d blocks per CU\n", per_cu); per_cu = 1; }
        (void)hipGetLastError();
        grid = cus * per_cu;
    }
    if (grid < 0) return;
    if (hipMemsetAsync((char*)d_ws + WS_BAR, 0, WS_BAR_BYTES, stream) != hipSuccess) { fprintf(stderr, "kernel_launch: memset of the barrier words failed\n"); return; }
    Args a{};
    for (int i = 0; i < 32; ++i) a.in[i] = (const float*)d_in[i];
    a.out = (float*)d_out; a.ws = (unsigned char*)d_ws;
    void* args[] = {&a};
    hipError_t e = hipLaunchCooperativeKernel((const void*)fwd_megakernel, dim3(grid), dim3(NTHR), args, LDS_BYTES, stream);
    if (e != hipSuccess) fprintf(stderr, "cooperative launch failed: %s (grid %d)\n", hipGetErrorString(e), grid);
}
```

```cpp
#include <hip/hip_runtime.h>
#include <hip/hip_cooperative_groups.h>
#include <cstdio>
#include <cstdint>
namespace cg = cooperative_groups;
namespace pg8 {
#define PG8_LAS __attribute__((address_space(3)))
typedef unsigned short bf16_t;
typedef short bf16x8 __attribute__((ext_vector_type(8)));
typedef float f32x4 __attribute__((ext_vector_type(4)));
typedef unsigned u32x4 __attribute__((ext_vector_type(4)));
constexpr int BM = 256, BK = 64, HALF = 128, HTB = HALF * BK * 2  , STAGE_BYTES = 8 * HTB, NXCD = 8, WGM = 8;

__host__ __device__ __forceinline__ int lds_byte(int r, int c) { const int st = (r >> 4) * 2 + (c >> 5), rr = r & 15, cc = c & 31, ob = rr * 64 + cc * 2; return st * 1024 + (ob ^ (((ob >> 9) & 1) << 5)); }
__host__ __device__ __forceinline__ void stage_rc(int b, int& R, int& C) { const int st = b / 1024, sb = b % 1024, swz = sb ^ (((sb >> 9) & 1) << 5); R = (st >> 1) * 16 + swz / 64; C = (st & 1) * 32 + (swz % 64) / 2; }
__host__ __device__ __forceinline__ int perm32(int rho) { const int n = rho >> 4, i = rho & 15; return 8 * (i >> 2) + 4 * n + (i & 3); }

struct Unit { int pm, pn; };
struct Gemm { const bf16_t* A; const bf16_t* Bt; int M, N, K; };

struct StaticOrder {
    int nM, nN, nwg, G, c;
    __host__ __device__ void init(int M, int N, int G_, int c_) { nM = M / BM; nN = N / BM; nwg = nM * nN; G = G_; c = c_; }
    __host__ __device__ bool next(int i, Unit& u) const {
        const long L = (long)i * G + c; if (L >= nwg) return false;
        int wgid = (int)L; { const int q = nwg / NXCD, r = nwg % NXCD, xcd = wgid % NXCD, off = wgid / NXCD; wgid = (xcd < r ? xcd * (q + 1) : r * (q + 1) + (xcd - r) * q) + off; }
        const int wgm = nN >= 8 ? 4 : WGM; const int nig = wgm * nN, gid = wgid / nig, fm = gid * wgm, gsz = (nM - fm) < wgm ? (nM - fm) : wgm;
        u.pm = fm + ((wgid % nig) % gsz); u.pn = (wgid % nig) / gsz; return true;
    }
    __device__ __forceinline__ void a_ready(const Unit&) const {}
    __device__ __forceinline__ void done(const Unit&) const {}
};

__device__ __forceinline__ unsigned cvt_pk_bf16(float lo, float hi) { unsigned r; asm volatile("v_cvt_pk_bf16_f32 %0, %1, %2" : "=v"(r) : "v"(lo), "v"(hi)); return r; }
typedef unsigned u32x4 __attribute__((ext_vector_type(4)));
typedef unsigned u32x2 __attribute__((ext_vector_type(2)));
constexpr float LOG2E = 1.4426950408889634f;
__device__ __forceinline__ float fast_sigmoid(float x) { return __builtin_amdgcn_rcpf(1.0f + __builtin_amdgcn_exp2f(-x * LOG2E)); }
__device__ __forceinline__ float row_rs(const float* rs, int row) {
    const f32x4* p = (const f32x4*)(rs + (size_t)row * 16);
    const f32x4 a = p[0], b = p[1], c = p[2], d = p[3];
    const float s = ((a[0] + a[1]) + (a[2] + a[3])) + ((b[0] + b[1]) + (b[2] + b[3])) + ((c[0] + c[1]) + (c[2] + c[3])) + ((d[0] + d[1]) + (d[2] + d[3]));
    return 1.0f / sqrtf(s * (1.0f / 1024.0f) + 1e-6f);
}
template <int MODE> struct EpiAct {
    static constexpr bool PERM = true, AFTER_DRAIN = false;
    bf16_t* O; int ldc; int split_cols; size_t split_stride; const float* rs; float scale0; const float* aux;
    __device__ __forceinline__ void operator()(const f32x4 (&acc)[2][2][4][2], const Unit& u, int wr, int wc, int fr, int fq) const {
        const int row0 = u.pm * BM + wr * 64 + fr; int colt = u.pn * BM; bf16_t* base = O; int t = 0;
        if (split_cols) { t = colt / split_cols; base += (size_t)t * split_stride; colt -= t * split_cols; }
        const float sc = (MODE == 0 && t == 0) ? scale0 : 1.f;
        const int col0 = colt + wc * 32 + 8 * fq;
        f32x4 lbk[2][2];
#pragma unroll
        for (int bj = 0; bj < 2; ++bj)
#pragma unroll
            for (int n = 0; n < 2; ++n) lbk[bj][n] = (MODE == 2 && t == 1) ? *(const f32x4*)(aux + col0 + bj * HALF + 4 * n) : (f32x4){0.f, 0.f, 0.f, 0.f};
        float rsv[2][4];
        if (rs) {
            f32x4 part[2][4];
#pragma unroll
            for (int ai = 0; ai < 2; ++ai)
#pragma unroll
                for (int m = 0; m < 4; ++m) part[ai][m] = *(const f32x4*)(rs + (size_t)(row0 + ai * HALF + m * 16) * 16 + 4 * fq);
#pragma unroll
            for (int ai = 0; ai < 2; ++ai)
#pragma unroll
                for (int m = 0; m < 4; ++m) { float s = (part[ai][m][0] + part[ai][m][1]) + (part[ai][m][2] + part[ai][m][3]); s += __shfl_xor(s, 16); s += __shfl_xor(s, 32);
                    rsv[ai][m] = sc / sqrtf(s * (1.0f / 1024.0f) + 1e-6f); }
        } else {
#pragma unroll
            for (int ai = 0; ai < 2; ++ai)
#pragma unroll
                for (int m = 0; m < 4; ++m) rsv[ai][m] = sc;
        }
#pragma unroll
        for (int ai = 0; ai < 2; ++ai)
#pragma unroll
            for (int m = 0; m < 4; ++m) {
                const int row = row0 + ai * HALF + m * 16;
                const float r = rsv[ai][m];
                bf16_t* rowp = base + (size_t)row * ldc + col0;
#pragma unroll
                for (int bj = 0; bj < 2; ++bj) {
                    f32x4 v[2] = {acc[ai][bj][m][0] * r, acc[ai][bj][m][1] * r};
#pragma unroll
                    for (int n = 0; n < 2; ++n)
#pragma unroll
                        for (int j = 0; j < 4; ++j) {
                            float x = v[n][j];
                            if (MODE == 1) { x = fmaxf(x, 0.f); x = x * x; }
                            if (MODE == 2) {
                                if (t == 0 || t == 3) x = x * fast_sigmoid(x);
                                else if (t == 1) x = lbk[bj][n][j] * __builtin_amdgcn_rcpf(1.0f + __builtin_amdgcn_exp2f(x * LOG2E));
                            }
                            v[n][j] = x;
                        }
                    u32x4 w; w.x = cvt_pk_bf16(v[0][0], v[0][1]); w.y = cvt_pk_bf16(v[0][2], v[0][3]); w.z = cvt_pk_bf16(v[1][0], v[1][1]); w.w = cvt_pk_bf16(v[1][2], v[1][3]);
                    *(u32x4*)(rowp + bj * HALF) = w;
                }
            }
    }
};
struct EpiRw1 {
    static constexpr bool PERM = true, AFTER_DRAIN = false;
    bf16_t* RKV; size_t split_stride; bf16_t* L;
    __device__ __forceinline__ void operator()(const f32x4 (&acc)[2][2][4][2], const Unit& u, int wr, int wc, int fr, int fq) const {
        const int row0 = u.pm * BM + wr * 64 + fr;
        const bool lora = (u.pn >= 12);
        bf16_t* base = lora ? L : RKV + (size_t)(u.pn >> 2) * split_stride;
        const int ldc = lora ? 256 : 1024;
        const int col0 = (lora ? 0 : (u.pn & 3) * BM) + wc * 32 + 8 * fq;
#pragma unroll
        for (int ai = 0; ai < 2; ++ai)
#pragma unroll
            for (int m = 0; m < 4; ++m) {
                bf16_t* rowp = base + (size_t)(row0 + ai * HALF + m * 16) * ldc + col0;
#pragma unroll
                for (int bj = 0; bj < 2; ++bj) {
                    f32x4 v[2] = {acc[ai][bj][m][0], acc[ai][bj][m][1]};
                    if (lora) {
#pragma unroll
                        for (int n = 0; n < 2; ++n)
#pragma unroll
                            for (int j = 0; j < 4; ++j) {
                                float x = v[n][j];
                                if (bj == 1) x = fast_sigmoid(x);
                                else if (wc < 2) x = 1.0f - 2.0f * __builtin_amdgcn_rcpf(1.0f + __builtin_amdgcn_exp2f(fminf(x, 40.f) * (2.0f * LOG2E)));
                                v[n][j] = x;
                            }
                    }
                    u32x4 w; w.x = cvt_pk_bf16(v[0][0], v[0][1]); w.y = cvt_pk_bf16(v[0][2], v[0][3]); w.z = cvt_pk_bf16(v[1][0], v[1][1]); w.w = cvt_pk_bf16(v[1][2], v[1][3]);
                    *(u32x4*)(rowp + bj * HALF) = w;
                }
            }
    }
};
struct EpiRw2 {
    static constexpr bool PERM = true, AFTER_DRAIN = false;
    bf16_t* WM; size_t offA, offG; const float* w0; const float* a0;
    __device__ __forceinline__ void operator()(const f32x4 (&acc)[2][2][4][2], const Unit& u, int wr, int wc, int fr, int fq) const {
        const int row0 = u.pm * BM + wr * 64 + fr; const int t = u.pn >> 2;
        bf16_t* base = WM + (t == 1 ? offA : (size_t)0) + (t == 2 ? offG : (size_t)0);
        const float* bias = t == 0 ? w0 : a0;
        const int col0 = (u.pn & 3) * BM + wc * 32 + 8 * fq;
        f32x4 bv[2][2];
#pragma unroll
        for (int bj = 0; bj < 2; ++bj)
#pragma unroll
            for (int n = 0; n < 2; ++n) bv[bj][n] = (t < 2) ? *(const f32x4*)(bias + col0 + bj * HALF + 4 * n) : (f32x4){0.f, 0.f, 0.f, 0.f};
#pragma unroll
        for (int ai = 0; ai < 2; ++ai)
#pragma unroll
            for (int m = 0; m < 4; ++m) {
                bf16_t* rowp = base + (size_t)(row0 + ai * HALF + m * 16) * 1024 + col0;
#pragma unroll
                for (int bj = 0; bj < 2; ++bj) {
                    f32x4 v[2] = {acc[ai][bj][m][0], acc[ai][bj][m][1]};
                    if (t < 2) {
                        v[0] += bv[bj][0]; v[1] += bv[bj][1];
#pragma unroll
                        for (int n = 0; n < 2; ++n)
#pragma unroll
                            for (int j = 0; j < 4; ++j) {
                                float x = fast_sigmoid(v[n][j]);
                                if (t == 0) x = 1.0f - __builtin_amdgcn_exp2f(x * (-0.6065306597126334f * LOG2E));
                                v[n][j] = x;
                            }
                    }
                    u32x4 w; w.x = cvt_pk_bf16(v[0][0], v[0][1]); w.y = cvt_pk_bf16(v[0][2], v[0][3]); w.z = cvt_pk_bf16(v[1][0], v[1][1]); w.w = cvt_pk_bf16(v[1][2], v[1][3]);
                    *(u32x4*)(rowp + bj * HALF) = w;
                    asm volatile("" ::: "memory");
                }
            }
    }
};
struct EpiResid {
    static constexpr bool PERM = false, AFTER_DRAIN = false;
    const float* base; float* out; bf16_t* hb; float* rsq;
    __device__ __forceinline__ void operator()(const f32x4 (&acc)[2][2][4][2], const Unit& u, int wr, int wc, int fr, int fq) const {
        const int col0 = u.pn * BM + wc * 32 + 4 * fq;
#pragma unroll
        for (int ai = 0; ai < 2; ++ai) {
            f32x4 pre[4][2][2];
#pragma unroll
            for (int m = 0; m < 4; ++m) { const size_t off = (size_t)(u.pm * BM + ai * HALF + wr * 64 + m * 16 + fr) * 1024 + col0;
#pragma unroll
                for (int bj = 0; bj < 2; ++bj)
#pragma unroll
                    for (int n = 0; n < 2; ++n) pre[m][bj][n] = *(const f32x4*)(base + off + bj * HALF + n * 16); }
#pragma unroll
            for (int m = 0; m < 4; ++m) {
                const int row = u.pm * BM + ai * HALF + wr * 64 + m * 16 + fr; const size_t off = (size_t)row * 1024 + col0;
                float ss = 0.f;
#pragma unroll
                for (int bj = 0; bj < 2; ++bj)
#pragma unroll
                    for (int n = 0; n < 2; ++n) {
                        const f32x4 o = pre[m][bj][n] + acc[ai][bj][m][n];
                        *(f32x4*)(out + off + bj * HALF + n * 16) = o;
                        u32x2 w; w.x = cvt_pk_bf16(o[0], o[1]); w.y = cvt_pk_bf16(o[2], o[3]);
                        if (hb) *(u32x2*)(hb + off + bj * HALF + n * 16) = w;
                        ss += (o[0] * o[0] + o[1] * o[1]) + (o[2] * o[2] + o[3] * o[3]);
                    }
                ss += __shfl_xor(ss, 16); ss += __shfl_xor(ss, 32);
                if (fq == 0) rsq[(size_t)row * 16 + u.pn * 4 + wc] = ss;
            }
        }
    }
};

struct EpiResidB {
    static constexpr bool PERM = false, AFTER_DRAIN = false;
    bf16_t* hb; float* rsq; const float* rs_in;
    __device__ __forceinline__ void operator()(const f32x4 (&acc)[2][2][4][2], const Unit& u, int wr, int wc, int fr, int fq) const {
        const int col0 = u.pn * BM + wc * 32 + 4 * fq;
#pragma unroll
        for (int ai = 0; ai < 2; ++ai) {
            u32x2 pre[2][4][2][2]; f32x4 prs[4]; float sc2[4];
#pragma unroll
            for (int m = 0; m < 4; ++m) prs[m] = rs_in ? *(const f32x4*)(rs_in + (size_t)(u.pm * BM + ai * HALF + wr * 64 + m * 16 + fr) * 16 + 4 * fq) : (f32x4){0.f, 0.f, 0.f, 0.f};
#pragma unroll
            for (int m = 0; m < 4; ++m) { const size_t off = (size_t)(u.pm * BM + ai * HALF + wr * 64 + m * 16 + fr) * 1024 + col0;
#pragma unroll
                for (int bj = 0; bj < 2; ++bj)
#pragma unroll
                    for (int n = 0; n < 2; ++n) pre[ai][m][bj][n] = *(const u32x2*)(hb + off + bj * HALF + n * 16); }
#pragma unroll
            for (int m = 0; m < 4; ++m) { float s = (prs[m][0] + prs[m][1]) + (prs[m][2] + prs[m][3]); s += __shfl_xor(s, 16); s += __shfl_xor(s, 32);
                sc2[m] = rs_in ? 1.0f / (s * (1.0f / 1024.0f) + 1e-6f) : 1.0f; }
#pragma unroll
            for (int m = 0; m < 4; ++m) {
                const int row = u.pm * BM + ai * HALF + wr * 64 + m * 16 + fr; const size_t off = (size_t)row * 1024 + col0;
                float ss = 0.f;
#pragma unroll
                for (int bj = 0; bj < 2; ++bj)
#pragma unroll
                    for (int n = 0; n < 2; ++n) {
                        const u32x2 p = pre[ai][m][bj][n];
                        f32x4 o; o[0] = __builtin_bit_cast(float, p.x << 16); o[1] = __builtin_bit_cast(float, p.x & 0xffff0000u); o[2] = __builtin_bit_cast(float, p.y << 16); o[3] = __builtin_bit_cast(float, p.y & 0xffff0000u);
                        o = o + acc[ai][bj][m][n] * sc2[m];
                        u32x2 w; w.x = cvt_pk_bf16(o[0], o[1]); w.y = cvt_pk_bf16(o[2], o[3]);
                        *(u32x2*)(hb + off + bj * HALF + n * 16) = w;
                        ss += (o[0] * o[0] + o[1] * o[1]) + (o[2] * o[2] + o[3] * o[3]);
                    }
                ss += __shfl_xor(ss, 16); ss += __shfl_xor(ss, 32);
                if (fq == 0) rsq[(size_t)row * 16 + u.pn * 4 + wc] = ss;
            }
        }
    }
};
template <class Epi, class Sched, bool ALIGN_EPI = false, bool SP2 = false>
__device__ __forceinline__ void gemm_phase(PG8_LAS unsigned char* lds, const Gemm g, const Sched& S, const Epi& E) {
    int tid_ = threadIdx.x; asm volatile("" : "+v"(tid_)); const int tid = tid_, wid = __builtin_amdgcn_readfirstlane(tid >> 6), lane = tid & 63, wr = wid >> 2, wc = wid & 3, fr = lane & 15, fq = lane >> 4;
    const int K = g.K, nt = K / BK;
    unsigned voffA[2], voffB[2];
#pragma unroll
    for (int i = 0; i < 2; ++i) { int R, C; stage_rc(tid * 16 + i * 8192, R, C); const int Rb = Epi::PERM ? ((R & ~31) + perm32(R & 31)) : R;
        voffA[i] = (unsigned)(R * K + C) * 2u; voffB[i] = (unsigned)(Rb * K + C) * 2u; }
    const size_t kstep = (size_t)(BK * 2);
    const size_t hstep = (size_t)HALF * K * 2;
    const size_t tstep = 2 * hstep;
    const unsigned ldsw = (unsigned)wid * 1024u;
    const int aoff = lds_byte(wr * 64 + fr, fq * 8), boff = lds_byte(wc * 32 + fr, fq * 8);
#define PG8_SA(b, h) (((b) * 2 + (h)) * HTB)
#define PG8_SB(b, h) ((4 + (b) * 2 + (h)) * HTB)
#define PG8_STAGE(bufoff, gbase, voff) do { _Pragma("unroll") for (int _i = 0; _i < 2; ++_i) \
        __builtin_amdgcn_global_load_lds((const unsigned*)((const char*)(gbase) + (voff)[_i]), (PG8_LAS unsigned*)(lds + (bufoff) + ldsw + _i * 8192), 16, 0, 0); } while (0)
#define PG8_LDA(dst, b, h) do { _Pragma("unroll") for (int m = 0; m < 4; ++m) _Pragma("unroll") for (int k = 0; k < 2; ++k) dst[m][k] = *(const PG8_LAS bf16x8*)(lds + PG8_SA(b, h) + aoff + m * 2048 + k * 1024); } while (0)
#define PG8_LDB(dst, b, h) do { _Pragma("unroll") for (int n = 0; n < 2; ++n) _Pragma("unroll") for (int k = 0; k < 2; ++k) dst[n][k] = *(const PG8_LAS bf16x8*)(lds + PG8_SB(b, h) + boff + n * 2048 + k * 1024); } while (0)
#define PG8_MMA(ai, bj, At, Bt) do { __builtin_amdgcn_s_setprio(1); _Pragma("unroll") for (int m = 0; m < 4; ++m) _Pragma("unroll") for (int n = 0; n < 2; ++n) _Pragma("unroll") for (int k = 0; k < 2; ++k) \
        acc[ai][bj][m][n] = __builtin_amdgcn_mfma_f32_16x16x32_bf16(Bt[n][k], At[m][k], acc[ai][bj][m][n], 0, 0, 0); __builtin_amdgcn_s_setprio(0); } while (0)
#define PG8_WAIT_V(n) asm volatile("s_waitcnt vmcnt(" #n ")" ::: "memory")
#define PG8_WAIT_L(n) asm volatile("s_waitcnt lgkmcnt(" #n ")" ::: "memory")
#define PG8_BAR __builtin_amdgcn_s_barrier()
#define PG8_SCHED __builtin_amdgcn_sched_barrier(0)
    Unit cur, nxt; int ui = 0;
    if (!S.next(0, cur)) return;
    f32x4 acc[2][2][4][2];
#pragma unroll
    for (int a = 0; a < 2; ++a)
#pragma unroll
        for (int b = 0; b < 2; ++b)
#pragma unroll
            for (int m = 0; m < 4; ++m)
#pragma unroll
                for (int n = 0; n < 2; ++n) acc[a][b][m][n] = (f32x4){0.f, 0.f, 0.f, 0.f};
    bf16x8 At[4][2], B0[2][2], B1[2][2];
    const char* cA = (const char*)g.A + (size_t)cur.pm * tstep; const char* cB = (const char*)g.Bt + (size_t)cur.pn * tstep;
    S.a_ready(cur);
    if constexpr (SP2) {
        PG8_STAGE(PG8_SB(0, 0), cB, voffB); PG8_STAGE(PG8_SB(0, 1), cB + hstep, voffB); PG8_STAGE(PG8_SA(0, 0), cA, voffA); PG8_STAGE(PG8_SA(0, 1), cA + hstep, voffA);
        if (wr == 1) PG8_BAR;
        PG8_WAIT_V(2); PG8_BAR;
        PG8_STAGE(PG8_SB(1, 0), cB + kstep, voffB); PG8_STAGE(PG8_SA(1, 0), cA + kstep, voffA); PG8_STAGE(PG8_SB(1, 1), cB + hstep + kstep, voffB);
        PG8_WAIT_V(6); PG8_BAR;
    } else {
        PG8_STAGE(PG8_SB(0, 0), cB, voffB); PG8_STAGE(PG8_SA(0, 0), cA, voffA); PG8_STAGE(PG8_SB(0, 1), cB + hstep, voffB); PG8_STAGE(PG8_SA(0, 1), cA + hstep, voffA);
        if (wr == 1) PG8_BAR;
        PG8_WAIT_V(4); PG8_BAR;
        PG8_STAGE(PG8_SB(1, 0), cB + kstep, voffB); PG8_STAGE(PG8_SA(1, 0), cA + kstep, voffA); PG8_STAGE(PG8_SB(1, 1), cB + hstep + kstep, voffB);
        PG8_WAIT_V(6); PG8_BAR;
    }
    for (;;) {
        const bool has_next = S.next(ui + 1, nxt);
        const char* nA = has_next ? (const char*)g.A + (size_t)nxt.pm * tstep : cA; const char* nB = has_next ? (const char*)g.Bt + (size_t)nxt.pn * tstep : cB;
        for (int t = 0; t < nt; t += 2) {
            const bool last = (t == nt - 2);
            const char* a1 = cA + (size_t)(t + 1) * kstep;
            const char* a2 = last ? nA : cA + (size_t)(t + 2) * kstep; const char* b2 = last ? nB : cB + (size_t)(t + 2) * kstep;
            const char* a3 = a2 + kstep; const char* b3 = b2 + kstep;
            if (last && has_next) S.a_ready(nxt);
            if constexpr (SP2) {
            PG8_LDB(B0, 0, 0); PG8_LDB(B1, 0, 1); PG8_SCHED; PG8_LDA(At, 0, 0); PG8_STAGE(PG8_SA(1, 1), a1 + hstep, voffA);
            PG8_WAIT_V(8); PG8_WAIT_L(0); PG8_BAR; PG8_MMA(0, 0, At, B0); PG8_MMA(0, 1, At, B1); PG8_BAR; PG8_SCHED;
            PG8_LDA(At, 0, 1); PG8_STAGE(PG8_SB(0, 0), b2, voffB); PG8_STAGE(PG8_SB(0, 1), b2 + hstep, voffB); PG8_STAGE(PG8_SA(0, 0), a2, voffA);
            PG8_WAIT_V(8); PG8_WAIT_L(0); PG8_BAR; PG8_MMA(1, 0, At, B0); PG8_MMA(1, 1, At, B1); PG8_BAR; PG8_SCHED;
            PG8_LDB(B0, 1, 0); PG8_LDB(B1, 1, 1); PG8_SCHED; PG8_LDA(At, 1, 0); PG8_STAGE(PG8_SA(0, 1), a2 + hstep, voffA);
            PG8_WAIT_V(8); PG8_WAIT_L(0); PG8_BAR; PG8_MMA(0, 0, At, B0); PG8_MMA(0, 1, At, B1); PG8_BAR; PG8_SCHED;
            PG8_LDA(At, 1, 1); PG8_STAGE(PG8_SB(1, 0), b3, voffB); PG8_STAGE(PG8_SB(1, 1), b3 + hstep, voffB); PG8_STAGE(PG8_SA(1, 0), a3, voffA);
            PG8_WAIT_V(8); PG8_WAIT_L(0); PG8_BAR; PG8_MMA(1, 0, At, B0); PG8_MMA(1, 1, At, B1); PG8_BAR; PG8_SCHED;
            } else {
            PG8_LDB(B0, 0, 0); PG8_SCHED; PG8_LDA(At, 0, 0); PG8_STAGE(PG8_SA(1, 1), a1 + hstep, voffA);
            PG8_WAIT_L(8); PG8_BAR; PG8_WAIT_L(0); PG8_MMA(0, 0, At, B0); PG8_BAR; PG8_SCHED;
            PG8_LDB(B1, 0, 1); PG8_STAGE(PG8_SB(0, 0), b2, voffB);
            PG8_BAR; PG8_WAIT_L(0); PG8_MMA(0, 1, At, B1); PG8_BAR;
            PG8_LDA(At, 0, 1); PG8_STAGE(PG8_SA(0, 0), a2, voffA);
            PG8_BAR; PG8_WAIT_L(0); PG8_MMA(1, 0, At, B0); PG8_BAR; PG8_SCHED;
            PG8_STAGE(PG8_SB(0, 1), b2 + hstep, voffB);
            PG8_WAIT_V(6); PG8_BAR; PG8_MMA(1, 1, At, B1); PG8_BAR;
            PG8_LDB(B0, 1, 0); PG8_SCHED; PG8_LDA(At, 1, 0); PG8_STAGE(PG8_SA(0, 1), a2 + hstep, voffA);
            PG8_WAIT_L(8); PG8_BAR; PG8_WAIT_L(0); PG8_MMA(0, 0, At, B0); PG8_BAR; PG8_SCHED;
            PG8_LDB(B1, 1, 1); PG8_STAGE(PG8_SB(1, 0), b3, voffB);
            PG8_BAR; PG8_WAIT_L(0); PG8_MMA(0, 1, At, B1); PG8_BAR;
            PG8_LDA(At, 1, 1); PG8_STAGE(PG8_SA(1, 0), a3, voffA);
            PG8_BAR; PG8_WAIT_L(0); PG8_MMA(1, 0, At, B0); PG8_BAR; PG8_SCHED;
            PG8_STAGE(PG8_SB(1, 1), b3 + hstep, voffB);
            PG8_WAIT_V(6); PG8_BAR; PG8_MMA(1, 1, At, B1); PG8_BAR;
            }
        }
        if constexpr (ALIGN_EPI) { if (wr == 0) PG8_BAR; }
        if constexpr (!Epi::AFTER_DRAIN) { E(acc, cur, wr, wc, fr, fq); S.done(cur); }
        if (!has_next) break;
#pragma unroll
        for (int a = 0; a < 2; ++a)
#pragma unroll
            for (int b = 0; b < 2; ++b)
#pragma unroll
                for (int m = 0; m < 4; ++m)
#pragma unroll
                    for (int n = 0; n < 2; ++n) acc[a][b][m][n] = (f32x4){0.f, 0.f, 0.f, 0.f};
        cur = nxt; cA = nA; cB = nB; ++ui;
        if constexpr (ALIGN_EPI) { if (wr == 1) PG8_BAR; }
    }
    PG8_WAIT_V(0);
    if constexpr (!ALIGN_EPI) { if (wr == 0) PG8_BAR; }
    PG8_BAR;
    if constexpr (Epi::AFTER_DRAIN) { E.fused(acc, cur, wr, wc, fr, fq, lds, wid, lane); S.done(cur); }
#undef PG8_SA
#undef PG8_SB
#undef PG8_STAGE
#undef PG8_LDA
#undef PG8_LDB
#undef PG8_MMA
#undef PG8_WAIT_V
#undef PG8_WAIT_L
#undef PG8_BAR
#undef PG8_SCHED
}
}
#define GAS __attribute__((address_space(1)))
#define LAS __attribute__((address_space(3)))
typedef unsigned short bf16;
typedef unsigned v4u __attribute__((ext_vector_type(4)));
typedef unsigned v2u __attribute__((ext_vector_type(2)));
typedef float f32x4 __attribute__((ext_vector_type(4)));
typedef short bf16x8 __attribute__((ext_vector_type(8)));
#ifndef REP_HG
#define REP_HG 1
#endif
#ifndef REP_RW
#define REP_RW 1
#endif
#ifndef REP_UP
#define REP_UP 1
#endif
#ifndef REP_ATT
#define REP_ATT 1
#endif
#ifndef REP_PRO
#define REP_PRO 1
#endif
#ifndef REP_G1
#define REP_G1 1
#endif
#ifndef REP_G2
#define REP_G2 1
#endif
#ifndef REP_SC
#define REP_SC 1
#endif
#ifndef REP_DN
#define REP_DN 1
#endif
#ifndef REP_OUT
#define REP_OUT 1
#endif
#ifndef REP_HGL
#define REP_HGL 1
#endif
#ifndef REP_IN
#define REP_IN 1
#endif
#ifndef REP_SYNC
#define REP_SYNC 1
#endif
#define GRID_SYNC() do { for (int r_ = 0; r_ < REP_SYNC; ++r_) xcd_barrier(xbar); } while (0)
constexpr int NWAVES = 8, NTHR = 512;
constexpr int M = 32768, D = 1024, SEQ = 8192, FF = 4096;
constexpr size_t MiB = 1u << 20;
constexpr size_t WS_BAR = 64 * 1024, WS_BAR_BYTES = 16 * 1024;
constexpr size_t WS_LBK = 0;
constexpr size_t WS_RS = 1 * MiB;
constexpr size_t WS_WA = 4 * MiB, WS_WB = 18 * MiB, WS_WO = 20 * MiB, WS_WUP = 22 * MiB, WS_WDN = 30 * MiB;
constexpr size_t WS_HB = 38 * MiB;
constexpr size_t WS_BIG = 102 * MiB;
constexpr size_t SLOT = 64 * MiB;
constexpr size_t WS_END = 512 * MiB;
constexpr int LDS_BYTES = 163840;
constexpr float LOG2E_F = 1.4426950408889634f;

#define LDS_WAIT() asm volatile("s_waitcnt lgkmcnt(0)" ::: "memory")
typedef float f32x2_t __attribute__((ext_vector_type(2))); typedef __bf16 bf16x2_t __attribute__((ext_vector_type(2)));
__device__ __forceinline__ unsigned pk2(float lo, float hi) { const f32x2_t v = {lo, hi}; const bf16x2_t b = __builtin_convertvector(v, bf16x2_t); return __builtin_bit_cast(unsigned, b); }
__device__ __forceinline__ unsigned f2bf(float f) { return pk2(f, 0.f) & 0xffffu; }
__device__ __forceinline__ float bflo(unsigned u) { return __builtin_bit_cast(float, u << 16); }
__device__ __forceinline__ float bfhi(unsigned u) { return __builtin_bit_cast(float, u & 0xffff0000u); }
__device__ __forceinline__ float bf1(unsigned short b) { return __builtin_bit_cast(float, (unsigned)b << 16); }
__device__ __forceinline__ f32x4 bf4(v2u u) { return (f32x4){bflo(u.x), bfhi(u.x), bflo(u.y), bfhi(u.y)}; }
__device__ __forceinline__ float wave_sum(float v) {
#pragma unroll
    for (int o = 1; o < 64; o <<= 1) v += __shfl_xor(v, o);
    return v;
}
template <int CTRL> __device__ __forceinline__ float dpp_f(float x) { return __builtin_bit_cast(float, __builtin_amdgcn_update_dpp(0, __builtin_bit_cast(int, x), CTRL, 0xf, 0xf, true)); }
__device__ __forceinline__ float row16_sum(float x) { x += dpp_f<0xB1>(x); x += dpp_f<0x4E>(x); x += dpp_f<0x141>(x); x += dpp_f<0x140>(x); return x; }

__device__ __forceinline__ void wt_item(const float* W, int K, int N, bf16* WT, int ld, int row_off, int col_off, const float* sc, LAS float* scr, int item, int lane) {
    const int nblk = N / 32, kb = item / nblk, nb = item % nblk, k0 = 64 * kb, n0 = 32 * nb;
    f32x4 wv[8]; float sv[8];
#pragma unroll
    for (int i = 0; i < 8; ++i) { const int kk = 8 * i + (lane >> 3); wv[i] = *(const f32x4*)(W + (size_t)(k0 + kk) * N + n0 + 4 * (lane & 7)); sv[i] = sc ? sc[k0 + kk] : 1.f; }
#pragma unroll
    for (int i = 0; i < 8; ++i) { const int kk = 8 * i + (lane >> 3); LAS float* d = scr + kk * 33 + 4 * (lane & 7); d[0] = wv[i][0] * sv[i]; d[1] = wv[i][1] * sv[i]; d[2] = wv[i][2] * sv[i]; d[3] = wv[i][3] * sv[i]; }
    LDS_WAIT(); asm volatile("" ::: "memory");
    const int c = lane & 7;
#pragma unroll
    for (int j = 0; j < 4; ++j) { const int n = (lane >> 3) + 8 * j; const LAS float* s = scr + (8 * c) * 33 + n;
        v4u o; o.x = pk2(s[0 * 33], s[1 * 33]); o.y = pk2(s[2 * 33], s[3 * 33]); o.z = pk2(s[4 * 33], s[5 * 33]); o.w = pk2(s[6 * 33], s[7 * 33]);
        *(v4u*)(WT + (size_t)(row_off + n0 + n) * ld + col_off + k0 + 8 * c) = o; }
    LDS_WAIT(); asm volatile("" ::: "memory");
}
__device__ __forceinline__ void conv_mat(const float* W, int K, int N, bf16* WT, int ld, int row_off, int col_off, const float* sc, LAS float* scr, int gw, int ngw, int lane) {
    const int nitems = (K / 64) * (N / 32);
    for (int it = gw; it < nitems; it += ngw) wt_item(W, K, N, WT, ld, row_off, col_off, sc, scr, it, lane);
}

__device__ __forceinline__ void attn_phase(const bf16* Q, const bf16* K, const bf16* V, bf16* O, int gw, int ngw, int lane) {
    const int fr = lane & 15, fq = lane >> 4;
    for (int unit = gw; unit < (M / 16) * 16; unit += ngw) {
        const int qt = unit & 511, bh = unit >> 9, h = bh & 15, b = bh >> 4;
        const int t0 = qt * 16; const size_t rowb = (size_t)b * SEQ;
        const bf16* qp = Q + (rowb + t0 + fr) * 1024 + h * 64 + fq * 8;
        const bf16x8 qb0 = *(const bf16x8*)(qp), qb1 = *(const bf16x8*)(qp + 32);
        f32x4 o[4];
#pragma unroll
        for (int dt = 0; dt < 4; ++dt) o[dt] = (f32x4){0.f, 0.f, 0.f, 0.f};
        float carry = 1.f;
        const int tq = t0 + fr;
        bf16x8 kn0, kn1; unsigned short vn[4][4];
#define ATT_LOAD(SH) { int sk_ = (SH) - fr; sk_ = sk_ < 0 ? 0 : sk_; const bf16* kp_ = K + (rowb + sk_) * 1024 + h * 64 + fq * 8; kn0 = *(const bf16x8*)(kp_); kn1 = *(const bf16x8*)(kp_ + 32); \
            _Pragma("unroll") for (int j = 0; j < 4; ++j) { int sv_ = (SH) - (4 * fq + j); sv_ = sv_ < 0 ? 0 : sv_; const bf16* vp_ = V + (rowb + sv_) * 1024 + h * 64 + fr; \
                _Pragma("unroll") for (int dt = 0; dt < 4; ++dt) vn[dt][j] = vp_[16 * dt]; } }
        ATT_LOAD(t0 + 14)
        for (int s_hi = t0 + 14; s_hi >= 0; s_hi -= 16) {
            const bf16x8 ka0 = kn0, ka1 = kn1;
            unsigned short vv[4][4];
#pragma unroll
            for (int j = 0; j < 4; ++j)
#pragma unroll
                for (int dt = 0; dt < 4; ++dt) vv[dt][j] = vn[dt][j];
            ATT_LOAD(s_hi - 16)
            f32x4 z = (f32x4){0.f, 0.f, 0.f, 0.f};
            z = __builtin_amdgcn_mfma_f32_16x16x32_bf16(ka0, qb0, z, 0, 0, 0);
            z = __builtin_amdgcn_mfma_f32_16x16x32_bf16(ka1, qb1, z, 0, 0, 0);
            float dd[4], sg[4];
#pragma unroll
            for (int i = 0; i < 4; ++i) {
                const int s = s_hi - (4 * fq + i);
                const bool valid = (s >= 0) && (s < tq);
                const float e = __builtin_amdgcn_exp2f(fminf(z[i], 100.f));
                const float d = __builtin_amdgcn_rcpf(1.0f + e);
                dd[i] = valid ? d : 1.f; sg[i] = valid ? e * d : 0.f;
            }
            const float c1 = dd[0], c2 = c1 * dd[1], c3 = c2 * dd[2], g = c3 * dd[3];
            const float g0 = __shfl(g, fr), g1 = __shfl(g, fr + 16), g2 = __shfl(g, fr + 32), g3 = __shfl(g, fr + 48);
            float pre = carry;
            if (fq > 0) pre *= g0;
            if (fq > 1) pre *= g1;
            if (fq > 2) pre *= g2;
            carry = carry * ((g0 * g1) * (g2 * g3));
            const float p0 = sg[0] * pre, p1 = sg[1] * (pre * c1), p2 = sg[2] * (pre * c2), p3 = sg[3] * (pre * c3);
            bf16x8 pb; { const unsigned w0 = pk2(p0, p1), w1 = pk2(p2, p3); pb[0] = (short)(w0 & 0xffff); pb[1] = (short)(w0 >> 16); pb[2] = (short)(w1 & 0xffff); pb[3] = (short)(w1 >> 16); pb[4] = 0; pb[5] = 0; pb[6] = 0; pb[7] = 0; }
#pragma unroll
            for (int dt = 0; dt < 4; ++dt) {
                bf16x8 va; va[0] = (short)vv[dt][0]; va[1] = (short)vv[dt][1]; va[2] = (short)vv[dt][2]; va[3] = (short)vv[dt][3]; va[4] = 0; va[5] = 0; va[6] = 0; va[7] = 0;
                o[dt] = __builtin_amdgcn_mfma_f32_16x16x32_bf16(va, pb, o[dt], 0, 0, 0);
            }
            if (__builtin_amdgcn_ballot_w64(carry != 0.f) == 0ull) break;
        }
#undef ATT_LOAD
        bf16* op = O + (rowb + t0 + fr) * 1024 + h * 64 + fq * 4;
#pragma unroll
        for (int dt = 0; dt < 4; ++dt) { v2u w; w.x = pk2(o[dt][0], o[dt][1]); w.y = pk2(o[dt][2], o[dt][3]); *(v2u*)(op + 16 * dt) = w; }
    }
}

typedef unsigned u32x4_t __attribute__((ext_vector_type(4)));
__device__ __forceinline__ bf16x8 mk8(unsigned a, unsigned b, unsigned c, unsigned d) { const u32x4_t t = {a, b, c, d}; return __builtin_bit_cast(bf16x8, t); }
__device__ __forceinline__ void hg_prep_item(bf16* QS, bf16* KF, bf16* KT, float* DB, int chunk, int c) {
    {
        const size_t base = (size_t)chunk * 16 * 1024 + c;
        v2u kin[16], qin[16];
#pragma unroll
        for (int t = 0; t < 16; ++t) { kin[t] = *(const v2u*)(KF + base + (size_t)t * 1024); qin[t] = *(const v2u*)(QS + base + (size_t)t * 1024); }
        float b[4] = {0.f, 0.f, 0.f, 0.f};
        unsigned ktp[4][8];
#pragma unroll
        for (int t2 = 0; t2 < 8; ++t2) {
            float kt2[2][4];
#pragma unroll
            for (int u = 0; u < 2; ++u) {
                const int t = 2 * t2 + u;
                const f32x4 kf = bf4(kin[t]), q = bf4(qin[t]);
                float qt[4];
#pragma unroll
                for (int j = 0; j < 4; ++j) {
                    const float fdec = fmaxf(1.0f - kf[j], 1e-4f);
                    b[j] += __builtin_amdgcn_logf(fdec);
                    const float e = __builtin_amdgcn_exp2f(b[j]);
                    qt[j] = q[j] * e; kt2[u][j] = kf[j] * __builtin_amdgcn_rcpf(e);
                }
                v2u qo; qo.x = pk2(qt[0], qt[1]); qo.y = pk2(qt[2], qt[3]); *(v2u*)(QS + base + (size_t)t * 1024) = qo;
                v2u ko; ko.x = pk2(kt2[u][0], kt2[u][1]); ko.y = pk2(kt2[u][2], kt2[u][3]); *(v2u*)(KF + base + (size_t)t * 1024) = ko;
            }
#pragma unroll
            for (int j = 0; j < 4; ++j) ktp[j][t2] = pk2(kt2[0][j], kt2[1][j]);
        }
        f32x4 dv; dv[0] = __builtin_amdgcn_exp2f(b[0]); dv[1] = __builtin_amdgcn_exp2f(b[1]); dv[2] = __builtin_amdgcn_exp2f(b[2]); dv[3] = __builtin_amdgcn_exp2f(b[3]);
        *(f32x4*)(DB + (size_t)chunk * 1024 + c) = dv;
#pragma unroll
        for (int j = 0; j < 4; ++j) { v4u* kp = (v4u*)(KT + ((size_t)chunk * 1024 + c + j) * 16);
            kp[0] = (v4u){ktp[j][0], ktp[j][1], ktp[j][2], ktp[j][3]}; kp[1] = (v4u){ktp[j][4], ktp[j][5], ktp[j][6], ktp[j][7]}; }
    }
}
__device__ __forceinline__ void hg_local(bf16* QS, bf16* KF, bf16* KT, const bf16* IV, float* DB, float* SL, float* DT) {
    int tid_ = threadIdx.x; asm volatile("" : "+v"(tid_)); const int tid = tid_, lane = tid & 63, w = __builtin_amdgcn_readfirstlane(tid >> 6), fr = lane & 15, fq = lane >> 4;
    for (int unit = blockIdx.x; unit < 256; unit += gridDim.x) {
        const int seg = unit & 7, bh = unit >> 3, h = bh & 7, b = bh >> 3;
#pragma unroll 1
        for (int ps = 0; ps < 4; ++ps) hg_prep_item(QS, KF, KT, DB, (int)((((size_t)b * SEQ + (size_t)seg * 1024) >> 4) + 16 * ps + 2 * w + (lane >> 5)), 128 * h + 4 * (lane & 31));
        asm volatile("s_waitcnt vmcnt(0)" ::: "memory"); __syncthreads();
        if (seg == 7) continue;
        f32x4 S[8], DTt[8];
#pragma unroll
        for (int kt = 0; kt < 8; ++kt) { S[kt] = (f32x4){0.f, 0.f, 0.f, 0.f}; DTt[kt] = (f32x4){1.f, 1.f, 1.f, 1.f}; }
        const size_t m0 = (size_t)b * SEQ + (size_t)seg * 1024;
        v2u kt1[8], kt2[8]; f32x4 d1[8], d2[8]; unsigned short v1_[4], v2_[4];
#define HGL_LOAD(KTV, DV, VV, CJ) { const int cj_ = (CJ) < 64 ? (CJ) : 63; const size_t chunk_ = (m0 >> 4) + cj_, mrow_ = m0 + 16 * cj_; \
          _Pragma("unroll") for (int kt = 0; kt < 8; ++kt) { KTV[kt] = *(const v2u*)(KT + (chunk_ * 1024 + 128 * h + 16 * kt + fr) * 16 + 4 * fq); DV[kt] = *(const f32x4*)(DB + chunk_ * 1024 + 128 * h + 16 * kt + 4 * fq); } \
          const bf16* vp_ = IV + (mrow_ + 4 * fq) * 1024 + 128 * h + 16 * w + fr; VV[0] = vp_[0]; VV[1] = vp_[1024]; VV[2] = vp_[2048]; VV[3] = vp_[3072]; }
        HGL_LOAD(kt1, d1, v1_, 0) HGL_LOAD(kt2, d2, v2_, 1)
        for (int ci = 0; ci < 64; ++ci) {
            v2u ktv[8]; f32x4 dv[8];
#pragma unroll
            for (int kt = 0; kt < 8; ++kt) { ktv[kt] = kt1[kt]; dv[kt] = d1[kt]; kt1[kt] = kt2[kt]; d1[kt] = d2[kt]; }
            const unsigned v0 = v1_[0], v1 = v1_[1], v2 = v1_[2], v3 = v1_[3];
#pragma unroll
            for (int x = 0; x < 4; ++x) v1_[x] = v2_[x];
            HGL_LOAD(kt2, d2, v2_, ci + 2)
            const bf16x8 vb = mk8(v0 | (v1 << 16), v2 | (v3 << 16), 0u, 0u);
#pragma unroll
            for (int kt = 0; kt < 8; ++kt) { S[kt] = __builtin_amdgcn_mfma_f32_16x16x32_bf16(mk8(ktv[kt].x, ktv[kt].y, 0u, 0u), vb, S[kt], 0, 0, 0); S[kt] = S[kt] * dv[kt]; DTt[kt] = DTt[kt] * dv[kt]; }
        }
#undef HGL_LOAD
#pragma unroll
        for (int kt = 0; kt < 8; ++kt) {
#pragma unroll
            for (int i = 0; i < 4; ++i) SL[((size_t)(bh * 8 + seg) * 128 + 16 * kt + 4 * fq + i) * 128 + 16 * w + fr] = S[kt][i];
            if (w == 0 && fr == 0) *(f32x4*)(DT + (size_t)(bh * 8 + seg) * 128 + 16 * kt + 4 * fq) = DTt[kt];
        }
    }
}
__device__ __forceinline__ void hg_out(const bf16* QT, const bf16* KTL, const bf16* KT, const bf16* IV, const float* DB, const float* SL, const float* DT, const float* norm_g, bf16* SGO, LAS unsigned char* lds) {
    int tid_ = threadIdx.x; asm volatile("" : "+v"(tid_)); const int tid = tid_, lane = tid & 63, w = __builtin_amdgcn_readfirstlane(tid >> 6), fr = lane & 15, fq = lane >> 4;
    LAS float* ssb = (LAS float*)lds;
    for (int unit = blockIdx.x; unit < 256; unit += gridDim.x) {
        const int seg = unit & 7, bh = unit >> 3, h = bh & 7, b = bh >> 3;
        f32x4 S[8];
#pragma unroll
        for (int kt = 0; kt < 8; ++kt) S[kt] = (f32x4){0.f, 0.f, 0.f, 0.f};
        for (int j = 0; j < seg; ++j) {
#pragma unroll
            for (int kt = 0; kt < 8; ++kt) {
                const f32x4 dt = *(const f32x4*)(DT + (size_t)(bh * 8 + j) * 128 + 16 * kt + 4 * fq);
#pragma unroll
                for (int i = 0; i < 4; ++i) S[kt][i] = S[kt][i] * dt[i] + SL[((size_t)(bh * 8 + j) * 128 + 16 * kt + 4 * fq + i) * 128 + 16 * w + fr];
            }
        }
        const float ng = norm_g[128 * h + 16 * w + fr];
        const size_t m0 = (size_t)b * SEQ + (size_t)seg * 1024;
        v2u qn[8], kn[8];
        { const bf16* qp = QT + (m0 + fr) * 1024 + 128 * h + 4 * fq; const bf16* kp = KTL + (m0 + fr) * 1024 + 128 * h + 4 * fq;
#pragma unroll
          for (int x = 0; x < 8; ++x) { qn[x] = *(const v2u*)(qp + 16 * x); kn[x] = *(const v2u*)(kp + 16 * x); } }
        unsigned short vn[4], gn[4];
        { const bf16* vp = IV + (m0 + 4 * fq) * 1024 + 128 * h + 16 * w + fr; const bf16* gq = SGO + (m0 + 4 * fq) * 1024 + 128 * h + 16 * w + fr;
          vn[0] = vp[0]; vn[1] = vp[1024]; vn[2] = vp[2048]; vn[3] = vp[3072]; gn[0] = gq[0]; gn[1] = gq[1024]; gn[2] = gq[2048]; gn[3] = gq[3072]; }
        for (int ci = 0; ci < 64; ++ci) {
            const size_t chunk = (m0 >> 4) + ci, mrow = m0 + 16 * ci;
            v2u ktv[8]; f32x4 dv[8];
#pragma unroll
            for (int kt = 0; kt < 8; ++kt) { ktv[kt] = *(const v2u*)(KT + (chunk * 1024 + 128 * h + 16 * kt + fr) * 16 + 4 * fq); dv[kt] = *(const f32x4*)(DB + chunk * 1024 + 128 * h + 16 * kt + 4 * fq); }
            const unsigned v0 = vn[0], v1 = vn[1], v2 = vn[2], v3 = vn[3];
            bf16* gp = SGO + (mrow + 4 * fq) * 1024 + 128 * h + 16 * w + fr;
            const float sg0 = bf1(gn[0]), sg1 = bf1(gn[1]), sg2 = bf1(gn[2]), sg3 = bf1(gn[3]);
            { const size_t mn = m0 + 16 * (ci + 1 < 64 ? ci + 1 : ci); const bf16* vp = IV + (mn + 4 * fq) * 1024 + 128 * h + 16 * w + fr; const bf16* gq = SGO + (mn + 4 * fq) * 1024 + 128 * h + 16 * w + fr;
              if (ci + 1 < 64) { vn[0] = vp[0]; vn[1] = vp[1024]; vn[2] = vp[2048]; vn[3] = vp[3072]; gn[0] = gq[0]; gn[1] = gq[1024]; gn[2] = gq[2048]; gn[3] = gq[3072]; } }
            v2u qc[8], kc[8];
#pragma unroll
            for (int x = 0; x < 8; ++x) { qc[x] = qn[x]; kc[x] = kn[x]; }
            { const size_t mn = m0 + 16 * (ci + 1 < 64 ? ci + 1 : ci); const bf16* qp = QT + (mn + fr) * 1024 + 128 * h + 4 * fq; const bf16* kp = KTL + (mn + fr) * 1024 + 128 * h + 4 * fq;
#pragma unroll
              for (int x = 0; x < 8; ++x) { qn[x] = *(const v2u*)(qp + 16 * x); kn[x] = *(const v2u*)(kp + 16 * x); } }
            const bf16x8 vb = mk8(v0 | (v1 << 16), v2 | (v3 << 16), 0u, 0u);
            f32x4 pt = (f32x4){0.f, 0.f, 0.f, 0.f};
#pragma unroll
            for (int p = 0; p < 4; ++p) pt = __builtin_amdgcn_mfma_f32_16x16x32_bf16(mk8(kc[2 * p].x, kc[2 * p].y, kc[2 * p + 1].x, kc[2 * p + 1].y), mk8(qc[2 * p].x, qc[2 * p].y, qc[2 * p + 1].x, qc[2 * p + 1].y), pt, 0, 0, 0);
#pragma unroll
            for (int i = 0; i < 4; ++i) if (4 * fq + i > fr) pt[i] = 0.f;
            f32x4 o = (f32x4){0.f, 0.f, 0.f, 0.f};
#pragma unroll
            for (int p = 0; p < 4; ++p) {
                const bf16x8 sb = mk8(pk2(S[2 * p][0], S[2 * p][1]), pk2(S[2 * p][2], S[2 * p][3]), pk2(S[2 * p + 1][0], S[2 * p + 1][1]), pk2(S[2 * p + 1][2], S[2 * p + 1][3]));
                o = __builtin_amdgcn_mfma_f32_16x16x32_bf16(mk8(qc[2 * p].x, qc[2 * p].y, qc[2 * p + 1].x, qc[2 * p + 1].y), sb, o, 0, 0, 0);
            }
            o = __builtin_amdgcn_mfma_f32_16x16x32_bf16(mk8(pk2(pt[0], pt[1]), pk2(pt[2], pt[3]), 0u, 0u), vb, o, 0, 0, 0);
#pragma unroll
            for (int kt = 0; kt < 8; ++kt) { S[kt] = __builtin_amdgcn_mfma_f32_16x16x32_bf16(mk8(ktv[kt].x, ktv[kt].y, 0u, 0u), vb, S[kt], 0, 0, 0); S[kt] = S[kt] * dv[kt]; }
            LAS float* sb_ = ssb + (ci & 1) * 128;
#pragma unroll
            for (int i = 0; i < 4; ++i) { const float ss = row16_sum(o[i] * o[i]); if (fr == 0) sb_[(4 * fq + i) * 8 + w] = ss; }
            __syncthreads();
            const float sgv[4] = {sg0, sg1, sg2, sg3};
#pragma unroll
            for (int i = 0; i < 4; ++i) {
                const f32x4 a0 = *(const LAS f32x4*)(sb_ + (4 * fq + i) * 8), a1 = *(const LAS f32x4*)(sb_ + (4 * fq + i) * 8 + 4);
                const float tot = ((a0[0] + a0[1]) + (a0[2] + a0[3])) + ((a1[0] + a1[1]) + (a1[2] + a1[3]));
                const float r = 1.0f / sqrtf(tot * (1.0f / 128.0f) + 1e-6f);
                gp[(size_t)i * 1024] = (bf16)f2bf(o[i] * r * ng * sgv[i]);
            }
        }
        __syncthreads();
    }
}

__device__ __forceinline__ void rw_prep(const bf16* h, const float* rs, const float* g, bf16* A2, int gw, int ngw, int lane) {
    for (int it = gw; it < M / 2; it += ngw) {
        const int m = 2 * it, t = m & (SEQ - 1);
        const int mp = t ? m - 1 : m;
        f32x4 x[3][4], pr[3];
#pragma unroll
        for (int u = 0; u < 3; ++u) { const int mm = u == 0 ? mp : m + u - 1; pr[u] = *(const f32x4*)(rs + (size_t)mm * 16 + 4 * (lane & 3));
#pragma unroll
            for (int j = 0; j < 4; ++j) x[u][j] = bf4(*(const v2u*)(h + (size_t)mm * 1024 + 4 * lane + 256 * j)); }
        float r3[3];
#pragma unroll
        for (int u = 0; u < 3; ++u) { float s = (pr[u][0] + pr[u][1]) + (pr[u][2] + pr[u][3]); s += dpp_f<0xB1>(s); s += dpp_f<0x4E>(s); r3[u] = 1.0f / sqrtf(s * (1.0f / 1024.0f) + 1e-6f); }
        if (t == 0) r3[0] = 0.f;
#pragma unroll
        for (int j = 0; j < 4; ++j) {
            const int c = 4 * lane + 256 * j;
            const f32x4 gc = *(const f32x4*)(g + c);
            const f32x4 xp = x[0][j] * gc * r3[0], x0 = x[1][j] * gc * r3[1], x1 = x[2][j] * gc * r3[2];
            const f32x4 d0 = xp - x0, d1 = x0 - x1;
            v2u o;
            o.x = pk2(x0[0], x0[1]); o.y = pk2(x0[2], x0[3]); *(v2u*)(A2 + (size_t)m * 2048 + c) = o;
            o.x = pk2(d0[0], d0[1]); o.y = pk2(d0[2], d0[3]); *(v2u*)(A2 + (size_t)m * 2048 + 1024 + c) = o;
            o.x = pk2(x1[0], x1[1]); o.y = pk2(x1[2], x1[3]); *(v2u*)(A2 + (size_t)(m + 1) * 2048 + c) = o;
            o.x = pk2(d1[0], d1[1]); o.y = pk2(d1[2], d1[3]); *(v2u*)(A2 + (size_t)(m + 1) * 2048 + 1024 + c) = o;
        }
    }
}
constexpr int RWS_AH = 0, RWS_RB = 2048, RWS_KGT = 4096, RWS_BGT = 6144, RWS_G15 = 8192, RWS_KNI = 8448, RWS_WVI = 9472, RWS_VCI = 10496, RWS_SLOT = 11264;
constexpr int RWT_AB = 0, RWT_BT = 2048, RWT_KT = 4096, RWT_ABT = 6144, RWT_NM = 0  , RWT_TM = 2048  , RWT_BYTES = 8192;
__device__ __forceinline__ int rwz(int k) { return (k & ~7) | ((k & 7) ^ ((k >> 3) & 7)); }
constexpr int RW_NSLOT = 9, RW_NPROD = 7, RW_RING = RW_NSLOT * RWS_SLOT, RW_FLAGS = RW_RING + RW_NPROD * RWT_BYTES;
struct RwRaw4 { v2u r[4], k[4], wm[4], a[4]; unsigned short v[4]; };
__device__ __forceinline__ void rw_load4(RwRaw4& x, const bf16* R, const bf16* K, const bf16* V, const bf16* WM, const bf16* A, size_t m, int ch, int vch) {
#pragma unroll
    for (int j = 0; j < 4; ++j) { const size_t off = (m + j) * 1024 + ch;
        x.r[j] = *(const v2u*)(R + off); x.k[j] = *(const v2u*)(K + off); x.wm[j] = *(const v2u*)(WM + off); x.a[j] = *(const v2u*)(A + off); x.v[j] = V[(m + j) * 1024 + vch]; }
}
__device__ __forceinline__ bf16x8 lds_op16(const LAS unsigned char* mtx, int row, int kbyte) { return *(const LAS bf16x8*)(mtx + row * 128 + kbyte); }
__device__ __forceinline__ v2u lds_8(const LAS unsigned char* p) { return *(const LAS v2u*)p; }
__device__ __forceinline__ void rw_scan(const bf16* R, const bf16* K, const bf16* V, const bf16* WM, const bf16* A, const float* k_k, const float* k_a, bf16* Y, LAS unsigned char* lds) {
    int tid_ = threadIdx.x; asm volatile("" : "+v"(tid_)); const int tid = tid_, lane = tid & 63, w = __builtin_amdgcn_readfirstlane(tid >> 6);
    const int fr = lane & 15, fq = lane >> 4;
    constexpr int NCH = SEQ / 16;
    for (int unit = blockIdx.x; unit < 256; unit += gridDim.x) {
        const int rg = unit & 3, h = (unit >> 2) & 15, b = unit >> 6;
        const size_t row0 = (size_t)b * SEQ;
        volatile LAS unsigned* flg = (volatile LAS unsigned*)(lds + RW_FLAGS);
        if (tid < 16) flg[tid] = 0u;
        __syncthreads();
        if (w >= 1) {
            const int pw = w - 1, ch = 64 * h + 4 * fr, vch = 64 * h + 16 * rg + fr;
            LAS unsigned char* tmp = lds + RW_RING + pw * RWT_BYTES;
            const f32x4 kkc = *(const f32x4*)(k_k + ch), kac = *(const f32x4*)(k_a + ch);
            RwRaw4 nx; rw_load4(nx, R, K, V, WM, A, row0 + 16 * pw + 4 * fq, ch, vch);
            for (int cj = pw; cj < NCH; cj += RW_NPROD) {
                {
                    const RwRaw4 cu = nx;
                    { const int cn = cj + RW_NPROD < NCH ? cj + RW_NPROD : cj; rw_load4(nx, R, K, V, WM, A, row0 + 16 * (size_t)cn + 4 * fq, ch, vch); }
                    while ((int)flg[RW_NSLOT] < cj - (RW_NSLOT - 1)) __builtin_amdgcn_s_sleep(2);
                    asm volatile("" ::: "memory");
                    LAS unsigned char* slot = lds + (cj % RW_NSLOT) * RWS_SLOT;
                    f32x4 wv[4], kk[4], km[4], be[4], rr[4];
#pragma unroll
                    for (int j = 0; j < 4; ++j) {
                        const f32x4 r = bf4(cu.r[j]), k = bf4(cu.k[j]), wm = bf4(cu.wm[j]), a = bf4(cu.a[j]);
                        const f32x4 kr = k * kkc;
                        const float n2 = row16_sum((kr[0] * kr[0] + kr[1] * kr[1]) + (kr[2] * kr[2] + kr[3] * kr[3]));
                        const float inv = 1.0f / fmaxf(sqrtf(n2), 1e-12f);
                        kk[j] = kr * inv; be[j] = kk[j] * a; km[j] = k * (1.0f + (a - 1.0f) * kac); wv[j] = 1.0f - wm; rr[j] = r;
                    }
                    f32x4 g[4]; g[0] = wv[0]; g[1] = g[0] * wv[1]; g[2] = g[1] * wv[2]; g[3] = g[2] * wv[3];
                    f32x4 pre = (f32x4){1.f, 1.f, 1.f, 1.f}, all = (f32x4){1.f, 1.f, 1.f, 1.f};
#pragma unroll
                    for (int x = 0; x < 4; ++x) {
                        const float t0 = __shfl(g[3][x], fr), t1 = __shfl(g[3][x], 16 + fr), t2 = __shfl(g[3][x], 32 + fr), t3 = __shfl(g[3][x], 48 + fr);
                        float p = 1.f; if (fq > 0) p *= t0; if (fq > 1) p *= t1; if (fq > 2) p *= t2;
                        pre[x] = p; all[x] = (t0 * t1) * (t2 * t3);
                    }
                    unsigned kgp[4][2], bgp[4][2], abp[4][2];
                    float kgt[4][4], bgt[4][4], abt[4][4];
#pragma unroll
                    for (int j = 0; j < 4; ++j) {
                        const f32x4 Gs = pre * g[j], Gm = j ? pre * g[j - 1] : pre;
                        f32x4 ginv; ginv[0] = __builtin_amdgcn_rcpf(Gs[0]); ginv[1] = __builtin_amdgcn_rcpf(Gs[1]); ginv[2] = __builtin_amdgcn_rcpf(Gs[2]); ginv[3] = __builtin_amdgcn_rcpf(Gs[3]);
                        const f32x4 alb = kk[j] * Gm, rb = rr[j] * Gs, bet = be[j] * ginv, ktl = km[j] * ginv;
                        const int s = 4 * fq + j;
                        v2u o;
                        o.x = pk2(alb[0], alb[1]); o.y = pk2(alb[2], alb[3]); *(LAS v2u*)(tmp + RWT_AB + s * 128 + 8 * fr) = o;
                        o.x = pk2(bet[0], bet[1]); o.y = pk2(bet[2], bet[3]); *(LAS v2u*)(tmp + RWT_BT + s * 128 + 8 * fr) = o;
                        o.x = pk2(ktl[0], ktl[1]); o.y = pk2(ktl[2], ktl[3]); *(LAS v2u*)(tmp + RWT_KT + s * 128 + 8 * fr) = o;
                        o.x = pk2(rb[0], rb[1]); o.y = pk2(rb[2], rb[3]); *(LAS v2u*)(slot + RWS_RB + s * 128 + 8 * fr) = o;
#pragma unroll
                        for (int x = 0; x < 4; ++x) { kgt[x][j] = ktl[x] * all[x]; bgt[x][j] = -(bet[x] * all[x]); abt[x][j] = alb[x]; }
                    }
#pragma unroll
                    for (int x = 0; x < 4; ++x) {
                        const int kch = 4 * fr + x;
                        v2u o;
                        o.x = pk2(kgt[x][0], kgt[x][1]); o.y = pk2(kgt[x][2], kgt[x][3]); *(LAS v2u*)(slot + RWS_KGT + rwz(kch) * 32 + 8 * fq) = o;
                        o.x = pk2(bgt[x][0], bgt[x][1]); o.y = pk2(bgt[x][2], bgt[x][3]); *(LAS v2u*)(slot + RWS_BGT + rwz(kch) * 32 + 8 * fq) = o;
                        o.x = pk2(abt[x][0], abt[x][1]); o.y = pk2(abt[x][2], abt[x][3]); *(LAS v2u*)(tmp + RWT_ABT + rwz(kch) * 32 + 8 * fq) = o;
                    }
                    if (fq == 0) *(LAS f32x4*)(slot + RWS_G15 + 16 * fr) = all;
                    const unsigned vlo = (unsigned)cu.v[0] | ((unsigned)cu.v[1] << 16), vhi = (unsigned)cu.v[2] | ((unsigned)cu.v[3] << 16);
                    { v2u o; o.x = vlo; o.y = vhi; *(LAS v2u*)(slot + RWS_VCI + 8 * lane) = o; }
                    LDS_WAIT(); asm volatile("" ::: "memory");
                    f32x4 nac = (f32x4){0.f, 0.f, 0.f, 0.f}, kat = nac, krt = nac, nrt = nac;
#pragma unroll
                    for (int p = 0; p < 2; ++p) {
                        const int kb = (32 * p + 8 * fq) * 2;
                        const bf16x8 oAB = lds_op16(tmp + RWT_AB, fr, kb), oBT = lds_op16(tmp + RWT_BT, fr, kb), oKT = lds_op16(tmp + RWT_KT, fr, kb), oRB = lds_op16(slot + RWS_RB, fr, kb);
                        nac = __builtin_amdgcn_mfma_f32_16x16x32_bf16(oBT, oAB, nac, 0, 0, 0);
                        kat = __builtin_amdgcn_mfma_f32_16x16x32_bf16(oKT, oAB, kat, 0, 0, 0);
                        krt = __builtin_amdgcn_mfma_f32_16x16x32_bf16(oKT, oRB, krt, 0, 0, 0);
                        nrt = __builtin_amdgcn_mfma_f32_16x16x32_bf16(oBT, oRB, nrt, 0, 0, 0);
                    }
#pragma unroll
                    for (int i = 0; i < 4; ++i) { const int rr_ = 4 * fq + i;
                        if (rr_ >= fr) { nac[i] = 0.f; kat[i] = 0.f; }
                        if (rr_ > fr) { krt[i] = 0.f; nrt[i] = 0.f; } }
                    { u32x4_t o; o.x = pk2(krt[0], krt[1]); o.y = pk2(krt[2], krt[3]); o.z = pk2(-nrt[0], -nrt[1]); o.w = pk2(-nrt[2], -nrt[3]); *(LAS u32x4_t*)(slot + RWS_KNI + 16 * lane) = o; }
                    LDS_WAIT(); asm volatile("" ::: "memory");
                    *(LAS f32x4*)(tmp + RWT_NM + (fr * 16 + 4 * fq) * 4) = nac;
                    LDS_WAIT(); asm volatile("" ::: "memory");
                    float Tc[16];
                    f32x4 nvv[16][4];
#define RW_LD_ROWS(lo, hi) _Pragma("unroll") for (int s = lo; s <= hi; ++s) _Pragma("unroll") for (int r4 = 0; r4 < (s + 3) / 4; ++r4) nvv[s][r4] = *(const LAS f32x4*)(tmp + RWT_NM + (s * 16 + 4 * r4) * 4);
#define RW_DO_ROWS(lo, hi) _Pragma("unroll") for (int s = lo; s <= hi; ++s) { float acc_ = (s == fr) ? 1.f : 0.f; \
                        _Pragma("unroll") for (int r4 = 0; r4 < (s + 3) / 4; ++r4) _Pragma("unroll") for (int e = 0; e < 4; ++e) if (4 * r4 + e < s) acc_ -= nvv[s][r4][e] * Tc[4 * r4 + e]; \
                        Tc[s] = acc_; }
                    RW_LD_ROWS(1, 8) RW_LD_ROWS(9, 12)
                    asm volatile("" ::: "memory");
                    RW_DO_ROWS(0, 8)
                    RW_LD_ROWS(13, 15)
                    asm volatile("" ::: "memory");
                    RW_DO_ROWS(9, 12)
                    RW_DO_ROWS(13, 15)
#undef RW_LD_ROWS
#undef RW_DO_ROWS
#pragma unroll
                    for (int e = 0; e < 4; ++e) {
                        float tv = Tc[0];
#pragma unroll
                        for (int s = 0; s < 16; ++s) if (s == 4 * fq + e) tv = Tc[s];
                        *(LAS unsigned short*)(tmp + RWT_TM + ((4 * fq + e) * 16 + fr) * 2) = (unsigned short)f2bf(tv);
                    }
                    LDS_WAIT(); asm volatile("" ::: "memory");
                    const v2u tq = lds_8(tmp + RWT_TM + (fr * 16 + 4 * fq) * 2);
                    const bf16x8 opT = mk8(tq.x, tq.y, 0u, 0u);
                    f32x4 xac = __builtin_amdgcn_mfma_f32_16x16x32_bf16(mk8(pk2(kat[0], kat[1]), pk2(kat[2], kat[3]), 0u, 0u), mk8(vlo, vhi, 0u, 0u), (f32x4){0.f, 0.f, 0.f, 0.f}, 0, 0, 0);
                    const f32x4 wvv = __builtin_amdgcn_mfma_f32_16x16x32_bf16(opT, mk8(pk2(xac[0], xac[1]), pk2(xac[2], xac[3]), 0u, 0u), (f32x4){0.f, 0.f, 0.f, 0.f}, 0, 0, 0);
                    *(LAS f32x4*)(slot + RWS_WVI + 16 * lane) = wvv;
                    f32x4 aht[4];
#pragma unroll
                    for (int nt = 0; nt < 4; ++nt) {
                        const v2u ab = lds_8(tmp + RWT_ABT + rwz(16 * nt + fr) * 32 + 8 * fq);
                        aht[nt] = __builtin_amdgcn_mfma_f32_16x16x32_bf16(mk8(ab.x, ab.y, 0u, 0u), opT, (f32x4){0.f, 0.f, 0.f, 0.f}, 0, 0, 0);
                    }
#pragma unroll
                    for (int p = 0; p < 2; ++p) { u32x4_t o; o.x = pk2(aht[2 * p][0], aht[2 * p][1]); o.y = pk2(aht[2 * p][2], aht[2 * p][3]); o.z = pk2(aht[2 * p + 1][0], aht[2 * p + 1][1]); o.w = pk2(aht[2 * p + 1][2], aht[2 * p + 1][3]);
                        *(LAS u32x4_t*)(slot + RWS_AH + (p * 64 + lane) * 16) = o; }
                    LDS_WAIT(); asm volatile("" ::: "memory");
                    if (lane == 0) flg[cj % RW_NSLOT] = (unsigned)(cj + 1);
                }
            }
        } else {
            f32x4 St[4];
#pragma unroll
            for (int kt = 0; kt < 4; ++kt) St[kt] = (f32x4){0.f, 0.f, 0.f, 0.f};
            {
#pragma unroll 1
                for (int c = 0; c < NCH; ++c) {
                    const LAS unsigned char* slot = lds + (c % RW_NSLOT) * RWS_SLOT;
                    while (flg[c % RW_NSLOT] != (unsigned)(c + 1)) __builtin_amdgcn_s_sleep(1);
                    asm volatile("" ::: "memory");
                    f32x4 zt = *(const LAS f32x4*)(slot + RWS_WVI + 16 * lane);
                    f32x4 y = (f32x4){0.f, 0.f, 0.f, 0.f};
#pragma unroll
                    for (int p = 0; p < 2; ++p) {
                        const bf16x8 sb = mk8(pk2(St[2 * p][0], St[2 * p][1]), pk2(St[2 * p][2], St[2 * p][3]), pk2(St[2 * p + 1][0], St[2 * p + 1][1]), pk2(St[2 * p + 1][2], St[2 * p + 1][3]));
                        const v2u r0 = lds_8(slot + RWS_RB + fr * 128 + (32 * p + 4 * fq) * 2), r1 = lds_8(slot + RWS_RB + fr * 128 + (32 * p + 16 + 4 * fq) * 2);
                        zt = __builtin_amdgcn_mfma_f32_16x16x32_bf16(*(const LAS bf16x8*)(slot + RWS_AH + (p * 64 + lane) * 16), sb, zt, 0, 0, 0);
                        y = __builtin_amdgcn_mfma_f32_16x16x32_bf16(mk8(r0.x, r0.y, r1.x, r1.y), sb, y, 0, 0, 0);
                    }
                    const v2u vc = lds_8(slot + RWS_VCI + 8 * lane);
                    const bf16x8 b2 = mk8(vc.x, vc.y, pk2(zt[0], zt[1]), pk2(zt[2], zt[3]));
                    y = __builtin_amdgcn_mfma_f32_16x16x32_bf16(*(const LAS bf16x8*)(slot + RWS_KNI + 16 * lane), b2, y, 0, 0, 0);
#pragma unroll
                    for (int kt = 0; kt < 4; ++kt) {
                        const v2u kg = lds_8(slot + RWS_KGT + rwz(16 * kt + fr) * 32 + 8 * fq), bg = lds_8(slot + RWS_BGT + rwz(16 * kt + fr) * 32 + 8 * fq);
                        const f32x4 g15 = *(const LAS f32x4*)(slot + RWS_G15 + (16 * kt + 4 * fq) * 4);
                        St[kt] = __builtin_amdgcn_mfma_f32_16x16x32_bf16(mk8(kg.x, kg.y, bg.x, bg.y), b2, St[kt] * g15, 0, 0, 0);
                    }
                    bf16* yp = Y + (row0 + 16 * (size_t)c + 4 * fq) * 1024 + 64 * h + 16 * rg + fr;
#pragma unroll
                    for (int i = 0; i < 4; ++i) yp[(size_t)i * 1024] = (bf16)f2bf(y[i]);
                    LDS_WAIT(); asm volatile("" ::: "memory");
                    if (lane == 0) flg[RW_NSLOT] = (unsigned)(c + 1);
                }
            }
        }
        __syncthreads();
    }
}
__device__ __forceinline__ void rw_post(const bf16* Y, bf16* R, const bf16* K, const bf16* V, const bf16* A, const bf16* G, const float* k_a, const float* r_k, const float* ln_g, const float* ln_b, int gw, int ngw, int lane) {
    const int c = (gw & 3) * 256 + 4 * lane;
    const f32x4 ka = *(const f32x4*)(k_a + c), rk = *(const f32x4*)(r_k + c), lg = *(const f32x4*)(ln_g + c), lb = *(const f32x4*)(ln_b + c);
    for (int it = gw; it < M * 4; it += 2 * ngw) {
        const int it2 = (it + ngw < M * 4) ? it + ngw : it;
        const size_t off[2] = {(size_t)(it >> 2) * 1024 + c, (size_t)(it2 >> 2) * 1024 + c};
        v2u yv[2], rv[2], kv[2], vv[2], av[2], gv[2];
#pragma unroll
        for (int u = 0; u < 2; ++u) { yv[u] = *(const v2u*)(Y + off[u]); rv[u] = *(const v2u*)(R + off[u]); kv[u] = *(const v2u*)(K + off[u]); vv[u] = *(const v2u*)(V + off[u]); av[u] = *(const v2u*)(A + off[u]); gv[u] = *(const v2u*)(G + off[u]); }
#pragma unroll
        for (int u = 0; u < 2; ++u) {
            const f32x4 y = bf4(yv[u]), r = bf4(rv[u]), k = bf4(kv[u]), v = bf4(vv[u]), a = bf4(av[u]), g = bf4(gv[u]);
            const float mu = row16_sum((y[0] + y[1]) + (y[2] + y[3])) * (1.0f / 64.0f);
            const f32x4 yc = y - mu;
            const float var = row16_sum((yc[0] * yc[0] + yc[1] * yc[1]) + (yc[2] * yc[2] + yc[3] * yc[3])) * (1.0f / 64.0f);
            const float rstd = 1.0f / sqrtf(var + 64e-5f);
            const f32x4 km = k * (1.0f + (a - 1.0f) * ka);
            const f32x4 pr = r * km * rk;
            const float cs = row16_sum((pr[0] + pr[1]) + (pr[2] + pr[3]));
            const f32x4 o = (yc * rstd * lg + lb + v * cs) * g;
            v2u wv; wv.x = pk2(o[0], o[1]); wv.y = pk2(o[2], o[3]);
            if (u == 0 || it2 != it) *(v2u*)(R + off[u]) = wv;
        }
    }
}

__device__ __forceinline__ void sc_conv(const bf16* BG, const bf16* CG, const bf16* HX, const float* cw, const float* cb, bf16* O3, int gt, int ngt) {
    const int c = (gt & 127) * 8;
    float w0[8], w1[8], w2[8], bb[8];
#pragma unroll
    for (int j = 0; j < 8; ++j) { w0[j] = cw[c + j]; w1[j] = cw[1024 + c + j]; w2[j] = cw[2048 + c + j]; bb[j] = cb[c + j]; }
    for (int idx = gt; idx < M * 128; idx += 2 * ngt) {
        const int idx2 = idx + ngt < M * 128 ? idx + ngt : idx;
        v4u cv[2][3], hv[2][3], bv[2]; int tt[2]; size_t offs[2];
#pragma unroll
        for (int u = 0; u < 2; ++u) {
            const int m = (u ? idx2 : idx) >> 7; tt[u] = m & (SEQ - 1); offs[u] = (size_t)m * 1024 + c;
#pragma unroll
            for (int dt = 0; dt < 3; ++dt) { const size_t o2 = offs[u] - (size_t)((tt[u] - 2 + dt >= 0) ? (2 - dt) : 0) * 1024; cv[u][dt] = *(const v4u*)(CG + o2); hv[u][dt] = *(const v4u*)(HX + o2); }
            bv[u] = *(const v4u*)(BG + offs[u]);
        }
#pragma unroll
        for (int u = 0; u < 2; ++u) {
            float y[8];
#pragma unroll
            for (int j = 0; j < 8; ++j) y[j] = bb[j];
#pragma unroll
            for (int dt = 0; dt < 3; ++dt) {
                const float on = (tt[u] - 2 + dt >= 0) ? 1.f : 0.f;
                const float* wp = dt == 0 ? w0 : (dt == 1 ? w1 : w2);
                const v4u cq = cv[u][dt], hq = hv[u][dt];
                y[0] += on * wp[0] * (bflo(cq.x) * bflo(hq.x)); y[1] += on * wp[1] * (bfhi(cq.x) * bfhi(hq.x));
                y[2] += on * wp[2] * (bflo(cq.y) * bflo(hq.y)); y[3] += on * wp[3] * (bfhi(cq.y) * bfhi(hq.y));
                y[4] += on * wp[4] * (bflo(cq.z) * bflo(hq.z)); y[5] += on * wp[5] * (bfhi(cq.z) * bfhi(hq.z));
                y[6] += on * wp[6] * (bflo(cq.w) * bflo(hq.w)); y[7] += on * wp[7] * (bfhi(cq.w) * bfhi(hq.w));
            }
            const v4u bq = bv[u];
            v4u w; w.x = pk2(y[0] * bflo(bq.x), y[1] * bfhi(bq.x)); w.y = pk2(y[2] * bflo(bq.y), y[3] * bfhi(bq.y)); w.z = pk2(y[4] * bflo(bq.z), y[5] * bfhi(bq.z)); w.w = pk2(y[6] * bflo(bq.w), y[7] * bfhi(bq.w));
            if (u == 0 || idx2 != idx) *(v4u*)(O3 + offs[u]) = w;
        }
    }
}

#define XB_TMO      128
#define XB_XCNT(j)  (256  + 64 * (j))
#define XB_XSUB(j)  (1280 + 64 * (j))
#define XB_XGEN(j)  (2304 + 64 * (j))
#define XB_TOP      3328
#define XB_TOPGEN   3392
#define XCD_BAR_WORDS 3456
#define XB_SPIN_CAP (1u << 18)

__device__ __forceinline__ unsigned xb_ld(unsigned* p)              { return __hip_atomic_load(p, __ATOMIC_RELAXED, __HIP_MEMORY_SCOPE_AGENT); }
__device__ __forceinline__ unsigned xb_add(unsigned* p, unsigned v) { return __hip_atomic_fetch_add(p, v, __ATOMIC_RELAXED, __HIP_MEMORY_SCOPE_AGENT); }
__device__ __forceinline__ unsigned xb_xcc_id() { return (unsigned)__builtin_amdgcn_s_getreg((3 << 11) | 20) & 0xFu; }
#define XB_SPIN(cond, bar) do { unsigned _sp = 0; while (cond) { __builtin_amdgcn_s_sleep(1); \
    if ((++_sp & 255u) == 0u) { if (xb_ld(&(bar)[XB_TMO])) break; if (_sp > XB_SPIN_CAP) { atomicAdd(&(bar)[XB_TMO], 1u); break; } } } } while (0)

struct XcdBarrier {
    unsigned* bar; unsigned x;
    volatile LAS unsigned* st;
};

__device__ __forceinline__ XcdBarrier xcd_barrier_post(unsigned* bar, volatile LAS unsigned* st) {
    XcdBarrier b; b.bar = bar; b.x = xb_xcc_id(); b.st = st;
    if (threadIdx.x == 0) (void)xb_add(&bar[XB_XCNT(b.x)], 1u);
    return b;
}
__device__ __forceinline__ void xcd_barrier_complete(unsigned* bar, unsigned x, unsigned& nloc, unsigned& nx) {
    const unsigned G = gridDim.x * gridDim.y * gridDim.z;
    unsigned sum, cnt, mine, sp = 0u;
    for (;;) {
        sum = 0u; cnt = 0u; mine = 0u;
#pragma unroll
        for (unsigned j = 0; j < 16; ++j) { const unsigned c = xb_ld(&bar[XB_XCNT(j)]); sum += c; cnt += (c > 0u) ? 1u : 0u; mine = (j == x) ? c : mine; }
        if (sum == G) break;
        __builtin_amdgcn_s_sleep(1);
        if ((++sp & 255u) == 0u) { if (xb_ld(&bar[XB_TMO])) break; if (sp > XB_SPIN_CAP) { atomicAdd(&bar[XB_TMO], 1u); break; } }
    }
    nloc = mine > 0u ? mine : 1u; nx = cnt > 0u ? cnt : 1u;
}

__device__ __forceinline__ void xcd_barrier(const XcdBarrier& b) {
    asm volatile("s_waitcnt vmcnt(0)" ::: "memory");
    __syncthreads();
    if (threadIdx.x == 0) {
        unsigned* bar = b.bar;
        __builtin_amdgcn_s_waitcnt(0);
        unsigned nloc = b.st[0], nx = b.st[1];
        if (nloc == 0u) { xcd_barrier_complete(bar, b.x, nloc, nx); b.st[0] = nloc; b.st[1] = nx; }
        const unsigned old = xb_add(&bar[XB_XSUB(b.x)], 1u);
        const unsigned gen = old / nloc;
        if (old + 1u == (gen + 1u) * nloc) {
            __builtin_amdgcn_fence(__ATOMIC_RELEASE, "agent");
            asm volatile("s_waitcnt vmcnt(0)" ::: "memory");
            const unsigned og = xb_add(&bar[XB_TOP], 1u);
            const unsigned tg = og / nx;
            if (og + 1u == (tg + 1u) * nx) xb_add(&bar[XB_TOPGEN], 1u);
            else XB_SPIN(xb_ld(&bar[XB_TOPGEN]) == tg, bar);
            __builtin_amdgcn_fence(__ATOMIC_ACQUIRE, "agent");
            xb_add(&bar[XB_XGEN(b.x)], 1u);
            asm volatile("s_waitcnt vmcnt(0)" ::: "memory");
        } else {
            XB_SPIN(xb_ld(&bar[XB_XGEN(b.x)]) == gen, bar);
            __builtin_amdgcn_fence(__ATOMIC_ACQUIRE, "agent");
            asm volatile("s_waitcnt vmcnt(0)" ::: "memory");
        }
    }
    __syncthreads();
}

struct Args { const float* in[32]; float* out; unsigned char* ws; };
#define PHASE_VARS \
    unsigned char* ws = a.ws; float* out = a.out; asm volatile("" : "+s"(ws), "+s"(out)); \
    int tid = threadIdx.x; asm volatile("" : "+v"(tid)); \
    const int lane = tid & 63, wave = __builtin_amdgcn_readfirstlane(tid >> 6); \
    const int G = gridDim.x, gw = blockIdx.x * NWAVES + wave, ngw = G * NWAVES, gt = blockIdx.x * NTHR + tid, ngt = G * NTHR; \
    float* RS = (float*)(ws + WS_BIG + 402 * MiB)  ; float* RSM = (float*)(ws + WS_RS)  ; float* LBK = (float*)(ws + WS_LBK); (void)RSM; \
    bf16* WA = (bf16*)(ws + WS_WA); bf16* WB = (bf16*)(ws + WS_WB); bf16* WO = (bf16*)(ws + WS_WO); bf16* WUP = (bf16*)(ws + WS_WUP); bf16* WDN = (bf16*)(ws + WS_WDN); \
    bf16* HB = (bf16*)(ws + WS_HB); \
    bf16* B0 = (bf16*)(ws + WS_BIG); bf16* B1 = (bf16*)(ws + WS_BIG + SLOT); bf16* B2 = (bf16*)(ws + WS_BIG + 2 * SLOT); bf16* B3 = (bf16*)(ws + WS_BIG + 3 * SLOT); \
    bf16* B4 = (bf16*)(ws + WS_BIG + 4 * SLOT); bf16* B5 = (bf16*)(ws + WS_BIG + 5 * SLOT); bf16* B5b = (bf16*)(ws + WS_BIG + 5 * SLOT + 16 * MiB); \
    LAS float* scr = (LAS float*)(lds + wave * 16384); \
    (void)lane; (void)gw; (void)ngw; (void)gt; (void)ngt; (void)RS; (void)LBK; (void)WA; (void)WB; (void)WO; (void)WUP; (void)WDN; (void)HB; (void)B0; (void)B1; (void)B2; (void)B3; (void)B4; (void)B5; (void)B5b; (void)scr; (void)out; (void)G;
constexpr size_t SLOT_E = SLOT / 2;

__global__ void __launch_bounds__(NTHR, 2) fwd_megakernel(Args a) {
    extern __shared__ __attribute__((aligned(16))) unsigned char lds_raw[];
    cg::grid_group grid = cg::this_grid();
    LAS unsigned char* lds = (LAS unsigned char*)lds_raw;
    volatile LAS unsigned* xb_st = (volatile LAS unsigned*)(lds + LDS_BYTES - 64);
    if (threadIdx.x < 2) xb_st[threadIdx.x] = 0u;
    __syncthreads();
    const XcdBarrier xbar = xcd_barrier_post((unsigned*)(a.ws + WS_BAR), xb_st);

#pragma nounroll
    for (int layer = 0; layer < 4; ++layer) {
        for (int rp_ = 0; rp_ < REP_PRO; ++rp_) { PHASE_VARS
        const float* gmix = a.in[1] + layer * 1024; const float* gffn = a.in[2] + layer * 1024;
        conv_mat(a.in[3] + (size_t)layer * D * FF, D, FF, WUP, D, 0, 0, gffn, scr, gw, ngw, lane);
        conv_mat(a.in[4] + (size_t)layer * D * FF, FF, D, WDN, FF, 0, 0, nullptr, scr, gw, ngw, lane);
        if (layer == 0) {
            conv_mat(a.in[6], D, 3 * D, WA, D, 0, 0, gmix, scr, gw, ngw, lane);
            conv_mat(a.in[7], D, D, WO, D, 0, 0, nullptr, scr, gw, ngw, lane);
            for (int m0 = gw; m0 < M; m0 += 4 * ngw) {
                f32x4 v[4][4];
#pragma unroll
                for (int u = 0; u < 4; ++u) { const int ml = m0 + u * ngw < M ? m0 + u * ngw : m0; const f32x4* xr = (const f32x4*)(a.in[0] + (size_t)ml * 1024) + lane;
#pragma unroll
                    for (int j = 0; j < 4; ++j) v[u][j] = xr[64 * j]; }
#pragma unroll
                for (int u = 0; u < 4; ++u) { const int m = m0 + u * ngw; if (m >= M) break; float ss = 0.f;
#pragma unroll
                    for (int j = 0; j < 4; ++j) { ss += (v[u][j][0] * v[u][j][0] + v[u][j][1] * v[u][j][1]) + (v[u][j][2] * v[u][j][2] + v[u][j][3] * v[u][j][3]);
                        v2u w; w.x = pk2(v[u][j][0], v[u][j][1]); w.y = pk2(v[u][j][2], v[u][j][3]); *(v2u*)(HB + (size_t)m * 1024 + 4 * lane + 256 * j) = w; }
                    ss = wave_sum(ss);
                    if (lane < 16) RS[(size_t)m * 16 + lane] = lane == 0 ? ss : 0.f; }
            }
        } else if (layer == 1) {
            conv_mat(a.in[8], D, 4 * D, WA, D, 0, 0, gmix, scr, gw, ngw, lane);
            conv_mat(a.in[11], D, D, WO, D, 0, 0, nullptr, scr, gw, ngw, lane);
            for (int c = gt; c < 1024; c += ngt) {
                const float* tb = a.in[9]; const float t0 = tb[c], t1 = tb[1024 + c], t2 = tb[2048 + c], t3 = tb[3072 + c];
                const float mx = fmaxf(fmaxf(t0, t1), fmaxf(t2, t3));
                const float e0 = expf(t0 - mx), e1 = expf(t1 - mx), e2 = expf(t2 - mx), e3 = expf(t3 - mx);
                LBK[c] = 1.0f - e1 / (e0 + e1 + e2 + e3);
            }
        } else if (layer == 2) {
            const float* mix = a.in[12];
#pragma nounroll
            for (int j = 0; j < 3; ++j) {
                conv_mat(a.in[13] + (size_t)j * D * D, D, D, WA, 2048, 1024 * j, 0, nullptr, scr, gw, ngw, lane);
                conv_mat(a.in[13] + (size_t)j * D * D, D, D, WA, 2048, 1024 * j, 1024, mix + 1024 * j, scr, gw, ngw, lane);
            }
            conv_mat(a.in[15], D, 64, WA, 2048, 3072, 0, nullptr, scr, gw, ngw, lane); conv_mat(a.in[15], D, 64, WA, 2048, 3072, 1024, mix + 3 * 1024, scr, gw, ngw, lane);
            conv_mat(a.in[18], D, 64, WA, 2048, 3136, 0, nullptr, scr, gw, ngw, lane); conv_mat(a.in[18], D, 64, WA, 2048, 3136, 1024, mix + 4 * 1024, scr, gw, ngw, lane);
            conv_mat(a.in[20], D, 128, WA, 2048, 3200, 0, nullptr, scr, gw, ngw, lane); conv_mat(a.in[20], D, 128, WA, 2048, 3200, 1024, mix + 5 * 1024, scr, gw, ngw, lane);
            conv_mat(a.in[27], D, D, WO, D, 0, 0, nullptr, scr, gw, ngw, lane);
            for (int idx = gt; idx < 256 * 3072; idx += ngt) {
                const int k = idx / 3072, n = idx - k * 3072, grp = n >> 10, nn = n & 1023; float v = 0.f;
                if (grp == 0) { if (k < 64) v = a.in[16][k * 1024 + nn]; }
                else if (grp == 1) { if (k >= 64 && k < 128) v = a.in[19][(k - 64) * 1024 + nn]; }
                else { if (k >= 128) v = a.in[21][(k - 128) * 1024 + nn]; }
                WB[(size_t)n * 256 + k] = (bf16)f2bf(v);
            }
            rw_prep(HB, RS, gmix, B0, gw, ngw, lane);
        } else {
            conv_mat(a.in[28], D, 3 * D, WA, D, 0, 0, gmix, scr, gw, ngw, lane);
            conv_mat(a.in[31], D, D, WO, D, 0, 0, nullptr, scr, gw, ngw, lane);
        }
        }
        if (layer == 0) grid.sync();
        else GRID_SYNC();

        if (layer == 0 || layer == 3) {
            { PHASE_VARS
            pg8::Gemm g{HB, WA, M, 3 * D, D}; pg8::StaticOrder S; S.init(M, 3 * D, G, (int)blockIdx.x);
            pg8::EpiAct<0> E{B0, 1024, 1024, SLOT_E, RS, layer == 0 ? 0.125f * LOG2E_F : 1.0f, nullptr};
            for (int r_ = 0; r_ < REP_IN; ++r_) pg8::gemm_phase<pg8::EpiAct<0>, pg8::StaticOrder, true, true>(lds, g, S, E); }
            GRID_SYNC();
            { PHASE_VARS
            if (layer == 0) { for (int r_ = 0; r_ < REP_ATT; ++r_) attn_phase(B0, B1, B2, B3, gw, ngw, lane); }
            else { for (int r_ = 0; r_ < REP_SC; ++r_) sc_conv(B0, B1, B2, a.in[29], a.in[30], B3, gt, ngt); } }
        } else if (layer == 1) {
            { PHASE_VARS
            pg8::Gemm g{HB, WA, M, 4 * D, D}; pg8::StaticOrder S; S.init(M, 4 * D, G, (int)blockIdx.x);
            pg8::EpiAct<2> E{B0, 1024, 1024, SLOT_E, RS, 1.0f, LBK};
            for (int r_ = 0; r_ < REP_IN; ++r_) pg8::gemm_phase<pg8::EpiAct<2>, pg8::StaticOrder, true, true>(lds, g, S, E); }
            GRID_SYNC();
            { PHASE_VARS
            hg_local(B0, B1, B4, B2, (float*)B5, (float*)(ws + WS_BIG + 5 * SLOT + 8 * MiB), (float*)(ws + WS_BIG + 5 * SLOT + 24 * MiB)); }
            GRID_SYNC();
            { PHASE_VARS
            hg_out(B0, B1, B4, B2, (const float*)B5, (const float*)(ws + WS_BIG + 5 * SLOT + 8 * MiB), (const float*)(ws + WS_BIG + 5 * SLOT + 24 * MiB), a.in[10], B3, lds); }
        } else {
            { PHASE_VARS
              pg8::Gemm g{B0, WA, M, 3328, 2048}; pg8::StaticOrder S; S.init(M, 3328, G, (int)blockIdx.x);
              pg8::EpiRw1 E{B2, SLOT_E, B5};
              for (int r_ = 0; r_ < REP_G1; ++r_) pg8::gemm_phase<pg8::EpiRw1, pg8::StaticOrder, true, true>(lds, g, S, E); }
            GRID_SYNC();
            { PHASE_VARS
              int k256 = 256; asm volatile("" : "+s"(k256));
              pg8::Gemm g{B5, WB, M, 3 * D, k256}; pg8::StaticOrder S; S.init(M, 3 * D, G, (int)blockIdx.x);
              pg8::EpiRw2 E{B0, SLOT_E, 5 * SLOT_E + 8 * MiB, a.in[14], a.in[17]};
              for (int r_ = 0; r_ < REP_G2; ++r_) pg8::gemm_phase<pg8::EpiRw2, pg8::StaticOrder, true, true>(lds, g, S, E); }
            GRID_SYNC();
            { PHASE_VARS
            for (int r_ = 0; r_ < REP_RW; ++r_) rw_scan(B2, B3, B4, B0, B1, a.in[22], a.in[23], (bf16*)out, lds); }
            GRID_SYNC();
            { PHASE_VARS
            rw_post((const bf16*)out, B2, B3, B4, B1, B5b, a.in[23], a.in[24], a.in[25], a.in[26], gw, ngw, lane); }
        }
        GRID_SYNC();
        { PHASE_VARS
          const bf16* mix_out = (layer == 2) ? B2 : B3;
          pg8::Gemm g{mix_out, WO, M, D, D}; pg8::StaticOrder S; S.init(M, D, G, (int)blockIdx.x);
          pg8::EpiResidB E{HB, RSM, nullptr};
          pg8::gemm_phase<pg8::EpiResidB, pg8::StaticOrder, true, true>(lds, g, S, E); }
        GRID_SYNC();
        { PHASE_VARS
          pg8::Gemm g{HB, WUP, M, FF, D}; pg8::StaticOrder S; S.init(M, FF, G, (int)blockIdx.x);
          pg8::EpiAct<1> E{B0, FF, 0, 0, nullptr, 1.0f, nullptr};
#pragma nounroll
          for (int r_ = 0; r_ < REP_UP; ++r_) pg8::gemm_phase<pg8::EpiAct<1>, pg8::StaticOrder, true, true>(lds, g, S, E); }
        GRID_SYNC();
        { PHASE_VARS
          pg8::Gemm g{B0, WDN, M, D, FF}; pg8::StaticOrder S; S.init(M, D, G, (int)blockIdx.x);
          pg8::EpiResidB E{HB, RS, RSM};
          pg8::gemm_phase<pg8::EpiResidB, pg8::StaticOrder, true, true>(lds, g, S, E); }
        GRID_SYNC();
    }
    { PHASE_VARS
    const f32x4* gr = (const f32x4*)(a.in[5]) + lane;
    const f32x4 g0 = gr[0], g1 = gr[64], g2 = gr[128], g3 = gr[192];
    for (int m0 = gw; m0 < M; m0 += 4 * ngw) {
        f32x4 v[4][4]; f32x4 pr[4];
#pragma unroll
        for (int u = 0; u < 4; ++u) { const int m = m0 + u * ngw < M ? m0 + u * ngw : m0;
            pr[u] = *(const f32x4*)(RS + (size_t)m * 16 + 4 * (lane & 3));
#pragma unroll
            for (int j = 0; j < 4; ++j) v[u][j] = bf4(*(const v2u*)(HB + (size_t)m * 1024 + 4 * lane + 256 * j)); }
#pragma unroll
        for (int u = 0; u < 4; ++u) { const int m = m0 + u * ngw; if (m >= M) break; f32x4* xr = (f32x4*)(out + (size_t)m * 1024) + lane;
            float s = (pr[u][0] + pr[u][1]) + (pr[u][2] + pr[u][3]); s += dpp_f<0xB1>(s); s += dpp_f<0x4E>(s);
            const float r = 1.0f / sqrtf(s * (1.0f / 1024.0f) + 1e-6f);
            xr[0] = v[u][0] * r * g0; xr[64] = v[u][1] * r * g1; xr[128] = v[u][2] * r * g2; xr[192] = v[u][3] * r * g3; }
    } }
}

extern "C" void kernel_launch(void* const* d_in, const int* in_sizes, int n_in, void* d_out, int out_size, void* d_ws, size_t ws_size, hipStream_t stream) {
    static int grid = 0;
    if (grid == 0) {
        if (n_in != 32 || out_size != M * D || ws_size < WS_END) { fprintf(stderr, "kernel_launch: unexpected shapes (n_in %d out %d ws %zu)\n", n_in, out_size, ws_size); grid = -1; return; }
        int dev = 0, cus = 0, per_cu = 0;
        hipGetDevice(&dev); hipDeviceGetAttribute(&cus, hipDeviceAttributeMultiprocessorCount, dev);
        hipFuncSetAttribute((const void*)fwd_megakernel, hipFuncAttributeMaxDynamicSharedMemorySize, LDS_BYTES);
        hipOccupancyMaxActiveBlocksPerMultiprocessor(&per_cu, (const void*)fwd_megakernel, NTHR, LDS_BYTES);
        if (per_cu < 1) { fprintf(stderr, "kernel_launch: occupancy query says %d blocks per CU\n", per_cu); per_cu = 1; }
        (void)hipGetLastError();
        grid = cus * per_cu;
    }
    if (grid < 0) return;
    if (hipMemsetAsync((char*)d_ws + WS_BAR, 0, WS_BAR_BYTES, stream) != hipSuccess) { fprintf(stderr, "kernel_launch: memset of the barrier words failed\n"); return; }
    Args a{};
    for (int i = 0; i < 32; ++i) a.in[i] = (const float*)d_in[i];
    a.out = (float*)d_out; a.ws = (unsigned char*)d_ws;
    void* args[] = {&a};
    hipError_t e = hipLaunchCooperativeKernel((const void*)fwd_megakernel, dim3(grid), dim3(NTHR), args, LDS_BYTES, stream);
    if (e != hipSuccess) fprintf(stderr, "cooperative launch failed: %s (grid %d)\n", hipGetErrorString(e), grid);
}
```

```cpp
#include <hip/hip_runtime.h>
#include <hip/hip_cooperative_groups.h>
#include <cstdio>
#include <cstdint>
namespace cg = cooperative_groups;
namespace pg8 {
#define PG8_LAS __attribute__((address_space(3)))
typedef unsigned short bf16_t;
typedef short bf16x8 __attribute__((ext_vector_type(8)));
typedef float f32x4 __attribute__((ext_vector_type(4)));
typedef unsigned u32x4 __attribute__((ext_vector_type(4)));
constexpr int BM = 256, BK = 64, HALF = 128, HTB = HALF * BK * 2  , STAGE_BYTES = 8 * HTB, NXCD = 8, WGM = 8;

__host__ __device__ __forceinline__ int lds_byte(int r, int c) { const int st = (r >> 4) * 2 + (c >> 5), rr = r & 15, cc = c & 31, ob = rr * 64 + cc * 2; return st * 1024 + (ob ^ (((ob >> 9) & 1) << 5)); }
__host__ __device__ __forceinline__ void stage_rc(int b, int& R, int& C) { const int st = b / 1024, sb = b % 1024, swz = sb ^ (((sb >> 9) & 1) << 5); R = (st >> 1) * 16 + swz / 64; C = (st & 1) * 32 + (swz % 64) / 2; }
__host__ __device__ __forceinline__ int perm32(int rho) { const int n = rho >> 4, i = rho & 15; return 8 * (i >> 2) + 4 * n + (i & 3); }

struct Unit { int pm, pn; };
struct Gemm { const bf16_t* A; const bf16_t* Bt; int M, N, K; };

struct StaticOrder {
    int nM, nN, nwg, G, c;
    __host__ __device__ void init(int M, int N, int G_, int c_) { nM = M / BM; nN = N / BM; nwg = nM * nN; G = G_; c = c_; }
    __host__ __device__ bool next(int i, Unit& u) const {
        const long L = (long)i * G + c; if (L >= nwg) return false;
        int wgid = (int)L; { const int q = nwg / NXCD, r = nwg % NXCD, xcd = wgid % NXCD, off = wgid / NXCD; wgid = (xcd < r ? xcd * (q + 1) : r * (q + 1) + (xcd - r) * q) + off; }
        const int wgm = nN >= 8 ? 4 : WGM; const int nig = wgm * nN, gid = wgid / nig, fm = gid * wgm, gsz = (nM - fm) < wgm ? (nM - fm) : wgm;
        u.pm = fm + ((wgid % nig) % gsz); u.pn = (wgid % nig) / gsz; return true;
    }
    __device__ __forceinline__ void a_ready(const Unit&) const {}
    __device__ __forceinline__ void done(const Unit&) const {}
};

__device__ __forceinline__ unsigned cvt_pk_bf16(float lo, float hi) { unsigned r; asm volatile("v_cvt_pk_bf16_f32 %0, %1, %2" : "=v"(r) : "v"(lo), "v"(hi)); return r; }
typedef unsigned u32x4 __attribute__((ext_vector_type(4)));
typedef unsigned u32x2 __attribute__((ext_vector_type(2)));
constexpr float LOG2E = 1.4426950408889634f;
__device__ __forceinline__ float fast_sigmoid(float x) { return __builtin_amdgcn_rcpf(1.0f + __builtin_amdgcn_exp2f(-x * LOG2E)); }
__device__ __forceinline__ float row_rs(const float* rs, int row) {
    const f32x4* p = (const f32x4*)(rs + (size_t)row * 16);
    const f32x4 a = p[0], b = p[1], c = p[2], d = p[3];
    const float s = ((a[0] + a[1]) + (a[2] + a[3])) + ((b[0] + b[1]) + (b[2] + b[3])) + ((c[0] + c[1]) + (c[2] + c[3])) + ((d[0] + d[1]) + (d[2] + d[3]));
    return 1.0f / sqrtf(s * (1.0f / 1024.0f) + 1e-6f);
}
template <int MODE> struct EpiAct {
    static constexpr bool PERM = true, AFTER_DRAIN = false;
    bf16_t* O; int ldc; int split_cols; size_t split_stride; const float* rs; float scale0; const float* aux;
    __device__ __forceinline__ void operator()(const f32x4 (&acc)[2][2][4][2], const Unit& u, int wr, int wc, int fr, int fq) const {
        const int row0 = u.pm * BM + wr * 64 + fr; int colt = u.pn * BM; bf16_t* base = O; int t = 0;
        if (split_cols) { t = colt / split_cols; base += (size_t)t * split_stride; colt -= t * split_cols; }
        const float sc = (MODE == 0 && t == 0) ? scale0 : 1.f;
        const int col0 = colt + wc * 32 + 8 * fq;
        f32x4 lbk[2][2];
#pragma unroll
        for (int bj = 0; bj < 2; ++bj)
#pragma unroll
            for (int n = 0; n < 2; ++n) lbk[bj][n] = (MODE == 2 && t == 1) ? *(const f32x4*)(aux + col0 + bj * HALF + 4 * n) : (f32x4){0.f, 0.f, 0.f, 0.f};
        float rsv[2][4];
        if (rs) {
            f32x4 part[2][4];
#pragma unroll
            for (int ai = 0; ai < 2; ++ai)
#pragma unroll
                for (int m = 0; m < 4; ++m) part[ai][m] = *(const f32x4*)(rs + (size_t)(row0 + ai * HALF + m * 16) * 16 + 4 * fq);
#pragma unroll
            for (int ai = 0; ai < 2; ++ai)
#pragma unroll
                for (int m = 0; m < 4; ++m) { float s = (part[ai][m][0] + part[ai][m][1]) + (part[ai][m][2] + part[ai][m][3]); s += __shfl_xor(s, 16); s += __shfl_xor(s, 32);
                    rsv[ai][m] = sc / sqrtf(s * (1.0f / 1024.0f) + 1e-6f); }
        } else {
#pragma unroll
            for (int ai = 0; ai < 2; ++ai)
#pragma unroll
                for (int m = 0; m < 4; ++m) rsv[ai][m] = sc;
        }
#pragma unroll
        for (int ai = 0; ai < 2; ++ai)
#pragma unroll
            for (int m = 0; m < 4; ++m) {
                const int row = row0 + ai * HALF + m * 16;
                const float r = rsv[ai][m];
                bf16_t* rowp = base + (size_t)row * ldc + col0;
#pragma unroll
                for (int bj = 0; bj < 2; ++bj) {
                    f32x4 v[2] = {acc[ai][bj][m][0] * r, acc[ai][bj][m][1] * r};
#pragma unroll
                    for (int n = 0; n < 2; ++n)
#pragma unroll
                        for (int j = 0; j < 4; ++j) {
                            float x = v[n][j];
                            if (MODE == 1) { x = fmaxf(x, 0.f); x = x * x; }
                            if (MODE == 2) {
                                if (t == 0 || t == 3) x = x * fast_sigmoid(x);
                                else if (t == 1) x = lbk[bj][n][j] * __builtin_amdgcn_rcpf(1.0f + __builtin_amdgcn_exp2f(x * LOG2E));
                            }
                            v[n][j] = x;
                        }
                    u32x4 w; w.x = cvt_pk_bf16(v[0][0], v[0][1]); w.y = cvt_pk_bf16(v[0][2], v[0][3]); w.z = cvt_pk_bf16(v[1][0], v[1][1]); w.w = cvt_pk_bf16(v[1][2], v[1][3]);
                    *(u32x4*)(rowp + bj * HALF) = w;
                }
            }
    }
};
struct EpiRw1 {
    static constexpr bool PERM = true, AFTER_DRAIN = false;
    bf16_t* RKV; size_t split_stride; bf16_t* L;
    __device__ __forceinline__ void operator()(const f32x4 (&acc)[2][2][4][2], const Unit& u, int wr, int wc, int fr, int fq) const {
        const int row0 = u.pm * BM + wr * 64 + fr;
        const bool lora = (u.pn >= 12);
        bf16_t* base = lora ? L : RKV + (size_t)(u.pn >> 2) * split_stride;
        const int ldc = lora ? 256 : 1024;
        const int col0 = (lora ? 0 : (u.pn & 3) * BM) + wc * 32 + 8 * fq;
#pragma unroll
        for (int ai = 0; ai < 2; ++ai)
#pragma unroll
            for (int m = 0; m < 4; ++m) {
                bf16_t* rowp = base + (size_t)(row0 + ai * HALF + m * 16) * ldc + col0;
#pragma unroll
                for (int bj = 0; bj < 2; ++bj) {
                    f32x4 v[2] = {acc[ai][bj][m][0], acc[ai][bj][m][1]};
                    if (lora) {
#pragma unroll
                        for (int n = 0; n < 2; ++n)
#pragma unroll
                            for (int j = 0; j < 4; ++j) {
                                float x = v[n][j];
                                if (bj == 1) x = fast_sigmoid(x);
                                else if (wc < 2) x = 1.0f - 2.0f * __builtin_amdgcn_rcpf(1.0f + __builtin_amdgcn_exp2f(fminf(x, 40.f) * (2.0f * LOG2E)));
                                v[n][j] = x;
                            }
                    }
                    u32x4 w; w.x = cvt_pk_bf16(v[0][0], v[0][1]); w.y = cvt_pk_bf16(v[0][2], v[0][3]); w.z = cvt_pk_bf16(v[1][0], v[1][1]); w.w = cvt_pk_bf16(v[1][2], v[1][3]);
                    *(u32x4*)(rowp + bj * HALF) = w;
                }
            }
    }
};
struct EpiRw2 {
    static constexpr bool PERM = true, AFTER_DRAIN = false;
    bf16_t* WM; size_t offA, offG; const float* w0; const float* a0;
    __device__ __forceinline__ void operator()(const f32x4 (&acc)[2][2][4][2], const Unit& u, int wr, int wc, int fr, int fq) const {
        const int row0 = u.pm * BM + wr * 64 + fr; const int t = u.pn >> 2;
        bf16_t* base = WM + (t == 1 ? offA : (size_t)0) + (t == 2 ? offG : (size_t)0);
        const float* bias = t == 0 ? w0 : a0;
        const int col0 = (u.pn & 3) * BM + wc * 32 + 8 * fq;
        f32x4 bv[2][2];
#pragma unroll
        for (int bj = 0; bj < 2; ++bj)
#pragma unroll
            for (int n = 0; n < 2; ++n) bv[bj][n] = (t < 2) ? *(const f32x4*)(bias + col0 + bj * HALF + 4 * n) : (f32x4){0.f, 0.f, 0.f, 0.f};
#pragma unroll
        for (int ai = 0; ai < 2; ++ai)
#pragma unroll
            for (int m = 0; m < 4; ++m) {
                bf16_t* rowp = base + (size_t)(row0 + ai * HALF + m * 16) * 1024 + col0;
#pragma unroll
                for (int bj = 0; bj < 2; ++bj) {
                    f32x4 v[2] = {acc[ai][bj][m][0], acc[ai][bj][m][1]};
                    if (t < 2) {
                        v[0] += bv[bj][0]; v[1] += bv[bj][1];
#pragma unroll
                        for (int n = 0; n < 2; ++n)
#pragma unroll
                            for (int j = 0; j < 4; ++j) {
                                float x = fast_sigmoid(v[n][j]);
                                if (t == 0) x = 1.0f - __builtin_amdgcn_exp2f(x * (-0.6065306597126334f * LOG2E));
                                v[n][j] = x;
                            }
                    }
                    u32x4 w; w.x = cvt_pk_bf16(v[0][0], v[0][1]); w.y = cvt_pk_bf16(v[0][2], v[0][3]); w.z = cvt_pk_bf16(v[1][0], v[1][1]); w.w = cvt_pk_bf16(v[1][2], v[1][3]);
                    *(u32x4*)(rowp + bj * HALF) = w;
                    asm volatile("" ::: "memory");
                }
            }
    }
};
struct EpiResid {
    static constexpr bool PERM = false, AFTER_DRAIN = false;
    const float* base; float* out; bf16_t* hb; float* rsq;
    __device__ __forceinline__ void operator()(const f32x4 (&acc)[2][2][4][2], const Unit& u, int wr, int wc, int fr, int fq) const {
        const int col0 = u.pn * BM + wc * 32 + 4 * fq;
#pragma unroll
        for (int ai = 0; ai < 2; ++ai) {
            f32x4 pre[4][2][2];
#pragma unroll
            for (int m = 0; m < 4; ++m) { const size_t off = (size_t)(u.pm * BM + ai * HALF + wr * 64 + m * 16 + fr) * 1024 + col0;
#pragma unroll
                for (int bj = 0; bj < 2; ++bj)
#pragma unroll
                    for (int n = 0; n < 2; ++n) pre[m][bj][n] = *(const f32x4*)(base + off + bj * HALF + n * 16); }
#pragma unroll
            for (int m = 0; m < 4; ++m) {
                const int row = u.pm * BM + ai * HALF + wr * 64 + m * 16 + fr; const size_t off = (size_t)row * 1024 + col0;
                float ss = 0.f;
#pragma unroll
                for (int bj = 0; bj < 2; ++bj)
#pragma unroll
                    for (int n = 0; n < 2; ++n) {
                        const f32x4 o = pre[m][bj][n] + acc[ai][bj][m][n];
                        *(f32x4*)(out + off + bj * HALF + n * 16) = o;
                        u32x2 w; w.x = cvt_pk_bf16(o[0], o[1]); w.y = cvt_pk_bf16(o[2], o[3]);
                        if (hb) *(u32x2*)(hb + off + bj * HALF + n * 16) = w;
                        ss += (o[0] * o[0] + o[1] * o[1]) + (o[2] * o[2] + o[3] * o[3]);
                    }
                ss += __shfl_xor(ss, 16); ss += __shfl_xor(ss, 32);
                if (fq == 0) rsq[(size_t)row * 16 + u.pn * 4 + wc] = ss;
            }
        }
    }
};

struct EpiResidB {
    static constexpr bool PERM = false, AFTER_DRAIN = false;
    bf16_t* hb; float* rsq; const float* rs_in;
    __device__ __forceinline__ void operator()(const f32x4 (&acc)[2][2][4][2], const Unit& u, int wr, int wc, int fr, int fq) const {
        const int col0 = u.pn * BM + wc * 32 + 4 * fq;
#pragma unroll
        for (int ai = 0; ai < 2; ++ai) {
            u32x2 pre[2][4][2][2]; f32x4 prs[4]; float sc2[4];
#pragma unroll
            for (int m = 0; m < 4; ++m) prs[m] = rs_in ? *(const f32x4*)(rs_in + (size_t)(u.pm * BM + ai * HALF + wr * 64 + m * 16 + fr) * 16 + 4 * fq) : (f32x4){0.f, 0.f, 0.f, 0.f};
#pragma unroll
            for (int m = 0; m < 4; ++m) { const size_t off = (size_t)(u.pm * BM + ai * HALF + wr * 64 + m * 16 + fr) * 1024 + col0;
#pragma unroll
                for (int bj = 0; bj < 2; ++bj)
#pragma unroll
                    for (int n = 0; n < 2; ++n) pre[ai][m][bj][n] = *(const u32x2*)(hb + off + bj * HALF + n * 16); }
#pragma unroll
            for (int m = 0; m < 4; ++m) { float s = (prs[m][0] + prs[m][1]) + (prs[m][2] + prs[m][3]); s += __shfl_xor(s, 16); s += __shfl_xor(s, 32);
                sc2[m] = rs_in ? 1.0f / (s * (1.0f / 1024.0f) + 1e-6f) : 1.0f; }
#pragma unroll
            for (int m = 0; m < 4; ++m) {
                const int row = u.pm * BM + ai * HALF + wr * 64 + m * 16 + fr; const size_t off = (size_t)row * 1024 + col0;
                float ss = 0.f;
#pragma unroll
                for (int bj = 0; bj < 2; ++bj)
#pragma unroll
                    for (int n = 0; n < 2; ++n) {
                        const u32x2 p = pre[ai][m][bj][n];
                        f32x4 o; o[0] = __builtin_bit_cast(float, p.x << 16); o[1] = __builtin_bit_cast(float, p.x & 0xffff0000u); o[2] = __builtin_bit_cast(float, p.y << 16); o[3] = __builtin_bit_cast(float, p.y & 0xffff0000u);
                        o = o + acc[ai][bj][m][n] * sc2[m];
                        u32x2 w; w.x = cvt_pk_bf16(o[0], o[1]); w.y = cvt_pk_bf16(o[2], o[3]);
                        *(u32x2*)(hb + off + bj * HALF + n * 16) = w;
                        ss += (o[0] * o[0] + o[1] * o[1]) + (o[2] * o[2] + o[3] * o[3]);
                    }
                ss += __shfl_xor(ss, 16); ss += __shfl_xor(ss, 32);
                if (fq == 0) rsq[(size_t)row * 16 + u.pn * 4 + wc] = ss;
            }
        }
    }
};
template <class Epi, class Sched, bool ALIGN_EPI = false, bool SP2 = false>
__device__ __forceinline__ void gemm_phase(PG8_LAS unsigned char* lds, const Gemm g, const Sched& S, const Epi& E) {
    int tid_ = threadIdx.x; asm volatile("" : "+v"(tid_)); const int tid = tid_, wid = __builtin_amdgcn_readfirstlane(tid >> 6), lane = tid & 63, wr = wid >> 2, wc = wid & 3, fr = lane & 15, fq = lane >> 4;
    const int K = g.K, nt = K / BK;
    unsigned voffA[2], voffB[2];
#pragma unroll
    for (int i = 0; i < 2; ++i) { int R, C; stage_rc(tid * 16 + i * 8192, R, C); const int Rb = Epi::PERM ? ((R & ~31) + perm32(R & 31)) : R;
        voffA[i] = (unsigned)(R * K + C) * 2u; voffB[i] = (unsigned)(Rb * K + C) * 2u; }
    const size_t kstep = (size_t)(BK * 2);
    const size_t hstep = (size_t)HALF * K * 2;
    const size_t tstep = 2 * hstep;
    const unsigned ldsw = (unsigned)wid * 1024u;
    const int aoff = lds_byte(wr * 64 + fr, fq * 8), boff = lds_byte(wc * 32 + fr, fq * 8);
#define PG8_SA(b, h) (((b) * 2 + (h)) * HTB)
#define PG8_SB(b, h) ((4 + (b) * 2 + (h)) * HTB)
#define PG8_STAGE(bufoff, gbase, voff) do { _Pragma("unroll") for (int _i = 0; _i < 2; ++_i) \
        __builtin_amdgcn_global_load_lds((const unsigned*)((const char*)(gbase) + (voff)[_i]), (PG8_LAS unsigned*)(lds + (bufoff) + ldsw + _i * 8192), 16, 0, 0); } while (0)
#define PG8_LDA(dst, b, h) do { _Pragma("unroll") for (int m = 0; m < 4; ++m) _Pragma("unroll") for (int k = 0; k < 2; ++k) dst[m][k] = *(const PG8_LAS bf16x8*)(lds + PG8_SA(b, h) + aoff + m * 2048 + k * 1024); } while (0)
#define PG8_LDB(dst, b, h) do { _Pragma("unroll") for (int n = 0; n < 2; ++n) _Pragma("unroll") for (int k = 0; k < 2; ++k) dst[n][k] = *(const PG8_LAS bf16x8*)(lds + PG8_SB(b, h) + boff + n * 2048 + k * 1024); } while (0)
#define PG8_MMA(ai, bj, At, Bt) do { __builtin_amdgcn_s_setprio(1); _Pragma("unroll") for (int m = 0; m < 4; ++m) _Pragma("unroll") for (int n = 0; n < 2; ++n) _Pragma("unroll") for (int k = 0; k < 2; ++k) \
        acc[ai][bj][m][n] = __builtin_amdgcn_mfma_f32_16x16x32_bf16(Bt[n][k], At[m][k], acc[ai][bj][m][n], 0, 0, 0); __builtin_amdgcn_s_setprio(0); } while (0)
#define PG8_WAIT_V(n) asm volatile("s_waitcnt vmcnt(" #n ")" ::: "memory")
#define PG8_WAIT_L(n) asm volatile("s_waitcnt lgkmcnt(" #n ")" ::: "memory")
#define PG8_BAR __builtin_amdgcn_s_barrier()
#define PG8_SCHED __builtin_amdgcn_sched_barrier(0)
    Unit cur, nxt; int ui = 0;
    if (!S.next(0, cur)) return;
    f32x4 acc[2][2][4][2];
#pragma unroll
    for (int a = 0; a < 2; ++a)
#pragma unroll
        for (int b = 0; b < 2; ++b)
#pragma unroll
            for (int m = 0; m < 4; ++m)
#pragma unroll
                for (int n = 0; n < 2; ++n) acc[a][b][m][n] = (f32x4){0.f, 0.f, 0.f, 0.f};
    bf16x8 At[4][2], B0[2][2], B1[2][2];
    const char* cA = (const char*)g.A + (size_t)cur.pm * tstep; const char* cB = (const char*)g.Bt + (size_t)cur.pn * tstep;
    S.a_ready(cur);
    if constexpr (SP2) {
        PG8_STAGE(PG8_SB(0, 0), cB, voffB); PG8_STAGE(PG8_SB(0, 1), cB + hstep, voffB); PG8_STAGE(PG8_SA(0, 0), cA, voffA); PG8_STAGE(PG8_SA(0, 1), cA + hstep, voffA);
        if (wr == 1) PG8_BAR;
        PG8_WAIT_V(2); PG8_BAR;
        PG8_STAGE(PG8_SB(1, 0), cB + kstep, voffB); PG8_STAGE(PG8_SA(1, 0), cA + kstep, voffA); PG8_STAGE(PG8_SB(1, 1), cB + hstep + kstep, voffB);
        PG8_WAIT_V(6); PG8_BAR;
    } else {
        PG8_STAGE(PG8_SB(0, 0), cB, voffB); PG8_STAGE(PG8_SA(0, 0), cA, voffA); PG8_STAGE(PG8_SB(0, 1), cB + hstep, voffB); PG8_STAGE(PG8_SA(0, 1), cA + hstep, voffA);
        if (wr == 1) PG8_BAR;
        PG8_WAIT_V(4); PG8_BAR;
        PG8_STAGE(PG8_SB(1, 0), cB + kstep, voffB); PG8_STAGE(PG8_SA(1, 0), cA + kstep, voffA); PG8_STAGE(PG8_SB(1, 1), cB + hstep + kstep, voffB);
        PG8_WAIT_V(6); PG8_BAR;
    }
    for (;;) {
        const bool has_next = S.next(ui + 1, nxt);
        const char* nA = has_next ? (const char*)g.A + (size_t)nxt.pm * tstep : cA; const char* nB = has_next ? (const char*)g.Bt + (size_t)nxt.pn * tstep : cB;
        for (int t = 0; t < nt; t += 2) {
            const bool last = (t == nt - 2);
            const char* a1 = cA + (size_t)(t + 1) * kstep;
            const char* a2 = last ? nA : cA + (size_t)(t + 2) * kstep; const char* b2 = last ? nB : cB + (size_t)(t + 2) * kstep;
            const char* a3 = a2 + kstep; const char* b3 = b2 + kstep;
            if (last && has_next) S.a_ready(nxt);
            if constexpr (SP2) {
            PG8_LDB(B0, 0, 0); PG8_LDB(B1, 0, 1); PG8_SCHED; PG8_LDA(At, 0, 0); PG8_STAGE(PG8_SA(1, 1), a1 + hstep, voffA);
            PG8_WAIT_V(8); PG8_WAIT_L(0); PG8_BAR; PG8_MMA(0, 0, At, B0); PG8_MMA(0, 1, At, B1); PG8_BAR; PG8_SCHED;
            PG8_LDA(At, 0, 1); PG8_STAGE(PG8_SB(0, 0), b2, voffB); PG8_STAGE(PG8_SB(0, 1), b2 + hstep, voffB); PG8_STAGE(PG8_SA(0, 0), a2, voffA);
            PG8_WAIT_V(8); PG8_WAIT_L(0); PG8_BAR; PG8_MMA(1, 0, At, B0); PG8_MMA(1, 1, At, B1); PG8_BAR; PG8_SCHED;
            PG8_LDB(B0, 1, 0); PG8_LDB(B1, 1, 1); PG8_SCHED; PG8_LDA(At, 1, 0); PG8_STAGE(PG8_SA(0, 1), a2 + hstep, voffA);
            PG8_WAIT_V(8); PG8_WAIT_L(0); PG8_BAR; PG8_MMA(0, 0, At, B0); PG8_MMA(0, 1, At, B1); PG8_BAR; PG8_SCHED;
            PG8_LDA(At, 1, 1); PG8_STAGE(PG8_SB(1, 0), b3, voffB); PG8_STAGE(PG8_SB(1, 1), b3 + hstep, voffB); PG8_STAGE(PG8_SA(1, 0), a3, voffA);
            PG8_WAIT_V(8); PG8_WAIT_L(0); PG8_BAR; PG8_MMA(1, 0, At, B0); PG8_MMA(1, 1, At, B1); PG8_BAR; PG8_SCHED;
            } else {
            PG8_LDB(B0, 0, 0); PG8_SCHED; PG8_LDA(At, 0, 0); PG8_STAGE(PG8_SA(1, 1), a1 + hstep, voffA);
            PG8_WAIT_L(8); PG8_BAR; PG8_WAIT_L(0); PG8_MMA(0, 0, At, B0); PG8_BAR; PG8_SCHED;
            PG8_LDB(B1, 0, 1); PG8_STAGE(PG8_SB(0, 0), b2, voffB);
            PG8_BAR; PG8_WAIT_L(0); PG8_MMA(0, 1, At, B1); PG8_BAR;
            PG8_LDA(At, 0, 1); PG8_STAGE(PG8_SA(0, 0), a2, voffA);
            PG8_BAR; PG8_WAIT_L(0); PG8_MMA(1, 0, At, B0); PG8_BAR; PG8_SCHED;
            PG8_STAGE(PG8_SB(0, 1), b2 + hstep, voffB);
            PG8_WAIT_V(6); PG8_BAR; PG8_MMA(1, 1, At, B1); PG8_BAR;
            PG8_LDB(B0, 1, 0); PG8_SCHED; PG8_LDA(At, 1, 0); PG8_STAGE(PG8_SA(0, 1), a2 + hstep, voffA);
            PG8_WAIT_L(8); PG8_BAR; PG8_WAIT_L(0); PG8_MMA(0, 0, At, B0); PG8_BAR; PG8_SCHED;
            PG8_LDB(B1, 1, 1); PG8_STAGE(PG8_SB(1, 0), b3, voffB);
            PG8_BAR; PG8_WAIT_L(0); PG8_MMA(0, 1, At, B1); PG8_BAR;
            PG8_LDA(At, 1, 1); PG8_STAGE(PG8_SA(1, 0), a3, voffA);
            PG8_BAR; PG8_WAIT_L(0); PG8_MMA(1, 0, At, B0); PG8_BAR; PG8_SCHED;
            PG8_STAGE(PG8_SB(1, 1), b3 + hstep, voffB);
            PG8_WAIT_V(6); PG8_BAR; PG8_MMA(1, 1, At, B1); PG8_BAR;
            }
        }
        if constexpr (ALIGN_EPI) { if (wr == 0) PG8_BAR; }
        if constexpr (!Epi::AFTER_DRAIN) { E(acc, cur, wr, wc, fr, fq); S.done(cur); }
        if (!has_next) break;
#pragma unroll
        for (int a = 0; a < 2; ++a)
#pragma unroll
            for (int b = 0; b < 2; ++b)
#pragma unroll
                for (int m = 0; m < 4; ++m)
#pragma unroll
                    for (int n = 0; n < 2; ++n) acc[a][b][m][n] = (f32x4){0.f, 0.f, 0.f, 0.f};
        cur = nxt; cA = nA; cB = nB; ++ui;
        if constexpr (ALIGN_EPI) { if (wr == 1) PG8_BAR; }
    }
    PG8_WAIT_V(0);
    if constexpr (!ALIGN_EPI) { if (wr == 0) PG8_BAR; }
    PG8_BAR;
    if constexpr (Epi::AFTER_DRAIN) { E.fused(acc, cur, wr, wc, fr, fq, lds, wid, lane); S.done(cur); }
#undef PG8_SA
#undef PG8_SB
#undef PG8_STAGE
#undef PG8_LDA
#undef PG8_LDB
#undef PG8_MMA
#undef PG8_WAIT_V
#undef PG8_WAIT_L
#undef PG8_BAR
#undef PG8_SCHED
}
}
#define GAS __attribute__((address_space(1)))
#define LAS __attribute__((address_space(3)))
typedef unsigned short bf16;
typedef unsigned v4u __attribute__((ext_vector_type(4)));
typedef unsigned v2u __attribute__((ext_vector_type(2)));
typedef float f32x4 __attribute__((ext_vector_type(4)));
typedef short bf16x8 __attribute__((ext_vector_type(8)));
#ifndef REP_HG
#define REP_HG 1
#endif
#ifndef REP_RW
#define REP_RW 1
#endif
#ifndef REP_UP
#define REP_UP 1
#endif
#ifndef REP_ATT
#define REP_ATT 1
#endif
#ifndef REP_PRO
#define REP_PRO 1
#endif
#ifndef REP_G1
#define REP_G1 1
#endif
#ifndef REP_G2
#define REP_G2 1
#endif
#ifndef REP_SC
#define REP_SC 1
#endif
#ifndef REP_DN
#define REP_DN 1
#endif
#ifndef REP_OUT
#define REP_OUT 1
#endif
#ifndef REP_HGL
#define REP_HGL 1
#endif
#ifndef REP_IN
#define REP_IN 1
#endif
#ifndef REP_SYNC
#define REP_SYNC 1
#endif
#define GRID_SYNC() do { for (int r_ = 0; r_ < REP_SYNC; ++r_) xcd_barrier(xbar); } while (0)
constexpr int NWAVES = 8, NTHR = 512;
constexpr int M = 32768, D = 1024, SEQ = 8192, FF = 4096;
constexpr size_t MiB = 1u << 20;
constexpr size_t WS_BAR = 64 * 1024, WS_BAR_BYTES = 16 * 1024;
constexpr size_t WS_LBK = 0;
constexpr size_t WS_RS = 1 * MiB;
constexpr size_t WS_WA = 4 * MiB, WS_WB = 18 * MiB, WS_WO = 20 * MiB, WS_WUP = 22 * MiB, WS_WDN = 30 * MiB;
constexpr size_t WS_HB = 38 * MiB;
constexpr size_t WS_BIG = 102 * MiB;
constexpr size_t SLOT = 64 * MiB;
constexpr size_t WS_END = 512 * MiB;
constexpr int LDS_BYTES = 163840;
constexpr float LOG2E_F = 1.4426950408889634f;

#define LDS_WAIT() asm volatile("s_waitcnt lgkmcnt(0)" ::: "memory")
typedef float f32x2_t __attribute__((ext_vector_type(2))); typedef __bf16 bf16x2_t __attribute__((ext_vector_type(2)));
__device__ __forceinline__ unsigned pk2(float lo, float hi) { const f32x2_t v = {lo, hi}; const bf16x2_t b = __builtin_convertvector(v, bf16x2_t); return __builtin_bit_cast(unsigned, b); }
__device__ __forceinline__ unsigned f2bf(float f) { return pk2(f, 0.f) & 0xffffu; }
__device__ __forceinline__ float bflo(unsigned u) { return __builtin_bit_cast(float, u << 16); }
__device__ __forceinline__ float bfhi(unsigned u) { return __builtin_bit_cast(float, u & 0xffff0000u); }
__device__ __forceinline__ float bf1(unsigned short b) { return __builtin_bit_cast(float, (unsigned)b << 16); }
__device__ __forceinline__ f32x4 bf4(v2u u) { return (f32x4){bflo(u.x), bfhi(u.x), bflo(u.y), bfhi(u.y)}; }
__device__ __forceinline__ float wave_sum(float v) {
#pragma unroll
    for (int o = 1; o < 64; o <<= 1) v += __shfl_xor(v, o);
    return v;
}
template <int CTRL> __device__ __forceinline__ float dpp_f(float x) { return __builtin_bit_cast(float, __builtin_amdgcn_update_dpp(0, __builtin_bit_cast(int, x), CTRL, 0xf, 0xf, true)); }
__device__ __forceinline__ float row16_sum(float x) { x += dpp_f<0xB1>(x); x += dpp_f<0x4E>(x); x += dpp_f<0x141>(x); x += dpp_f<0x140>(x); return x; }

__device__ __forceinline__ void wt_item(const float* W, int K, int N, bf16* WT, int ld, int row_off, int col_off, const float* sc, LAS float* scr, int item, int lane) {
    const int nblk = N / 32, kb = item / nblk, nb = item % nblk, k0 = 64 * kb, n0 = 32 * nb;
    f32x4 wv[8]; float sv[8];
#pragma unroll
    for (int i = 0; i < 8; ++i) { const int kk = 8 * i + (lane >> 3); wv[i] = *(const f32x4*)(W + (size_t)(k0 + kk) * N + n0 + 4 * (lane & 7)); sv[i] = sc ? sc[k0 + kk] : 1.f; }
#pragma unroll
    for (int i = 0; i < 8; ++i) { const int kk = 8 * i + (lane >> 3); LAS float* d = scr + kk * 33 + 4 * (lane & 7); d[0] = wv[i][0] * sv[i]; d[1] = wv[i][1] * sv[i]; d[2] = wv[i][2] * sv[i]; d[3] = wv[i][3] * sv[i]; }
    LDS_WAIT(); asm volatile("" ::: "memory");
    const int c = lane & 7;
#pragma unroll
    for (int j = 0; j < 4; ++j) { const int n = (lane >> 3) + 8 * j; const LAS float* s = scr + (8 * c) * 33 + n;
        v4u o; o.x = pk2(s[0 * 33], s[1 * 33]); o.y = pk2(s[2 * 33], s[3 * 33]); o.z = pk2(s[4 * 33], s[5 * 33]); o.w = pk2(s[6 * 33], s[7 * 33]);
        *(v4u*)(WT + (size_t)(row_off + n0 + n) * ld + col_off + k0 + 8 * c) = o; }
    LDS_WAIT(); asm volatile("" ::: "memory");
}
__device__ __forceinline__ void conv_mat(const float* W, int K, int N, bf16* WT, int ld, int row_off, int col_off, const float* sc, LAS float* scr, int gw, int ngw, int lane) {
    const int nitems = (K / 64) * (N / 32);
    for (int it = gw; it < nitems; it += ngw) wt_item(W, K, N, WT, ld, row_off, col_off, sc, scr, it, lane);
}

__device__ __forceinline__ void attn_phase(const bf16* Q, const bf16* K, const bf16* V, bf16* O, int gw, int ngw, int lane) {
    const int fr = lane & 15, fq = lane >> 4;
    for (int unit = gw; unit < (M / 16) * 16; unit += ngw) {
        const int qt = unit & 511, bh = unit >> 9, h = bh & 15, b = bh >> 4;
        const int t0 = qt * 16; const size_t rowb = (size_t)b * SEQ;
        const bf16* qp = Q + (rowb + t0 + fr) * 1024 + h * 64 + fq * 8;
        const bf16x8 qb0 = *(const bf16x8*)(qp), qb1 = *(const bf16x8*)(qp + 32);
        f32x4 o[4];
#pragma unroll
        for (int dt = 0; dt < 4; ++dt) o[dt] = (f32x4){0.f, 0.f, 0.f, 0.f};
        float carry = 1.f;
        const int tq = t0 + fr;
        bf16x8 kn0, kn1; unsigned short vn[4][4];
#define ATT_LOAD(SH) { int sk_ = (SH) - fr; sk_ = sk_ < 0 ? 0 : sk_; const bf16* kp_ = K + (rowb + sk_) * 1024 + h * 64 + fq * 8; kn0 = *(const bf16x8*)(kp_); kn1 = *(const bf16x8*)(kp_ + 32); \
            _Pragma("unroll") for (int j = 0; j < 4; ++j) { int sv_ = (SH) - (4 * fq + j); sv_ = sv_ < 0 ? 0 : sv_; const bf16* vp_ = V + (rowb + sv_) * 1024 + h * 64 + fr; \
                _Pragma("unroll") for (int dt = 0; dt < 4; ++dt) vn[dt][j] = vp_[16 * dt]; } }
        ATT_LOAD(t0 + 14)
        for (int s_hi = t0 + 14; s_hi >= 0; s_hi -= 16) {
            const bf16x8 ka0 = kn0, ka1 = kn1;
            unsigned short vv[4][4];
#pragma unroll
            for (int j = 0; j < 4; ++j)
#pragma unroll
                for (int dt = 0; dt < 4; ++dt) vv[dt][j] = vn[dt][j];
            ATT_LOAD(s_hi - 16)
            f32x4 z = (f32x4){0.f, 0.f, 0.f, 0.f};
            z = __builtin_amdgcn_mfma_f32_16x16x32_bf16(ka0, qb0, z, 0, 0, 0);
            z = __builtin_amdgcn_mfma_f32_16x16x32_bf16(ka1, qb1, z, 0, 0, 0);
            float dd[4], sg[4];
#pragma unroll
            for (int i = 0; i < 4; ++i) {
                const int s = s_hi - (4 * fq + i);
                const bool valid = (s >= 0) && (s < tq);
                const float e = __builtin_amdgcn_exp2f(fminf(z[i], 100.f));
                const float d = __builtin_amdgcn_rcpf(1.0f + e);
                dd[i] = valid ? d : 1.f; sg[i] = valid ? e * d : 0.f;
            }
            const float c1 = dd[0], c2 = c1 * dd[1], c3 = c2 * dd[2], g = c3 * dd[3];
            const float g0 = __shfl(g, fr), g1 = __shfl(g, fr + 16), g2 = __shfl(g, fr + 32), g3 = __shfl(g, fr + 48);
            float pre = carry;
            if (fq > 0) pre *= g0;
            if (fq > 1) pre *= g1;
            if (fq > 2) pre *= g2;
            carry = carry * ((g0 * g1) * (g2 * g3));
            const float p0 = sg[0] * pre, p1 = sg[1] * (pre * c1), p2 = sg[2] * (pre * c2), p3 = sg[3] * (pre * c3);
            bf16x8 pb; { const unsigned w0 = pk2(p0, p1), w1 = pk2(p2, p3); pb[0] = (short)(w0 & 0xffff); pb[1] = (short)(w0 >> 16); pb[2] = (short)(w1 & 0xffff); pb[3] = (short)(w1 >> 16); pb[4] = 0; pb[5] = 0; pb[6] = 0; pb[7] = 0; }
#pragma unroll
            for (int dt = 0; dt < 4; ++dt) {
                bf16x8 va; va[0] = (short)vv[dt][0]; va[1] = (short)vv[dt][1]; va[2] = (short)vv[dt][2]; va[3] = (short)vv[dt][3]; va[4] = 0; va[5] = 0; va[6] = 0; va[7] = 0;
                o[dt] = __builtin_amdgcn_mfma_f32_16x16x32_bf16(va, pb, o[dt], 0, 0, 0);
            }
            if (__builtin_amdgcn_ballot_w64(carry != 0.f) == 0ull) break;
        }
#undef ATT_LOAD
        bf16* op = O + (rowb + t0 + fr) * 1024 + h * 64 + fq * 4;
#pragma unroll
        for (int dt = 0; dt < 4; ++dt) { v2u w; w.x = pk2(o[dt][0], o[dt][1]); w.y = pk2(o[dt][2], o[dt][3]); *(v2u*)(op + 16 * dt) = w; }
    }
}

typedef unsigned u32x4_t __attribute__((ext_vector_type(4)));
__device__ __forceinline__ bf16x8 mk8(unsigned a, unsigned b, unsigned c, unsigned d) { const u32x4_t t = {a, b, c, d}; return __builtin_bit_cast(bf16x8, t); }
__device__ __forceinline__ void hg_prep_item(bf16* QS, bf16* KF, bf16* KT, float* DB, int chunk, int c) {
    {
        const size_t base = (size_t)chunk * 16 * 1024 + c;
        v2u kin[16], qin[16];
#pragma unroll
        for (int t = 0; t < 16; ++t) { kin[t] = *(const v2u*)(KF + base + (size_t)t * 1024); qin[t] = *(const v2u*)(QS + base + (size_t)t * 1024); }
        float b[4] = {0.f, 0.f, 0.f, 0.f};
        unsigned ktp[4][8];
#pragma unroll
        for (int t2 = 0; t2 < 8; ++t2) {
            float kt2[2][4];
#pragma unroll
            for (int u = 0; u < 2; ++u) {
                const int t = 2 * t2 + u;
                const f32x4 kf = bf4(kin[t]), q = bf4(qin[t]);
                float qt[4];
#pragma unroll
                for (int j = 0; j < 4; ++j) {
                    const float fdec = fmaxf(1.0f - kf[j], 1e-4f);
                    b[j] += __builtin_amdgcn_logf(fdec);
                    const float e = __builtin_amdgcn_exp2f(b[j]);
                    qt[j] = q[j] * e; kt2[u][j] = kf[j] * __builtin_amdgcn_rcpf(e);
                }
                v2u qo; qo.x = pk2(qt[0], qt[1]); qo.y = pk2(qt[2], qt[3]); *(v2u*)(QS + base + (size_t)t * 1024) = qo;
                v2u ko; ko.x = pk2(kt2[u][0], kt2[u][1]); ko.y = pk2(kt2[u][2], kt2[u][3]); *(v2u*)(KF + base + (size_t)t * 1024) = ko;
            }
#pragma unroll
            for (int j = 0; j < 4; ++j) ktp[j][t2] = pk2(kt2[0][j], kt2[1][j]);
        }
        f32x4 dv; dv[0] = __builtin_amdgcn_exp2f(b[0]); dv[1] = __builtin_amdgcn_exp2f(b[1]); dv[2] = __builtin_amdgcn_exp2f(b[2]); dv[3] = __builtin_amdgcn_exp2f(b[3]);
        *(f32x4*)(DB + (size_t)chunk * 1024 + c) = dv;
#pragma unroll
        for (int j = 0; j < 4; ++j) { v4u* kp = (v4u*)(KT + ((size_t)chunk * 1024 + c + j) * 16);
            kp[0] = (v4u){ktp[j][0], ktp[j][1], ktp[j][2], ktp[j][3]}; kp[1] = (v4u){ktp[j][4], ktp[j][5], ktp[j][6], ktp[j][7]}; }
    }
}
__device__ __forceinline__ void hg_local(bf16* QS, bf16* KF, bf16* KT, const bf16* IV, float* DB, float* SL, float* DT) {
    int tid_ = threadIdx.x; asm volatile("" : "+v"(tid_)); const int tid = tid_, lane = tid & 63, w = __builtin_amdgcn_readfirstlane(tid >> 6), fr = lane & 15, fq = lane >> 4;
    for (int unit = blockIdx.x; unit < 256; unit += gridDim.x) {
        const int seg = unit & 7, bh = unit >> 3, h = bh & 7, b = bh >> 3;
#pragma unroll 1
        for (int ps = 0; ps < 4; ++ps) hg_prep_item(QS, KF, KT, DB, (int)((((size_t)b * SEQ + (size_t)seg * 1024) >> 4) + 16 * ps + 2 * w + (lane >> 5)), 128 * h + 4 * (lane & 31));
        asm volatile("s_waitcnt vmcnt(0)" ::: "memory"); __syncthreads();
        if (seg == 7) continue;
        f32x4 S[8], DTt[8];
#pragma unroll
        for (int kt = 0; kt < 8; ++kt) { S[kt] = (f32x4){0.f, 0.f, 0.f, 0.f}; DTt[kt] = (f32x4){1.f, 1.f, 1.f, 1.f}; }
        const size_t m0 = (size_t)b * SEQ + (size_t)seg * 1024;
        v2u kt1[8], kt2[8]; f32x4 d1[8], d2[8]; unsigned short v1_[4], v2_[4];
#define HGL_LOAD(KTV, DV, VV, CJ) { const int cj_ = (CJ) < 64 ? (CJ) : 63; const size_t chunk_ = (m0 >> 4) + cj_, mrow_ = m0 + 16 * cj_; \
          _Pragma("unroll") for (int kt = 0; kt < 8; ++kt) { KTV[kt] = *(const v2u*)(KT + (chunk_ * 1024 + 128 * h + 16 * kt + fr) * 16 + 4 * fq); DV[kt] = *(const f32x4*)(DB + chunk_ * 1024 + 128 * h + 16 * kt + 4 * fq); } \
          const bf16* vp_ = IV + (mrow_ + 4 * fq) * 1024 + 128 * h + 16 * w + fr; VV[0] = vp_[0]; VV[1] = vp_[1024]; VV[2] = vp_[2048]; VV[3] = vp_[3072]; }
        HGL_LOAD(kt1, d1, v1_, 0) HGL_LOAD(kt2, d2, v2_, 1)
        for (int ci = 0; ci < 64; ++ci) {
            v2u ktv[8]; f32x4 dv[8];
#pragma unroll
            for (int kt = 0; kt < 8; ++kt) { ktv[kt] = kt1[kt]; dv[kt] = d1[kt]; kt1[kt] = kt2[kt]; d1[kt] = d2[kt]; }
            const unsigned v0 = v1_[0], v1 = v1_[1], v2 = v1_[2], v3 = v1_[3];
#pragma unroll
            for (int x = 0; x < 4; ++x) v1_[x] = v2_[x];
            HGL_LOAD(kt2, d2, v2_, ci + 2)
            const bf16x8 vb = mk8(v0 | (v1 << 16), v2 | (v3 << 16), 0u, 0u);
#pragma unroll
            for (int kt = 0; kt < 8; ++kt) { S[kt] = __builtin_amdgcn_mfma_f32_16x16x32_bf16(mk8(ktv[kt].x, ktv[kt].y, 0u, 0u), vb, S[kt], 0, 0, 0); S[kt] = S[kt] * dv[kt]; DTt[kt] = DTt[kt] * dv[kt]; }
        }
#undef HGL_LOAD
#pragma unroll
        for (int kt = 0; kt < 8; ++kt) {
#pragma unroll
            for (int i = 0; i < 4; ++i) SL[((size_t)(bh * 8 + seg) * 128 + 16 * kt + 4 * fq + i) * 128 + 16 * w + fr] = S[kt][i];
            if (w == 0 && fr == 0) *(f32x4*)(DT + (size_t)(bh * 8 + seg) * 128 + 16 * kt + 4 * fq) = DTt[kt];
        }
    }
}
__device__ __forceinline__ void hg_out(const bf16* QT, const bf16* KTL, const bf16* KT, const bf16* IV, const float* DB, const float* SL, const float* DT, const float* norm_g, bf16* SGO, LAS unsigned char* lds) {
    int tid_ = threadIdx.x; asm volatile("" : "+v"(tid_)); const int tid = tid_, lane = tid & 63, w = __builtin_amdgcn_readfirstlane(tid >> 6), fr = lane & 15, fq = lane >> 4;
    LAS float* ssb = (LAS float*)lds;
    for (int unit = blockIdx.x; unit < 256; unit += gridDim.x) {
        const int seg = unit & 7, bh = unit >> 3, h = bh & 7, b = bh >> 3;
        f32x4 S[8];
#pragma unroll
        for (int kt = 0; kt < 8; ++kt) S[kt] = (f32x4){0.f, 0.f, 0.f, 0.f};
        for (int j = 0; j < seg; ++j) {
#pragma unroll
            for (int kt = 0; kt < 8; ++kt) {
                const f32x4 dt = *(const f32x4*)(DT + (size_t)(bh * 8 + j) * 128 + 16 * kt + 4 * fq);
#pragma unroll
                for (int i = 0; i < 4; ++i) S[kt][i] = S[kt][i] * dt[i] + SL[((size_t)(bh * 8 + j) * 128 + 16 * kt + 4 * fq + i) * 128 + 16 * w + fr];
            }
        }
        const float ng = norm_g[128 * h + 16 * w + fr];
        const size_t m0 = (size_t)b * SEQ + (size_t)seg * 1024;
        v2u qn[8], kn[8];
        { const bf16* qp = QT + (m0 + fr) * 1024 + 128 * h + 4 * fq; const bf16* kp = KTL + (m0 + fr) * 1024 + 128 * h + 4 * fq;
#pragma unroll
          for (int x = 0; x < 8; ++x) { qn[x] = *(const v2u*)(qp + 16 * x); kn[x] = *(const v2u*)(kp + 16 * x); } }
        unsigned short vn[4], gn[4];
        { const bf16* vp = IV + (m0 + 4 * fq) * 1024 + 128 * h + 16 * w + fr; const bf16* gq = SGO + (m0 + 4 * fq) * 1024 + 128 * h + 16 * w + fr;
          vn[0] = vp[0]; vn[1] = vp[1024]; vn[2] = vp[2048]; vn[3] = vp[3072]; gn[0] = gq[0]; gn[1] = gq[1024]; gn[2] = gq[2048]; gn[3] = gq[3072]; }
        for (int ci = 0; ci < 64; ++ci) {
            const size_t chunk = (m0 >> 4) + ci, mrow = m0 + 16 * ci;
            v2u ktv[8]; f32x4 dv[8];
#pragma unroll
            for (int kt = 0; kt < 8; ++kt) { ktv[kt] = *(const v2u*)(KT + (chunk * 1024 + 128 * h + 16 * kt + fr) * 16 + 4 * fq); dv[kt] = *(const f32x4*)(DB + chunk * 1024 + 128 * h + 16 * kt + 4 * fq); }
            const unsigned v0 = vn[0], v1 = vn[1], v2 = vn[2], v3 = vn[3];
            bf16* gp = SGO + (mrow + 4 * fq) * 1024 + 128 * h + 16 * w + fr;
            const float sg0 = bf1(gn[0]), sg1 = bf1(gn[1]), sg2 = bf1(gn[2]), sg3 = bf1(gn[3]);
            { const size_t mn = m0 + 16 * (ci + 1 < 64 ? ci + 1 : ci); const bf16* vp = IV + (mn + 4 * fq) * 1024 + 128 * h + 16 * w + fr; const bf16* gq = SGO + (mn + 4 * fq) * 1024 + 128 * h + 16 * w + fr;
              if (ci + 1 < 64) { vn[0] = vp[0]; vn[1] = vp[1024]; vn[2] = vp[2048]; vn[3] = vp[3072]; gn[0] = gq[0]; gn[1] = gq[1024]; gn[2] = gq[2048]; gn[3] = gq[3072]; } }
            v2u qc[8], kc[8];
#pragma unroll
            for (int x = 0; x < 8; ++x) { qc[x] = qn[x]; kc[x] = kn[x]; }
            { const size_t mn = m0 + 16 * (ci + 1 < 64 ? ci + 1 : ci); const bf16* qp = QT + (mn + fr) * 1024 + 128 * h + 4 * fq; const bf16* kp = KTL + (mn + fr) * 1024 + 128 * h + 4 * fq;
#pragma unroll
              for (int x = 0; x < 8; ++x) { qn[x] = *(const v2u*)(qp + 16 * x); kn[x] = *(const v2u*)(kp + 16 * x); } }
            const bf16x8 vb = mk8(v0 | (v1 << 16), v2 | (v3 << 16), 0u, 0u);
            f32x4 pt = (f32x4){0.f, 0.f, 0.f, 0.f};
#pragma unroll
            for (int p = 0; p < 4; ++p) pt = __builtin_amdgcn_mfma_f32_16x16x32_bf16(mk8(kc[2 * p].x, kc[2 * p].y, kc[2 * p + 1].x, kc[2 * p + 1].y), mk8(qc[2 * p].x, qc[2 * p].y, qc[2 * p + 1].x, qc[2 * p + 1].y), pt, 0, 0, 0);
#pragma unroll
            for (int i = 0; i < 4; ++i) if (4 * fq + i > fr) pt[i] = 0.f;
            f32x4 o = (f32x4){0.f, 0.f, 0.f, 0.f};
#pragma unroll
            for (int p = 0; p < 4; ++p) {
                const bf16x8 sb = mk8(pk2(S[2 * p][0], S[2 * p][1]), pk2(S[2 * p][2], S[2 * p][3]), pk2(S[2 * p + 1][0], S[2 * p + 1][1]), pk2(S[2 * p + 1][2], S[2 * p + 1][3]));
                o = __builtin_amdgcn_mfma_f32_16x16x32_bf16(mk8(qc[2 * p].x, qc[2 * p].y, qc[2 * p + 1].x, qc[2 * p + 1].y), sb, o, 0, 0, 0);
            }
            o = __builtin_amdgcn_mfma_f32_16x16x32_bf16(mk8(pk2(pt[0], pt[1]), pk2(pt[2], pt[3]), 0u, 0u), vb, o, 0, 0, 0);
#pragma unroll
            for (int kt = 0; kt < 8; ++kt) { S[kt] = __builtin_amdgcn_mfma_f32_16x16x32_bf16(mk8(ktv[kt].x, ktv[kt].y, 0u, 0u), vb, S[kt], 0, 0, 0); S[kt] = S[kt] * dv[kt]; }
            LAS float* sb_ = ssb + (ci & 1) * 128;
#pragma unroll
            for (int i = 0; i < 4; ++i) { const float ss = row16_sum(o[i] * o[i]); if (fr == 0) sb_[(4 * fq + i) * 8 + w] = ss; }
            __syncthreads();
            const float sgv[4] = {sg0, sg1, sg2, sg3};
#pragma unroll
            for (int i = 0; i < 4; ++i) {
                const f32x4 a0 = *(const LAS f32x4*)(sb_ + (4 * fq + i) * 8), a1 = *(const LAS f32x4*)(sb_ + (4 * fq + i) * 8 + 4);
                const float tot = ((a0[0] + a0[1]) + (a0[2] + a0[3])) + ((a1[0] + a1[1]) + (a1[2] + a1[3]));
                const float r = 1.0f / sqrtf(tot * (1.0f / 128.0f) + 1e-6f);
                gp[(size_t)i * 1024] = (bf16)f2bf(o[i] * r * ng * sgv[i]);
            }
        }
        __syncthreads();
    }
}

__device__ __forceinline__ void rw_prep(const bf16* h, const float* rs, const float* g, bf16* A2, int gw, int ngw, int lane) {
    for (int it = gw; it < M / 2; it += ngw) {
        const int m = 2 * it, t = m & (SEQ - 1);
        const int mp = t ? m - 1 : m;
        f32x4 x[3][4], pr[3];
#pragma unroll
        for (int u = 0; u < 3; ++u) { const int mm = u == 0 ? mp : m + u - 1; pr[u] = *(const f32x4*)(rs + (size_t)mm * 16 + 4 * (lane & 3));
#pragma unroll
            for (int j = 0; j < 4; ++j) x[u][j] = bf4(*(const v2u*)(h + (size_t)mm * 1024 + 4 * lane + 256 * j)); }
        float r3[3];
#pragma unroll
        for (int u = 0; u < 3; ++u) { float s = (pr[u][0] + pr[u][1]) + (pr[u][2] + pr[u][3]); s += dpp_f<0xB1>(s); s += dpp_f<0x4E>(s); r3[u] = 1.0f / sqrtf(s * (1.0f / 1024.0f) + 1e-6f); }
        if (t == 0) r3[0] = 0.f;
#pragma unroll
        for (int j = 0; j < 4; ++j) {
            const int c = 4 * lane + 256 * j;
            const f32x4 gc = *(const f32x4*)(g + c);
            const f32x4 xp = x[0][j] * gc * r3[0], x0 = x[1][j] * gc * r3[1], x1 = x[2][j] * gc * r3[2];
            const f32x4 d0 = xp - x0, d1 = x0 - x1;
            v2u o;
            o.x = pk2(x0[0], x0[1]); o.y = pk2(x0[2], x0[3]); *(v2u*)(A2 + (size_t)m * 2048 + c) = o;
            o.x = pk2(d0[0], d0[1]); o.y = pk2(d0[2], d0[3]); *(v2u*)(A2 + (size_t)m * 2048 + 1024 + c) = o;
            o.x = pk2(x1[0], x1[1]); o.y = pk2(x1[2], x1[3]); *(v2u*)(A2 + (size_t)(m + 1) * 2048 + c) = o;
            o.x = pk2(d1[0], d1[1]); o.y = pk2(d1[2], d1[3]); *(v2u*)(A2 + (size_t)(m + 1) * 2048 + 1024 + c) = o;
        }
    }
}
constexpr int RWS_AH = 0, RWS_RB = 2048, RWS_KGT = 4096, RWS_BGT = 6144, RWS_G15 = 8192, RWS_KNI = 8448, RWS_WVI = 9472, RWS_VCI = 10496, RWS_SLOT = 11264;
constexpr int RWT_AB = 0, RWT_BT = 2048, RWT_KT = 4096, RWT_ABT = 6144, RWT_NM = 0  , RWT_TM = 2048  , RWT_BYTES = 8192;
__device__ __forceinline__ int rwz(int k) { return (k & ~7) | ((k & 7) ^ ((k >> 3) & 7)); }
constexpr int RW_NSLOT = 9, RW_NPROD = 7, RW_RING = RW_NSLOT * RWS_SLOT, RW_FLAGS = RW_RING + RW_NPROD * RWT_BYTES;
struct RwRaw4 { v2u r[4], k[4], wm[4], a[4]; unsigned short v[4]; };
__device__ __forceinline__ void rw_load4(RwRaw4& x, const bf16* R, const bf16* K, const bf16* V, const bf16* WM, const bf16* A, size_t m, int ch, int vch) {
#pragma unroll
    for (int j = 0; j < 4; ++j) { const size_t off = (m + j) * 1024 + ch;
        x.r[j] = *(const v2u*)(R + off); x.k[j] = *(const v2u*)(K + off); x.wm[j] = *(const v2u*)(WM + off); x.a[j] = *(const v2u*)(A + off); x.v[j] = V[(m + j) * 1024 + vch]; }
}
__device__ __forceinline__ bf16x8 lds_op16(const LAS unsigned char* mtx, int row, int kbyte) { return *(const LAS bf16x8*)(mtx + row * 128 + kbyte); }
__device__ __forceinline__ v2u lds_8(const LAS unsigned char* p) { return *(const LAS v2u*)p; }
__device__ __forceinline__ void rw_scan(const bf16* R, const bf16* K, const bf16* V, const bf16* WM, const bf16* A, const float* k_k, const float* k_a, bf16* Y, LAS unsigned char* lds) {
    int tid_ = threadIdx.x; asm volatile("" : "+v"(tid_)); const int tid = tid_, lane = tid & 63, w = __builtin_amdgcn_readfirstlane(tid >> 6);
    const int fr = lane & 15, fq = lane >> 4;
    constexpr int NCH = SEQ / 16;
    for (int unit = blockIdx.x; unit < 256; unit += gridDim.x) {
        const int rg = unit & 3, h = (unit >> 2) & 15, b = unit >> 6;
        const size_t row0 = (size_t)b * SEQ;
        volatile LAS unsigned* flg = (volatile LAS unsigned*)(lds + RW_FLAGS);
        if (tid < 16) flg[tid] = 0u;
        __syncthreads();
        if (w >= 1) {
            const int pw = w - 1, ch = 64 * h + 4 * fr, vch = 64 * h + 16 * rg + fr;
            LAS unsigned char* tmp = lds + RW_RING + pw * RWT_BYTES;
            const f32x4 kkc = *(const f32x4*)(k_k + ch), kac = *(const f32x4*)(k_a + ch);
            RwRaw4 nx; rw_load4(nx, R, K, V, WM, A, row0 + 16 * pw + 4 * fq, ch, vch);
            for (int cj = pw; cj < NCH; cj += RW_NPROD) {
                {
                    const RwRaw4 cu = nx;
                    { const int cn = cj + RW_NPROD < NCH ? cj + RW_NPROD : cj; rw_load4(nx, R, K, V, WM, A, row0 + 16 * (size_t)cn + 4 * fq, ch, vch); }
                    while ((int)flg[RW_NSLOT] < cj - (RW_NSLOT - 1)) __builtin_amdgcn_s_sleep(2);
                    asm volatile("" ::: "memory");
                    LAS unsigned char* slot = lds + (cj % RW_NSLOT) * RWS_SLOT;
                    f32x4 wv[4], kk[4], km[4], be[4], rr[4];
#pragma unroll
                    for (int j = 0; j < 4; ++j) {
                        const f32x4 r = bf4(cu.r[j]), k = bf4(cu.k[j]), wm = bf4(cu.wm[j]), a = bf4(cu.a[j]);
                        const f32x4 kr = k * kkc;
                        const float n2 = row16_sum((kr[0] * kr[0] + kr[1] * kr[1]) + (kr[2] * kr[2] + kr[3] * kr[3]));
                        const float inv = 1.0f / fmaxf(sqrtf(n2), 1e-12f);
                        kk[j] = kr * inv; be[j] = kk[j] * a; km[j] = k * (1.0f + (a - 1.0f) * kac); wv[j] = 1.0f - wm; rr[j] = r;
                    }
                    f32x4 g[4]; g[0] = wv[0]; g[1] = g[0] * wv[1]; g[2] = g[1] * wv[2]; g[3] = g[2] * wv[3];
                    f32x4 pre = (f32x4){1.f, 1.f, 1.f, 1.f}, all = (f32x4){1.f, 1.f, 1.f, 1.f};
#pragma unroll
                    for (int x = 0; x < 4; ++x) {
                        const float t0 = __shfl(g[3][x], fr), t1 = __shfl(g[3][x], 16 + fr), t2 = __shfl(g[3][x], 32 + fr), t3 = __shfl(g[3][x], 48 + fr);
                        float p = 1.f; if (fq > 0) p *= t0; if (fq > 1) p *= t1; if (fq > 2) p *= t2;
                        pre[x] = p; all[x] = (t0 * t1) * (t2 * t3);
                    }
                    unsigned kgp[4][2], bgp[4][2], abp[4][2];
                    float kgt[4][4], bgt[4][4], abt[4][4];
#pragma unroll
                    for (int j = 0; j < 4; ++j) {
                        const f32x4 Gs = pre * g[j], Gm = j ? pre * g[j - 1] : pre;
                        f32x4 ginv; ginv[0] = __builtin_amdgcn_rcpf(Gs[0]); ginv[1] = __builtin_amdgcn_rcpf(Gs[1]); ginv[2] = __builtin_amdgcn_rcpf(Gs[2]); ginv[3] = __builtin_amdgcn_rcpf(Gs[3]);
                        const f32x4 alb = kk[j] * Gm, rb = rr[j] * Gs, bet = be[j] * ginv, ktl = km[j] * ginv;
                        const int s = 4 * fq + j;
                        v2u o;
                        o.x = pk2(alb[0], alb[1]); o.y = pk2(alb[2], alb[3]); *(LAS v2u*)(tmp + RWT_AB + s * 128 + 8 * fr) = o;
                        o.x = pk2(bet[0], bet[1]); o.y = pk2(bet[2], bet[3]); *(LAS v2u*)(tmp + RWT_BT + s * 128 + 8 * fr) = o;
                        o.x = pk2(ktl[0], ktl[1]); o.y = pk2(ktl[2], ktl[3]); *(LAS v2u*)(tmp + RWT_KT + s * 128 + 8 * fr) = o;
                        o.x = pk2(rb[0], rb[1]); o.y = pk2(rb[2], rb[3]); *(LAS v2u*)(slot + RWS_RB + s * 128 + 8 * fr) = o;
#pragma unroll
                        for (int x = 0; x < 4; ++x) { kgt[x][j] = ktl[x] * all[x]; bgt[x][j] = -(bet[x] * all[x]); abt[x][j] = alb[x]; }
                    }
#pragma unroll
                    for (int x = 0; x < 4; ++x) {
                        const int kch = 4 * fr + x;
                        v2u o;
                        o.x = pk2(kgt[x][0], kgt[x][1]); o.y = pk2(kgt[x][2], kgt[x][3]); *(LAS v2u*)(slot + RWS_KGT + rwz(kch) * 32 + 8 * fq) = o;
                        o.x = pk2(bgt[x][0], bgt[x][1]); o.y = pk2(bgt[x][2], bgt[x][3]); *(LAS v2u*)(slot + RWS_BGT + rwz(kch) * 32 + 8 * fq) = o;
                        o.x = pk2(abt[x][0], abt[x][1]); o.y = pk2(abt[x][2], abt[x][3]); *(LAS v2u*)(tmp + RWT_ABT + rwz(kch) * 32 + 8 * fq) = o;
                    }
                    if (fq == 0) *(LAS f32x4*)(slot + RWS_G15 + 16 * fr) = all;
                    const unsigned vlo = (unsigned)cu.v[0] | ((unsigned)cu.v[1] << 16), vhi = (unsigned)cu.v[2] | ((unsigned)cu.v[3] << 16);
                    { v2u o; o.x = vlo; o.y = vhi; *(LAS v2u*)(slot + RWS_VCI + 8 * lane) = o; }
                    LDS_WAIT(); asm volatile("" ::: "memory");
                    f32x4 nac = (f32x4){0.f, 0.f, 0.f, 0.f}, kat = nac, krt = nac, nrt = nac;
#pragma unroll
                    for (int p = 0; p < 2; ++p) {
                        const int kb = (32 * p + 8 * fq) * 2;
                        const bf16x8 oAB = lds_op16(tmp + RWT_AB, fr, kb), oBT = lds_op16(tmp + RWT_BT, fr, kb), oKT = lds_op16(tmp + RWT_KT, fr, kb), oRB = lds_op16(slot + RWS_RB, fr, kb);
                        nac = __builtin_amdgcn_mfma_f32_16x16x32_bf16(oBT, oAB, nac, 0, 0, 0);
                        kat = __builtin_amdgcn_mfma_f32_16x16x32_bf16(oKT, oAB, kat, 0, 0, 0);
                        krt = __builtin_amdgcn_mfma_f32_16x16x32_bf16(oKT, oRB, krt, 0, 0, 0);
                        nrt = __builtin_amdgcn_mfma_f32_16x16x32_bf16(oBT, oRB, nrt, 0, 0, 0);
                    }
#pragma unroll
                    for (int i = 0; i < 4; ++i) { const int rr_ = 4 * fq + i;
                        if (rr_ >= fr) { nac[i] = 0.f; kat[i] = 0.f; }
                        if (rr_ > fr) { krt[i] = 0.f; nrt[i] = 0.f; } }
                    { u32x4_t o; o.x = pk2(krt[0], krt[1]); o.y = pk2(krt[2], krt[3]); o.z = pk2(-nrt[0], -nrt[1]); o.w = pk2(-nrt[2], -nrt[3]); *(LAS u32x4_t*)(slot + RWS_KNI + 16 * lane) = o; }
                    LDS_WAIT(); asm volatile("" ::: "memory");
                    *(LAS f32x4*)(tmp + RWT_NM + (fr * 16 + 4 * fq) * 4) = nac;
                    LDS_WAIT(); asm volatile("" ::: "memory");
                    float Tc[16];
                    f32x4 nvv[16][4];
#define RW_LD_ROWS(lo, hi) _Pragma("unroll") for (int s = lo; s <= hi; ++s) _Pragma("unroll") for (int r4 = 0; r4 < (s + 3) / 4; ++r4) nvv[s][r4] = *(const LAS f32x4*)(tmp + RWT_NM + (s * 16 + 4 * r4) * 4);
#define RW_DO_ROWS(lo, hi) _Pragma("unroll") for (int s = lo; s <= hi; ++s) { float acc_ = (s == fr) ? 1.f : 0.f; \
                        _Pragma("unroll") for (int r4 = 0; r4 < (s + 3) / 4; ++r4) _Pragma("unroll") for (int e = 0; e < 4; ++e) if (4 * r4 + e < s) acc_ -= nvv[s][r4][e] * Tc[4 * r4 + e]; \
                        Tc[s] = acc_; }
                    RW_LD_ROWS(1, 8) RW_LD_ROWS(9, 12)
                    asm volatile("" ::: "memory");
                    RW_DO_ROWS(0, 8)
                    RW_LD_ROWS(13, 15)
                    asm volatile("" ::: "memory");
                    RW_DO_ROWS(9, 12)
                    RW_DO_ROWS(13, 15)
#undef RW_LD_ROWS
#undef RW_DO_ROWS
#pragma unroll
                    for (int e = 0; e < 4; ++e) {
                        float tv = Tc[0];
#pragma unroll
                        for (int s = 0; s < 16; ++s) if (s == 4 * fq + e) tv = Tc[s];
                        *(LAS unsigned short*)(tmp + RWT_TM + ((4 * fq + e) * 16 + fr) * 2) = (unsigned short)f2bf(tv);
                    }
                    LDS_WAIT(); asm volatile("" ::: "memory");
                    const v2u tq = lds_8(tmp + RWT_TM + (fr * 16 + 4 * fq) * 2);
                    const bf16x8 opT = mk8(tq.x, tq.y, 0u, 0u);
                    f32x4 xac = __builtin_amdgcn_mfma_f32_16x16x32_bf16(mk8(pk2(kat[0], kat[1]), pk2(kat[2], kat[3]), 0u, 0u), mk8(vlo, vhi, 0u, 0u), (f32x4){0.f, 0.f, 0.f, 0.f}, 0, 0, 0);
                    const f32x4 wvv = __builtin_amdgcn_mfma_f32_16x16x32_bf16(opT, mk8(pk2(xac[0], xac[1]), pk2(xac[2], xac[3]), 0u, 0u), (f32x4){0.f, 0.f, 0.f, 0.f}, 0, 0, 0);
                    *(LAS f32x4*)(slot + RWS_WVI + 16 * lane) = wvv;
                    f32x4 aht[4];
#pragma unroll
                    for (int nt = 0; nt < 4; ++nt) {
                        const v2u ab = lds_8(tmp + RWT_ABT + rwz(16 * nt + fr) * 32 + 8 * fq);
                        aht[nt] = __builtin_amdgcn_mfma_f32_16x16x32_bf16(mk8(ab.x, ab.y, 0u, 0u), opT, (f32x4){0.f, 0.f, 0.f, 0.f}, 0, 0, 0);
                    }
#pragma unroll
                    for (int p = 0; p < 2; ++p) { u32x4_t o; o.x = pk2(aht[2 * p][0], aht[2 * p][1]); o.y = pk2(aht[2 * p][2], aht[2 * p][3]); o.z = pk2(aht[2 * p + 1][0], aht[2 * p + 1][1]); o.w = pk2(aht[2 * p + 1][2], aht[2 * p + 1][3]);
                        *(LAS u32x4_t*)(slot + RWS_AH + (p * 64 + lane) * 16) = o; }
                    LDS_WAIT(); asm volatile("" ::: "memory");
                    if (lane == 0) flg[cj % RW_NSLOT] = (unsigned)(cj + 1);
                }
            }
        } else {
            f32x4 St[4];
#pragma unroll
            for (int kt = 0; kt < 4; ++kt) St[kt] = (f32x4){0.f, 0.f, 0.f, 0.f};
            {
#pragma unroll 1
                for (int c = 0; c < NCH; ++c) {
                    const LAS unsigned char* slot = lds + (c % RW_NSLOT) * RWS_SLOT;
                    while (flg[c % RW_NSLOT] != (unsigned)(c + 1)) __builtin_amdgcn_s_sleep(1);
                    asm volatile("" ::: "memory");
                    f32x4 zt = *(const LAS f32x4*)(slot + RWS_WVI + 16 * lane);
                    f32x4 y = (f32x4){0.f, 0.f, 0.f, 0.f};
#pragma unroll
                    for (int p = 0; p < 2; ++p) {
                        const bf16x8 sb = mk8(pk2(St[2 * p][0], St[2 * p][1]), pk2(St[2 * p][2], St[2 * p][3]), pk2(St[2 * p + 1][0], St[2 * p + 1][1]), pk2(St[2 * p + 1][2], St[2 * p + 1][3]));
                        const v2u r0 = lds_8(slot + RWS_RB + fr * 128 + (32 * p + 4 * fq) * 2), r1 = lds_8(slot + RWS_RB + fr * 128 + (32 * p + 16 + 4 * fq) * 2);
                        zt = __builtin_amdgcn_mfma_f32_16x16x32_bf16(*(const LAS bf16x8*)(slot + RWS_AH + (p * 64 + lane) * 16), sb, zt, 0, 0, 0);
                        y = __builtin_amdgcn_mfma_f32_16x16x32_bf16(mk8(r0.x, r0.y, r1.x, r1.y), sb, y, 0, 0, 0);
                    }
                    const v2u vc = lds_8(slot + RWS_VCI + 8 * lane);
                    const bf16x8 b2 = mk8(vc.x, vc.y, pk2(zt[0], zt[1]), pk2(zt[2], zt[3]));
                    y = __builtin_amdgcn_mfma_f32_16x16x32_bf16(*(const LAS bf16x8*)(slot + RWS_KNI + 16 * lane), b2, y, 0, 0, 0);
#pragma unroll
                    for (int kt = 0; kt < 4; ++kt) {
                        const v2u kg = lds_8(slot + RWS_KGT + rwz(16 * kt + fr) * 32 + 8 * fq), bg = lds_8(slot + RWS_BGT + rwz(16 * kt + fr) * 32 + 8 * fq);
                        const f32x4 g15 = *(const LAS f32x4*)(slot + RWS_G15 + (16 * kt + 4 * fq) * 4);
                        St[kt] = __builtin_amdgcn_mfma_f32_16x16x32_bf16(mk8(kg.x, kg.y, bg.x, bg.y), b2, St[kt] * g15, 0, 0, 0);
                    }
                    bf16* yp = Y + (row0 + 16 * (size_t)c + 4 * fq) * 1024 + 64 * h + 16 * rg + fr;
#pragma unroll
                    for (int i = 0; i < 4; ++i) yp[(size_t)i * 1024] = (bf16)f2bf(y[i]);
                    LDS_WAIT(); asm volatile("" ::: "memory");
                    if (lane == 0) flg[RW_NSLOT] = (unsigned)(c + 1);
                }
            }
        }
        __syncthreads();
    }
}
__device__ __forceinline__ void rw_post(const bf16* Y, bf16* R, const bf16* K, const bf16* V, const bf16* A, const bf16* G, const float* k_a, const float* r_k, const float* ln_g, const float* ln_b, int gw, int ngw, int lane) {
    const int c = (gw & 3) * 256 + 4 * lane;
    const f32x4 ka = *(const f32x4*)(k_a + c), rk = *(const f32x4*)(r_k + c), lg = *(const f32x4*)(ln_g + c), lb = *(const f32x4*)(ln_b + c);
    for (int it = gw; it < M * 4; it += 2 * ngw) {
        const int it2 = (it + ngw < M * 4) ? it + ngw : it;
        const size_t off[2] = {(size_t)(it >> 2) * 1024 + c, (size_t)(it2 >> 2) * 1024 + c};
        v2u yv[2], rv[2], kv[2], vv[2], av[2], gv[2];
#pragma unroll
        for (int u = 0; u < 2; ++u) { yv[u] = *(const v2u*)(Y + off[u]); rv[u] = *(const v2u*)(R + off[u]); kv[u] = *(const v2u*)(K + off[u]); vv[u] = *(const v2u*)(V + off[u]); av[u] = *(const v2u*)(A + off[u]); gv[u] = *(const v2u*)(G + off[u]); }
#pragma unroll
        for (int u = 0; u < 2; ++u) {
            const f32x4 y = bf4(yv[u]), r = bf4(rv[u]), k = bf4(kv[u]), v = bf4(vv[u]), a = bf4(av[u]), g = bf4(gv[u]);
            const float mu = row16_sum((y[0] + y[1]) + (y[2] + y[3])) * (1.0f / 64.0f);
            const f32x4 yc = y - mu;
            const float var = row16_sum((yc[0] * yc[0] + yc[1] * yc[1]) + (yc[2] * yc[2] + yc[3] * yc[3])) * (1.0f / 64.0f);
            const float rstd = 1.0f / sqrtf(var + 64e-5f);
            const f32x4 km = k * (1.0f + (a - 1.0f) * ka);
            const f32x4 pr = r * km * rk;
            const float cs = row16_sum((pr[0] + pr[1]) + (pr[2] + pr[3]));
            const f32x4 o = (yc * rstd * lg + lb + v * cs) * g;
            v2u wv; wv.x = pk2(o[0], o[1]); wv.y = pk2(o[2], o[3]);
            if (u == 0 || it2 != it) *(v2u*)(R + off[u]) = wv;
        }
    }
}

__device__ __forceinline__ void sc_conv(const bf16* BG, const bf16* CG, const bf16* HX, const float* cw, const float* cb, bf16* O3, int gt, int ngt) {
    const int c = (gt & 127) * 8;
    float w0[8], w1[8], w2[8], bb[8];
#pragma unroll
    for (int j = 0; j < 8; ++j) { w0[j] = cw[c + j]; w1[j] = cw[1024 + c + j]; w2[j] = cw[2048 + c + j]; bb[j] = cb[c + j]; }
    for (int idx = gt; idx < M * 128; idx += 2 * ngt) {
        const int idx2 = idx + ngt < M * 128 ? idx + ngt : idx;
        v4u cv[2][3], hv[2][3], bv[2]; int tt[2]; size_t offs[2];
#pragma unroll
        for (int u = 0; u < 2; ++u) {
            const int m = (u ? idx2 : idx) >> 7; tt[u] = m & (SEQ - 1); offs[u] = (size_t)m * 1024 + c;
#pragma unroll
            for (int dt = 0; dt < 3; ++dt) { const size_t o2 = offs[u] - (size_t)((tt[u] - 2 + dt >= 0) ? (2 - dt) : 0) * 1024; cv[u][dt] = *(const v4u*)(CG + o2); hv[u][dt] = *(const v4u*)(HX + o2); }
            bv[u] = *(const v4u*)(BG + offs[u]);
        }
#pragma unroll
        for (int u = 0; u < 2; ++u) {
            float y[8];
#pragma unroll
            for (int j = 0; j < 8; ++j) y[j] = bb[j];
#pragma unroll
            for (int dt = 0; dt < 3; ++dt) {
                const float on = (tt[u] - 2 + dt >= 0) ? 1.f : 0.f;
                const float* wp = dt == 0 ? w0 : (dt == 1 ? w1 : w2);
                const v4u cq = cv[u][dt], hq = hv[u][dt];
                y[0] += on * wp[0] * (bflo(cq.x) * bflo(hq.x)); y[1] += on * wp[1] * (bfhi(cq.x) * bfhi(hq.x));
                y[2] += on * wp[2] * (bflo(cq.y) * bflo(hq.y)); y[3] += on * wp[3] * (bfhi(cq.y) * bfhi(hq.y));
                y[4] += on * wp[4] * (bflo(cq.z) * bflo(hq.z)); y[5] += on * wp[5] * (bfhi(cq.z) * bfhi(hq.z));
                y[6] += on * wp[6] * (bflo(cq.w) * bflo(hq.w)); y[7] += on * wp[7] * (bfhi(cq.w) * bfhi(hq.w));
            }
            const v4u bq = bv[u];
            v4u w; w.x = pk2(y[0] * bflo(bq.x), y[1] * bfhi(bq.x)); w.y = pk2(y[2] * bflo(bq.y), y[3] * bfhi(bq.y)); w.z = pk2(y[4] * bflo(bq.z), y[5] * bfhi(bq.z)); w.w = pk2(y[6] * bflo(bq.w), y[7] * bfhi(bq.w));
            if (u == 0 || idx2 != idx) *(v4u*)(O3 + offs[u]) = w;
        }
    }
}

#define XB_TMO      128
#define XB_XCNT(j)  (256  + 64 * (j))
#define XB_XSUB(j)  (1280 + 64 * (j))
#define XB_XGEN(j)  (2304 + 64 * (j))
#define XB_TOP      3328
#define XB_TOPGEN   3392
#define XCD_BAR_WORDS 3456
#define XB_SPIN_CAP (1u << 18)

__device__ __forceinline__ unsigned xb_ld(unsigned* p)              { return __hip_atomic_load(p, __ATOMIC_RELAXED, __HIP_MEMORY_SCOPE_AGENT); }
__device__ __forceinline__ unsigned xb_add(unsigned* p, unsigned v) { return __hip_atomic_fetch_add(p, v, __ATOMIC_RELAXED, __HIP_MEMORY_SCOPE_AGENT); }
__device__ __forceinline__ unsigned xb_xcc_id() { return (unsigned)__builtin_amdgcn_s_getreg((3 << 11) | 20) & 0xFu; }
#define XB_SPIN(cond, bar) do { unsigned _sp = 0; while (cond) { __builtin_amdgcn_s_sleep(1); \
    if ((++_sp & 255u) == 0u) { if (xb_ld(&(bar)[XB_TMO])) break; if (_sp > XB_SPIN_CAP) { atomicAdd(&(bar)[XB_TMO], 1u); break; } } } } while (0)

struct XcdBarrier {
    unsigned* bar; unsigned x;
    volatile LAS unsigned* st;
};

__device__ __forceinline__ XcdBarrier xcd_barrier_post(unsigned* bar, volatile LAS unsigned* st) {
    XcdBarrier b; b.bar = bar; b.x = xb_xcc_id(); b.st = st;
    if (threadIdx.x == 0) (void)xb_add(&bar[XB_XCNT(b.x)], 1u);
    return b;
}
__device__ __forceinline__ void xcd_barrier_complete(unsigned* bar, unsigned x, unsigned& nloc, unsigned& nx) {
    const unsigned G = gridDim.x * gridDim.y * gridDim.z;
    unsigned sum, cnt, mine, sp = 0u;
    for (;;) {
        sum = 0u; cnt = 0u; mine = 0u;
#pragma unroll
        for (unsigned j = 0; j < 16; ++j) { const unsigned c = xb_ld(&bar[XB_XCNT(j)]); sum += c; cnt += (c > 0u) ? 1u : 0u; mine = (j == x) ? c : mine; }
        if (sum == G) break;
        __builtin_amdgcn_s_sleep(1);
        if ((++sp & 255u) == 0u) { if (xb_ld(&bar[XB_TMO])) break; if (sp > XB_SPIN_CAP) { atomicAdd(&bar[XB_TMO], 1u); break; } }
    }
    nloc = mine > 0u ? mine : 1u; nx = cnt > 0u ? cnt : 1u;
}

__device__ __forceinline__ void xcd_barrier(const XcdBarrier& b) {
    asm volatile("s_waitcnt vmcnt(0)" ::: "memory");
    __syncthreads();
    if (threadIdx.x == 0) {
        unsigned* bar = b.bar;
        __builtin_amdgcn_s_waitcnt(0);
        unsigned nloc = b.st[0], nx = b.st[1];
        if (nloc == 0u) { xcd_barrier_complete(bar, b.x, nloc, nx); b.st[0] = nloc; b.st[1] = nx; }
        const unsigned old = xb_add(&bar[XB_XSUB(b.x)], 1u);
        const unsigned gen = old / nloc;
        if (old + 1u == (gen + 1u) * nloc) {
            __builtin_amdgcn_fence(__ATOMIC_RELEASE, "agent");
            asm volatile("s_waitcnt vmcnt(0)" ::: "memory");
            const unsigned og = xb_add(&bar[XB_TOP], 1u);
            const unsigned tg = og / nx;
            if (og + 1u == (tg + 1u) * nx) xb_add(&bar[XB_TOPGEN], 1u);
            else XB_SPIN(xb_ld(&bar[XB_TOPGEN]) == tg, bar);
            __builtin_amdgcn_fence(__ATOMIC_ACQUIRE, "agent");
            xb_add(&bar[XB_XGEN(b.x)], 1u);
            asm volatile("s_waitcnt vmcnt(0)" ::: "memory");
        } else {
            XB_SPIN(xb_ld(&bar[XB_XGEN(b.x)]) == gen, bar);
            __builtin_amdgcn_fence(__ATOMIC_ACQUIRE, "agent");
            asm volatile("s_waitcnt vmcnt(0)" ::: "memory");
        }
    }
    __syncthreads();
}

struct Args { const float* in[32]; float* out; unsigned char* ws; };
#define PHASE_VARS \
    size_t zoff_ = 0; asm volatile("" : "+s"(zoff_)); unsigned char* ws = a.ws + zoff_; float* out = a.out + zoff_;     \
    int tid = threadIdx.x; asm volatile("" : "+v"(tid)); \
    const int lane = tid & 63, wave = __builtin_amdgcn_readfirstlane(tid >> 6); \
    const int G = gridDim.x, gw = blockIdx.x * NWAVES + wave, ngw = G * NWAVES, gt = blockIdx.x * NTHR + tid, ngt = G * NTHR; \
    float* RS = (float*)(ws + WS_BIG + 402 * MiB)  ; float* RSM = (float*)(ws + WS_RS)  ; float* LBK = (float*)(ws + WS_LBK); (void)RSM; \
    bf16* WA = (bf16*)(ws + WS_WA); bf16* WB = (bf16*)(ws + WS_WB); bf16* WO = (bf16*)(ws + WS_WO); bf16* WUP = (bf16*)(ws + WS_WUP); bf16* WDN = (bf16*)(ws + WS_WDN); \
    bf16* HB = (bf16*)(ws + WS_HB); \
    bf16* B0 = (bf16*)(ws + WS_BIG); bf16* B1 = (bf16*)(ws + WS_BIG + SLOT); bf16* B2 = (bf16*)(ws + WS_BIG + 2 * SLOT); bf16* B3 = (bf16*)(ws + WS_BIG + 3 * SLOT); \
    bf16* B4 = (bf16*)(ws + WS_BIG + 4 * SLOT); bf16* B5 = (bf16*)(ws + WS_BIG + 5 * SLOT); bf16* B5b = (bf16*)(ws + WS_BIG + 5 * SLOT + 16 * MiB); \
    LAS float* scr = (LAS float*)(lds + wave * 16384); \
    (void)lane; (void)gw; (void)ngw; (void)gt; (void)ngt; (void)RS; (void)LBK; (void)WA; (void)WB; (void)WO; (void)WUP; (void)WDN; (void)HB; (void)B0; (void)B1; (void)B2; (void)B3; (void)B4; (void)B5; (void)B5b; (void)scr; (void)out; (void)G;
constexpr size_t SLOT_E = SLOT / 2;

__global__ void __launch_bounds__(NTHR, 2) fwd_megakernel(Args a) {
    extern __shared__ __attribute__((aligned(16))) unsigned char lds_raw[];
    cg::grid_group grid = cg::this_grid();
    LAS unsigned char* lds = (LAS unsigned char*)lds_raw;
    volatile LAS unsigned* xb_st = (volatile LAS unsigned*)(lds + LDS_BYTES - 64);
    if (threadIdx.x < 2) xb_st[threadIdx.x] = 0u;
    __syncthreads();
    const XcdBarrier xbar = xcd_barrier_post((unsigned*)(a.ws + WS_BAR), xb_st);

#pragma nounroll
    for (int layer = 0; layer < 4; ++layer) {
        for (int rp_ = 0; rp_ < REP_PRO; ++rp_) { PHASE_VARS
        const float* gmix = a.in[1] + layer * 1024; const float* gffn = a.in[2] + layer * 1024;
        conv_mat(a.in[3] + (size_t)layer * D * FF, D, FF, WUP, D, 0, 0, gffn, scr, gw, ngw, lane);
        conv_mat(a.in[4] + (size_t)layer * D * FF, FF, D, WDN, FF, 0, 0, nullptr, scr, gw, ngw, lane);
        if (layer == 0) {
            conv_mat(a.in[6], D, 3 * D, WA, D, 0, 0, gmix, scr, gw, ngw, lane);
            conv_mat(a.in[7], D, D, WO, D, 0, 0, nullptr, scr, gw, ngw, lane);
            for (int m0 = gw; m0 < M; m0 += 4 * ngw) {
                f32x4 v[4][4];
#pragma unroll
                for (int u = 0; u < 4; ++u) { const int ml = m0 + u * ngw < M ? m0 + u * ngw : m0; const f32x4* xr = (const f32x4*)(a.in[0] + (size_t)ml * 1024) + lane;
#pragma unroll
                    for (int j = 0; j < 4; ++j) v[u][j] = xr[64 * j]; }
#pragma unroll
                for (int u = 0; u < 4; ++u) { const int m = m0 + u * ngw; if (m >= M) break; float ss = 0.f;
#pragma unroll
                    for (int j = 0; j < 4; ++j) { ss += (v[u][j][0] * v[u][j][0] + v[u][j][1] * v[u][j][1]) + (v[u][j][2] * v[u][j][2] + v[u][j][3] * v[u][j][3]);
                        v2u w; w.x = pk2(v[u][j][0], v[u][j][1]); w.y = pk2(v[u][j][2], v[u][j][3]); *(v2u*)(HB + (size_t)m * 1024 + 4 * lane + 256 * j) = w; }
                    ss = wave_sum(ss);
                    if (lane < 16) RS[(size_t)m * 16 + lane] = lane == 0 ? ss : 0.f; }
            }
        } else if (layer == 1) {
            conv_mat(a.in[8], D, 4 * D, WA, D, 0, 0, gmix, scr, gw, ngw, lane);
            conv_mat(a.in[11], D, D, WO, D, 0, 0, nullptr, scr, gw, ngw, lane);
            for (int c = gt; c < 1024; c += ngt) {
                const float* tb = a.in[9]; const float t0 = tb[c], t1 = tb[1024 + c], t2 = tb[2048 + c], t3 = tb[3072 + c];
                const float mx = fmaxf(fmaxf(t0, t1), fmaxf(t2, t3));
                const float e0 = expf(t0 - mx), e1 = expf(t1 - mx), e2 = expf(t2 - mx), e3 = expf(t3 - mx);
                LBK[c] = 1.0f - e1 / (e0 + e1 + e2 + e3);
            }
        } else if (layer == 2) {
            const float* mix = a.in[12];
#pragma nounroll
            for (int j = 0; j < 3; ++j) {
                conv_mat(a.in[13] + (size_t)j * D * D, D, D, WA, 2048, 1024 * j, 0, nullptr, scr, gw, ngw, lane);
                conv_mat(a.in[13] + (size_t)j * D * D, D, D, WA, 2048, 1024 * j, 1024, mix + 1024 * j, scr, gw, ngw, lane);
            }
            conv_mat(a.in[15], D, 64, WA, 2048, 3072, 0, nullptr, scr, gw, ngw, lane); conv_mat(a.in[15], D, 64, WA, 2048, 3072, 1024, mix + 3 * 1024, scr, gw, ngw, lane);
            conv_mat(a.in[18], D, 64, WA, 2048, 3136, 0, nullptr, scr, gw, ngw, lane); conv_mat(a.in[18], D, 64, WA, 2048, 3136, 1024, mix + 4 * 1024, scr, gw, ngw, lane);
            conv_mat(a.in[20], D, 128, WA, 2048, 3200, 0, nullptr, scr, gw, ngw, lane); conv_mat(a.in[20], D, 128, WA, 2048, 3200, 1024, mix + 5 * 1024, scr, gw, ngw, lane);
            conv_mat(a.in[27], D, D, WO, D, 0, 0, nullptr, scr, gw, ngw, lane);
            for (int idx = gt; idx < 256 * 3072; idx += ngt) {
                const int k = idx / 3072, n = idx - k * 3072, grp = n >> 10, nn = n & 1023; float v = 0.f;
                if (grp == 0) { if (k < 64) v = a.in[16][k * 1024 + nn]; }
                else if (grp == 1) { if (k >= 64 && k < 128) v = a.in[19][(k - 64) * 1024 + nn]; }
                else { if (k >= 128) v = a.in[21][(k - 128) * 1024 + nn]; }
                WB[(size_t)n * 256 + k] = (bf16)f2bf(v);
            }
            rw_prep(HB, RS, gmix, B0, gw, ngw, lane);
        } else {
            conv_mat(a.in[28], D, 3 * D, WA, D, 0, 0, gmix, scr, gw, ngw, lane);
            conv_mat(a.in[31], D, D, WO, D, 0, 0, nullptr, scr, gw, ngw, lane);
        }
        }
        if (layer == 0) grid.sync();
        else GRID_SYNC();

        if (layer == 0 || layer == 3) {
            { PHASE_VARS
            pg8::Gemm g{HB, WA, M, 3 * D, D}; pg8::StaticOrder S; S.init(M, 3 * D, G, (int)blockIdx.x);
            pg8::EpiAct<0> E{B0, 1024, 1024, SLOT_E, RS, layer == 0 ? 0.125f * LOG2E_F : 1.0f, nullptr};
            for (int r_ = 0; r_ < REP_IN; ++r_) pg8::gemm_phase<pg8::EpiAct<0>, pg8::StaticOrder, true, true>(lds, g, S, E); }
            GRID_SYNC();
            { PHASE_VARS
            if (layer == 0) { for (int r_ = 0; r_ < REP_ATT; ++r_) attn_phase(B0, B1, B2, B3, gw, ngw, lane); }
            else { for (int r_ = 0; r_ < REP_SC; ++r_) sc_conv(B0, B1, B2, a.in[29], a.in[30], B3, gt, ngt); } }
        } else if (layer == 1) {
            { PHASE_VARS
            pg8::Gemm g{HB, WA, M, 4 * D, D}; pg8::StaticOrder S; S.init(M, 4 * D, G, (int)blockIdx.x);
            pg8::EpiAct<2> E{B0, 1024, 1024, SLOT_E, RS, 1.0f, LBK};
            for (int r_ = 0; r_ < REP_IN; ++r_) pg8::gemm_phase<pg8::EpiAct<2>, pg8::StaticOrder, true, true>(lds, g, S, E); }
            GRID_SYNC();
            { PHASE_VARS
            hg_local(B0, B1, B4, B2, (float*)B5, (float*)(ws + WS_BIG + 5 * SLOT + 8 * MiB), (float*)(ws + WS_BIG + 5 * SLOT + 24 * MiB)); }
            GRID_SYNC();
            { PHASE_VARS
            hg_out(B0, B1, B4, B2, (const float*)B5, (const float*)(ws + WS_BIG + 5 * SLOT + 8 * MiB), (const float*)(ws + WS_BIG + 5 * SLOT + 24 * MiB), a.in[10], B3, lds); }
        } else {
            { PHASE_VARS
              pg8::Gemm g{B0, WA, M, 3328, 2048}; pg8::StaticOrder S; S.init(M, 3328, G, (int)blockIdx.x);
              pg8::EpiRw1 E{B2, SLOT_E, B5};
              for (int r_ = 0; r_ < REP_G1; ++r_) pg8::gemm_phase<pg8::EpiRw1, pg8::StaticOrder, true, true>(lds, g, S, E); }
            GRID_SYNC();
            { PHASE_VARS
              int k256 = 256; asm volatile("" : "+s"(k256));
              pg8::Gemm g{B5, WB, M, 3 * D, k256}; pg8::StaticOrder S; S.init(M, 3 * D, G, (int)blockIdx.x);
              pg8::EpiRw2 E{B0, SLOT_E, 5 * SLOT_E + 8 * MiB, a.in[14], a.in[17]};
              for (int r_ = 0; r_ < REP_G2; ++r_) pg8::gemm_phase<pg8::EpiRw2, pg8::StaticOrder, true, true>(lds, g, S, E); }
            GRID_SYNC();
            { PHASE_VARS
            for (int r_ = 0; r_ < REP_RW; ++r_) rw_scan(B2, B3, B4, B0, B1, a.in[22], a.in[23], (bf16*)out, lds); }
            GRID_SYNC();
            { PHASE_VARS
            rw_post((const bf16*)out, B2, B3, B4, B1, B5b, a.in[23], a.in[24], a.in[25], a.in[26], gw, ngw, lane); }
        }
        GRID_SYNC();
        { PHASE_VARS
          const bf16* mix_out = (layer == 2) ? B2 : B3;
          pg8::Gemm g{mix_out, WO, M, D, D}; pg8::StaticOrder S; S.init(M, D, G, (int)blockIdx.x);
          pg8::EpiResidB E{HB, RSM, nullptr};
          pg8::gemm_phase<pg8::EpiResidB, pg8::StaticOrder, true, true>(lds, g, S, E); }
        GRID_SYNC();
        { PHASE_VARS
          pg8::Gemm g{HB, WUP, M, FF, D}; pg8::StaticOrder S; S.init(M, FF, G, (int)blockIdx.x);
          pg8::EpiAct<1> E{B0, FF, 0, 0, nullptr, 1.0f, nullptr};
#pragma nounroll
          for (int r_ = 0; r_ < REP_UP; ++r_) pg8::gemm_phase<pg8::EpiAct<1>, pg8::StaticOrder, true, true>(lds, g, S, E); }
        GRID_SYNC();
        { PHASE_VARS
          pg8::Gemm g{B0, WDN, M, D, FF}; pg8::StaticOrder S; S.init(M, D, G, (int)blockIdx.x);
          pg8::EpiResidB E{HB, RS, RSM};
          pg8::gemm_phase<pg8::EpiResidB, pg8::StaticOrder, true, true>(lds, g, S, E); }
        GRID_SYNC();
    }
    { PHASE_VARS
    const f32x4* gr = (const f32x4*)(a.in[5]) + lane;
    const f32x4 g0 = gr[0], g1 = gr[64], g2 = gr[128], g3 = gr[192];
    for (int m0 = gw; m0 < M; m0 += 4 * ngw) {
        f32x4 v[4][4]; f32x4 pr[4];
#pragma unroll
        for (int u = 0; u < 4; ++u) { const int m = m0 + u * ngw < M ? m0 + u * ngw : m0;
            pr[u] = *(const f32x4*)(RS + (size_t)m * 16 + 4 * (lane & 3));
#pragma unroll
            for (int j = 0; j < 4; ++j) v[u][j] = bf4(*(const v2u*)(HB + (size_t)m * 1024 + 4 * lane + 256 * j)); }
#pragma unroll
        for (int u = 0; u < 4; ++u) { const int m = m0 + u * ngw; if (m >= M) break; f32x4* xr = (f32x4*)(out + (size_t)m * 1024) + lane;
            float s = (pr[u][0] + pr[u][1]) + (pr[u][2] + pr[u][3]); s += dpp_f<0xB1>(s); s += dpp_f<0x4E>(s);
            const float r = 1.0f / sqrtf(s * (1.0f / 1024.0f) + 1e-6f);
            xr[0] = v[u][0] * r * g0; xr[64] = v[u][1] * r * g1; xr[128] = v[u][2] * r * g2; xr[192] = v[u][3] * r * g3; }
    } }
}

extern "C" void kernel_launch(void* const* d_in, const int* in_sizes, int n_in, void* d_out, int out_size, void* d_ws, size_t ws_size, hipStream_t stream) {
    static int grid = 0;
    if (grid == 0) {
        if (n_in != 32 || out_size != M * D || ws_size < WS_END) { fprintf(stderr, "kernel_launch: unexpected shapes (n_in %d out %d ws %zu)\n", n_in, out_size, ws_size); grid = -1; return; }
        int dev = 0, cus = 0, per_cu = 0;
        hipGetDevice(&dev); hipDeviceGetAttribute(&cus, hipDeviceAttributeMultiprocessorCount, dev);
        hipFuncSetAttribute((const void*)fwd_megakernel, hipFuncAttributeMaxDynamicSharedMemorySize, LDS_BYTES);
        hipOccupancyMaxActiveBlocksPerMultiprocessor(&per_cu, (const void*)fwd_megakernel, NTHR, LDS_BYTES);
        if (per_cu < 1) { fprintf(stderr, "kernel_launch: occupancy query says %d blocks per CU\n", per_cu); per_cu = 1; }
        (void)hipGetLastError();
        grid = cus * per_cu;
    }
    if (grid < 0) return;
    if (hipMemsetAsync((char*)d_ws + WS_BAR, 0, WS_BAR_BYTES, stream) != hipSuccess) { fprintf(stderr, "kernel_launch: memset of the barrier words failed\n"); return; }
    Args a{};
    for (int i = 0; i < 32; ++i) a.in[i] = (const float*)d_in[i];
    a.out = (float*)d_out; a.ws = (unsigned char*)d_ws;
    void* args[] = {&a};
    hipError_t e = hipLaunchCooperativeKernel((const void*)fwd_megakernel, dim3(grid), dim3(NTHR), args, LDS_BYTES, stream);
    if (e != hipSuccess) fprintf(stderr, "cooperative launch failed: %s (grid %d)\n", hipGetErrorString(e), grid);
}
```

```cpp
#include <hip/hip_runtime.h>
#include <hip/hip_cooperative_groups.h>
#include <cstdio>
#include <cstdint>
namespace cg = cooperative_groups;
namespace pg8 {
#define PG8_LAS __attribute__((address_space(3)))
typedef unsigned short bf16_t;
typedef short bf16x8 __attribute__((ext_vector_type(8)));
typedef float f32x4 __attribute__((ext_vector_type(4)));
typedef unsigned u32x4 __attribute__((ext_vector_type(4)));
constexpr int BM = 256, BK = 64, HALF = 128, HTB = HALF * BK * 2  , STAGE_BYTES = 8 * HTB, NXCD = 8, WGM = 8;

__host__ __device__ __forceinline__ int lds_byte(int r, int c) { const int st = (r >> 4) * 2 + (c >> 5), rr = r & 15, cc = c & 31, ob = rr * 64 + cc * 2; return st * 1024 + (ob ^ (((ob >> 9) & 1) << 5)); }
__host__ __device__ __forceinline__ void stage_rc(int b, int& R, int& C) { const int st = b / 1024, sb = b % 1024, swz = sb ^ (((sb >> 9) & 1) << 5); R = (st >> 1) * 16 + swz / 64; C = (st & 1) * 32 + (swz % 64) / 2; }
__host__ __device__ __forceinline__ int perm32(int rho) { const int n = rho >> 4, i = rho & 15; return 8 * (i >> 2) + 4 * n + (i & 3); }

struct Unit { int pm, pn; };
struct Gemm { const bf16_t* A; const bf16_t* Bt; int M, N, K; };

struct StaticOrder {
    int nM, nN, nwg, G, c;
    __host__ __device__ void init(int M, int N, int G_, int c_) { nM = M / BM; nN = N / BM; nwg = nM * nN; G = G_; c = c_; }
    __host__ __device__ bool next(int i, Unit& u) const {
        const long L = (long)i * G + c; if (L >= nwg) return false;
        int wgid = (int)L; { const int q = nwg / NXCD, r = nwg % NXCD, xcd = wgid % NXCD, off = wgid / NXCD; wgid = (xcd < r ? xcd * (q + 1) : r * (q + 1) + (xcd - r) * q) + off; }
        const int wgm = nN >= 8 ? 4 : WGM; const int nig = wgm * nN, gid = wgid / nig, fm = gid * wgm, gsz = (nM - fm) < wgm ? (nM - fm) : wgm;
        u.pm = fm + ((wgid % nig) % gsz); u.pn = (wgid % nig) / gsz; return true;
    }
    __device__ __forceinline__ void a_ready(const Unit&) const {}
    __device__ __forceinline__ void done(const Unit&) const {}
};

__device__ __forceinline__ unsigned cvt_pk_bf16(float lo, float hi) { unsigned r; asm volatile("v_cvt_pk_bf16_f32 %0, %1, %2" : "=v"(r) : "v"(lo), "v"(hi)); return r; }
typedef unsigned u32x4 __attribute__((ext_vector_type(4)));
typedef unsigned u32x2 __attribute__((ext_vector_type(2)));
constexpr float LOG2E = 1.4426950408889634f;
__device__ __forceinline__ float fast_sigmoid(float x) { return __builtin_amdgcn_rcpf(1.0f + __builtin_amdgcn_exp2f(-x * LOG2E)); }
__device__ __forceinline__ float row_rs(const float* rs, int row) {
    const f32x4* p = (const f32x4*)(rs + (size_t)row * 16);
    const f32x4 a = p[0], b = p[1], c = p[2], d = p[3];
    const float s = ((a[0] + a[1]) + (a[2] + a[3])) + ((b[0] + b[1]) + (b[2] + b[3])) + ((c[0] + c[1]) + (c[2] + c[3])) + ((d[0] + d[1]) + (d[2] + d[3]));
    return 1.0f / sqrtf(s * (1.0f / 1024.0f) + 1e-6f);
}
template <int MODE> struct EpiAct {
    static constexpr bool PERM = true, AFTER_DRAIN = false;
    bf16_t* O; int ldc; int split_cols; size_t split_stride; const float* rs; float scale0; const float* aux;
    __device__ __forceinline__ void operator()(const f32x4 (&acc)[2][2][4][2], const Unit& u, int wr, int wc, int fr, int fq) const {
        const int row0 = u.pm * BM + wr * 64 + fr; int colt = u.pn * BM; bf16_t* base = O; int t = 0;
        if (split_cols) { t = colt / split_cols; base += (size_t)t * split_stride; colt -= t * split_cols; }
        const float sc = (MODE == 0 && t == 0) ? scale0 : 1.f;
        const int col0 = colt + wc * 32 + 8 * fq;
        f32x4 lbk[2][2];
#pragma unroll
        for (int bj = 0; bj < 2; ++bj)
#pragma unroll
            for (int n = 0; n < 2; ++n) lbk[bj][n] = (MODE == 2 && t == 1) ? *(const f32x4*)(aux + col0 + bj * HALF + 4 * n) : (f32x4){0.f, 0.f, 0.f, 0.f};
        float rsv[2][4];
        if (rs) {
            f32x4 part[2][4];
#pragma unroll
            for (int ai = 0; ai < 2; ++ai)
#pragma unroll
                for (int m = 0; m < 4; ++m) part[ai][m] = *(const f32x4*)(rs + (size_t)(row0 + ai * HALF + m * 16) * 16 + 4 * fq);
#pragma unroll
            for (int ai = 0; ai < 2; ++ai)
#pragma unroll
                for (int m = 0; m < 4; ++m) { float s = (part[ai][m][0] + part[ai][m][1]) + (part[ai][m][2] + part[ai][m][3]); s += __shfl_xor(s, 16); s += __shfl_xor(s, 32);
                    rsv[ai][m] = sc / sqrtf(s * (1.0f / 1024.0f) + 1e-6f); }
        } else {
#pragma unroll
            for (int ai = 0; ai < 2; ++ai)
#pragma unroll
                for (int m = 0; m < 4; ++m) rsv[ai][m] = sc;
        }
#pragma unroll
        for (int ai = 0; ai < 2; ++ai)
#pragma unroll
            for (int m = 0; m < 4; ++m) {
                const int row = row0 + ai * HALF + m * 16;
                const float r = rsv[ai][m];
                bf16_t* rowp = base + (size_t)row * ldc + col0;
#pragma unroll
                for (int bj = 0; bj < 2; ++bj) {
                    f32x4 v[2] = {acc[ai][bj][m][0] * r, acc[ai][bj][m][1] * r};
#pragma unroll
                    for (int n = 0; n < 2; ++n)
#pragma unroll
                        for (int j = 0; j < 4; ++j) {
                            float x = v[n][j];
                            if (MODE == 1) { x = fmaxf(x, 0.f); x = x * x; }
                            if (MODE == 2) {
                                if (t == 0 || t == 3) x = x * fast_sigmoid(x);
                                else if (t == 1) x = lbk[bj][n][j] * __builtin_amdgcn_rcpf(1.0f + __builtin_amdgcn_exp2f(x * LOG2E));
                            }
                            v[n][j] = x;
                        }
                    u32x4 w; w.x = cvt_pk_bf16(v[0][0], v[0][1]); w.y = cvt_pk_bf16(v[0][2], v[0][3]); w.z = cvt_pk_bf16(v[1][0], v[1][1]); w.w = cvt_pk_bf16(v[1][2], v[1][3]);
                    *(u32x4*)(rowp + bj * HALF) = w;
                }
            }
    }
};
struct EpiRw1 {
    static constexpr bool PERM = true, AFTER_DRAIN = false;
    bf16_t* RKV; size_t split_stride; bf16_t* L;
    __device__ __forceinline__ void operator()(const f32x4 (&acc)[2][2][4][2], const Unit& u, int wr, int wc, int fr, int fq) const {
        const int row0 = u.pm * BM + wr * 64 + fr;
        const bool lora = (u.pn >= 12);
        bf16_t* base = lora ? L : RKV + (size_t)(u.pn >> 2) * split_stride;
        const int ldc = lora ? 256 : 1024;
        const int col0 = (lora ? 0 : (u.pn & 3) * BM) + wc * 32 + 8 * fq;
#pragma unroll
        for (int ai = 0; ai < 2; ++ai)
#pragma unroll
            for (int m = 0; m < 4; ++m) {
                bf16_t* rowp = base + (size_t)(row0 + ai * HALF + m * 16) * ldc + col0;
#pragma unroll
                for (int bj = 0; bj < 2; ++bj) {
                    f32x4 v[2] = {acc[ai][bj][m][0], acc[ai][bj][m][1]};
                    if (lora) {
#pragma unroll
                        for (int n = 0; n < 2; ++n)
#pragma unroll
                            for (int j = 0; j < 4; ++j) {
                                float x = v[n][j];
                                if (bj == 1) x = fast_sigmoid(x);
                                else if (wc < 2) x = 1.0f - 2.0f * __builtin_amdgcn_rcpf(1.0f + __builtin_amdgcn_exp2f(fminf(x, 40.f) * (2.0f * LOG2E)));
                                v[n][j] = x;
                            }
                    }
                    u32x4 w; w.x = cvt_pk_bf16(v[0][0], v[0][1]); w.y = cvt_pk_bf16(v[0][2], v[0][3]); w.z = cvt_pk_bf16(v[1][0], v[1][1]); w.w = cvt_pk_bf16(v[1][2], v[1][3]);
                    *(u32x4*)(rowp + bj * HALF) = w;
                }
            }
    }
};
struct EpiRw2 {
    static constexpr bool PERM = true, AFTER_DRAIN = false;
    bf16_t* WM; size_t offA, offG; const float* w0; const float* a0;
    __device__ __forceinline__ void operator()(const f32x4 (&acc)[2][2][4][2], const Unit& u, int wr, int wc, int fr, int fq) const {
        const int row0 = u.pm * BM + wr * 64 + fr; const int t = u.pn >> 2;
        bf16_t* base = WM + (t == 1 ? offA : (size_t)0) + (t == 2 ? offG : (size_t)0);
        const float* bias = t == 0 ? w0 : a0;
        const int col0 = (u.pn & 3) * BM + wc * 32 + 8 * fq;
        f32x4 bv[2][2];
#pragma unroll
        for (int bj = 0; bj < 2; ++bj)
#pragma unroll
            for (int n = 0; n < 2; ++n) bv[bj][n] = (t < 2) ? *(const f32x4*)(bias + col0 + bj * HALF + 4 * n) : (f32x4){0.f, 0.f, 0.f, 0.f};
#pragma unroll
        for (int ai = 0; ai < 2; ++ai)
#pragma unroll
            for (int m = 0; m < 4; ++m) {
                bf16_t* rowp = base + (size_t)(row0 + ai * HALF + m * 16) * 1024 + col0;
#pragma unroll
                for (int bj = 0; bj < 2; ++bj) {
                    f32x4 v[2] = {acc[ai][bj][m][0], acc[ai][bj][m][1]};
                    if (t < 2) {
                        v[0] += bv[bj][0]; v[1] += bv[bj][1];
#pragma unroll
                        for (int n = 0; n < 2; ++n)
#pragma unroll
                            for (int j = 0; j < 4; ++j) {
                                float x = fast_sigmoid(v[n][j]);
                                if (t == 0) x = 1.0f - __builtin_amdgcn_exp2f(x * (-0.6065306597126334f * LOG2E));
                                v[n][j] = x;
                            }
                    }
                    u32x4 w; w.x = cvt_pk_bf16(v[0][0], v[0][1]); w.y = cvt_pk_bf16(v[0][2], v[0][3]); w.z = cvt_pk_bf16(v[1][0], v[1][1]); w.w = cvt_pk_bf16(v[1][2], v[1][3]);
                    *(u32x4*)(rowp + bj * HALF) = w;
                    asm volatile("" ::: "memory");
                }
            }
    }
};
struct EpiResid {
    static constexpr bool PERM = false, AFTER_DRAIN = false;
    const float* base; float* out; bf16_t* hb; float* rsq;
    __device__ __forceinline__ void operator()(const f32x4 (&acc)[2][2][4][2], const Unit& u, int wr, int wc, int fr, int fq) const {
        const int col0 = u.pn * BM + wc * 32 + 4 * fq;
#pragma unroll
        for (int ai = 0; ai < 2; ++ai) {
            f32x4 pre[4][2][2];
#pragma unroll
            for (int m = 0; m < 4; ++m) { const size_t off = (size_t)(u.pm * BM + ai * HALF + wr * 64 + m * 16 + fr) * 1024 + col0;
#pragma unroll
                for (int bj = 0; bj < 2; ++bj)
#pragma unroll
                    for (int n = 0; n < 2; ++n) pre[m][bj][n] = *(const f32x4*)(base + off + bj * HALF + n * 16); }
#pragma unroll
            for (int m = 0; m < 4; ++m) {
                const int row = u.pm * BM + ai * HALF + wr * 64 + m * 16 + fr; const size_t off = (size_t)row * 1024 + col0;
                float ss = 0.f;
#pragma unroll
                for (int bj = 0; bj < 2; ++bj)
#pragma unroll
                    for (int n = 0; n < 2; ++n) {
                        const f32x4 o = pre[m][bj][n] + acc[ai][bj][m][n];
                        *(f32x4*)(out + off + bj * HALF + n * 16) = o;
                        u32x2 w; w.x = cvt_pk_bf16(o[0], o[1]); w.y = cvt_pk_bf16(o[2], o[3]);
                        if (hb) *(u32x2*)(hb + off + bj * HALF + n * 16) = w;
                        ss += (o[0] * o[0] + o[1] * o[1]) + (o[2] * o[2] + o[3] * o[3]);
                    }
                ss += __shfl_xor(ss, 16); ss += __shfl_xor(ss, 32);
                if (fq == 0) rsq[(size_t)row * 16 + u.pn * 4 + wc] = ss;
            }
        }
    }
};

struct EpiResidB {
    static constexpr bool PERM = false, AFTER_DRAIN = false;
    bf16_t* hb; float* rsq; const float* rs_in;
    __device__ __forceinline__ void operator()(const f32x4 (&acc)[2][2][4][2], const Unit& u, int wr, int wc, int fr, int fq) const {
        const int col0 = u.pn * BM + wc * 32 + 4 * fq;
#pragma unroll
        for (int ai = 0; ai < 2; ++ai) {
            u32x2 pre[2][4][2][2]; f32x4 prs[4]; float sc2[4];
#pragma unroll
            for (int m = 0; m < 4; ++m) prs[m] = rs_in ? *(const f32x4*)(rs_in + (size_t)(u.pm * BM + ai * HALF + wr * 64 + m * 16 + fr) * 16 + 4 * fq) : (f32x4){0.f, 0.f, 0.f, 0.f};
#pragma unroll
            for (int m = 0; m < 4; ++m) { const size_t off = (size_t)(u.pm * BM + ai * HALF + wr * 64 + m * 16 + fr) * 1024 + col0;
#pragma unroll
                for (int bj = 0; bj < 2; ++bj)
#pragma unroll
                    for (int n = 0; n < 2; ++n) pre[ai][m][bj][n] = *(const u32x2*)(hb + off + bj * HALF + n * 16); }
#pragma unroll
            for (int m = 0; m < 4; ++m) { float s = (prs[m][0] + prs[m][1]) + (prs[m][2] + prs[m][3]); s += __shfl_xor(s, 16); s += __shfl_xor(s, 32);
                sc2[m] = rs_in ? 1.0f / (s * (1.0f / 1024.0f) + 1e-6f) : 1.0f; }
#pragma unroll
            for (int m = 0; m < 4; ++m) {
                const int row = u.pm * BM + ai * HALF + wr * 64 + m * 16 + fr; const size_t off = (size_t)row * 1024 + col0;
                float ss = 0.f;
#pragma unroll
                for (int bj = 0; bj < 2; ++bj)
#pragma unroll
                    for (int n = 0; n < 2; ++n) {
                        const u32x2 p = pre[ai][m][bj][n];
                        f32x4 o; o[0] = __builtin_bit_cast(float, p.x << 16); o[1] = __builtin_bit_cast(float, p.x & 0xffff0000u); o[2] = __builtin_bit_cast(float, p.y << 16); o[3] = __builtin_bit_cast(float, p.y & 0xffff0000u);
                        o = o + acc[ai][bj][m][n] * sc2[m];
                        u32x2 w; w.x = cvt_pk_bf16(o[0], o[1]); w.y = cvt_pk_bf16(o[2], o[3]);
                        *(u32x2*)(hb + off + bj * HALF + n * 16) = w;
                        ss += (o[0] * o[0] + o[1] * o[1]) + (o[2] * o[2] + o[3] * o[3]);
                    }
                ss += __shfl_xor(ss, 16); ss += __shfl_xor(ss, 32);
                if (fq == 0) rsq[(size_t)row * 16 + u.pn * 4 + wc] = ss;
            }
        }
    }
};
template <class Epi, class Sched, bool ALIGN_EPI = false, bool SP2 = false>
__device__ __forceinline__ void gemm_phase(PG8_LAS unsigned char* lds, const Gemm g, const Sched& S, const Epi& E) {
    int tid_ = threadIdx.x; asm volatile("" : "+v"(tid_)); const int tid = tid_, wid = __builtin_amdgcn_readfirstlane(tid >> 6), lane = tid & 63, wr = wid >> 2, wc = wid & 3, fr = lane & 15, fq = lane >> 4;
    const int K = g.K, nt = K / BK;
    unsigned voffA[2], voffB[2];
#pragma unroll
    for (int i = 0; i < 2; ++i) { int R, C; stage_rc(tid * 16 + i * 8192, R, C); const int Rb = Epi::PERM ? ((R & ~31) + perm32(R & 31)) : R;
        voffA[i] = (unsigned)(R * K + C) * 2u; voffB[i] = (unsigned)(Rb * K + C) * 2u; }
    const size_t kstep = (size_t)(BK * 2);
    const size_t hstep = (size_t)HALF * K * 2;
    const size_t tstep = 2 * hstep;
    const unsigned ldsw = (unsigned)wid * 1024u;
    const int aoff = lds_byte(wr * 64 + fr, fq * 8), boff = lds_byte(wc * 32 + fr, fq * 8);
#define PG8_SA(b, h) (((b) * 2 + (h)) * HTB)
#define PG8_SB(b, h) ((4 + (b) * 2 + (h)) * HTB)
#define PG8_STAGE(bufoff, gbase, voff) do { _Pragma("unroll") for (int _i = 0; _i < 2; ++_i) \
        __builtin_amdgcn_global_load_lds((const unsigned*)((const char*)(gbase) + (voff)[_i]), (PG8_LAS unsigned*)(lds + (bufoff) + ldsw + _i * 8192), 16, 0, 0); } while (0)
#define PG8_LDA(dst, b, h) do { _Pragma("unroll") for (int m = 0; m < 4; ++m) _Pragma("unroll") for (int k = 0; k < 2; ++k) dst[m][k] = *(const PG8_LAS bf16x8*)(lds + PG8_SA(b, h) + aoff + m * 2048 + k * 1024); } while (0)
#define PG8_LDB(dst, b, h) do { _Pragma("unroll") for (int n = 0; n < 2; ++n) _Pragma("unroll") for (int k = 0; k < 2; ++k) dst[n][k] = *(const PG8_LAS bf16x8*)(lds + PG8_SB(b, h) + boff + n * 2048 + k * 1024); } while (0)
#define PG8_MMA(ai, bj, At, Bt) do { __builtin_amdgcn_s_setprio(1); _Pragma("unroll") for (int m = 0; m < 4; ++m) _Pragma("unroll") for (int n = 0; n < 2; ++n) _Pragma("unroll") for (int k = 0; k < 2; ++k) \
        acc[ai][bj][m][n] = __builtin_amdgcn_mfma_f32_16x16x32_bf16(Bt[n][k], At[m][k], acc[ai][bj][m][n], 0, 0, 0); __builtin_amdgcn_s_setprio(0); } while (0)
#define PG8_WAIT_V(n) asm volatile("s_waitcnt vmcnt(" #n ")" ::: "memory")
#define PG8_WAIT_L(n) asm volatile("s_waitcnt lgkmcnt(" #n ")" ::: "memory")
#define PG8_BAR __builtin_amdgcn_s_barrier()
#define PG8_SCHED __builtin_amdgcn_sched_barrier(0)
    Unit cur, nxt; int ui = 0;
    if (!S.next(0, cur)) return;
    f32x4 acc[2][2][4][2];
#pragma unroll
    for (int a = 0; a < 2; ++a)
#pragma unroll
        for (int b = 0; b < 2; ++b)
#pragma unroll
            for (int m = 0; m < 4; ++m)
#pragma unroll
                for (int n = 0; n < 2; ++n) acc[a][b][m][n] = (f32x4){0.f, 0.f, 0.f, 0.f};
    bf16x8 At[4][2], B0[2][2], B1[2][2];
    const char* cA = (const char*)g.A + (size_t)cur.pm * tstep; const char* cB = (const char*)g.Bt + (size_t)cur.pn * tstep;
    S.a_ready(cur);
    if constexpr (SP2) {
        PG8_STAGE(PG8_SB(0, 0), cB, voffB); PG8_STAGE(PG8_SB(0, 1), cB + hstep, voffB); PG8_STAGE(PG8_SA(0, 0), cA, voffA); PG8_STAGE(PG8_SA(0, 1), cA + hstep, voffA);
        if (wr == 1) PG8_BAR;
        PG8_WAIT_V(2); PG8_BAR;
        PG8_STAGE(PG8_SB(1, 0), cB + kstep, voffB); PG8_STAGE(PG8_SA(1, 0), cA + kstep, voffA); PG8_STAGE(PG8_SB(1, 1), cB + hstep + kstep, voffB);
        PG8_WAIT_V(6); PG8_BAR;
    } else {
        PG8_STAGE(PG8_SB(0, 0), cB, voffB); PG8_STAGE(PG8_SA(0, 0), cA, voffA); PG8_STAGE(PG8_SB(0, 1), cB + hstep, voffB); PG8_STAGE(PG8_SA(0, 1), cA + hstep, voffA);
        if (wr == 1) PG8_BAR;
        PG8_WAIT_V(4); PG8_BAR;
        PG8_STAGE(PG8_SB(1, 0), cB + kstep, voffB); PG8_STAGE(PG8_SA(1, 0), cA + kstep, voffA); PG8_STAGE(PG8_SB(1, 1), cB + hstep + kstep, voffB);
        PG8_WAIT_V(6); PG8_BAR;
    }
    for (;;) {
        const bool has_next = S.next(ui + 1, nxt);
        const char* nA = has_next ? (const char*)g.A + (size_t)nxt.pm * tstep : cA; const char* nB = has_next ? (const char*)g.Bt + (size_t)nxt.pn * tstep : cB;
        for (int t = 0; t < nt; t += 2) {
            const bool last = (t == nt - 2);
            const char* a1 = cA + (size_t)(t + 1) * kstep;
            const char* a2 = last ? nA : cA + (size_t)(t + 2) * kstep; const char* b2 = last ? nB : cB + (size_t)(t + 2) * kstep;
            const char* a3 = a2 + kstep; const char* b3 = b2 + kstep;
            if (last && has_next) S.a_ready(nxt);
            if constexpr (SP2) {
            PG8_LDB(B0, 0, 0); PG8_LDB(B1, 0, 1); PG8_SCHED; PG8_LDA(At, 0, 0); PG8_STAGE(PG8_SA(1, 1), a1 + hstep, voffA);
            PG8_WAIT_V(8); PG8_WAIT_L(0); PG8_BAR; PG8_MMA(0, 0, At, B0); PG8_MMA(0, 1, At, B1); PG8_BAR; PG8_SCHED;
            PG8_LDA(At, 0, 1); PG8_STAGE(PG8_SB(0, 0), b2, voffB); PG8_STAGE(PG8_SB(0, 1), b2 + hstep, voffB); PG8_STAGE(PG8_SA(0, 0), a2, voffA);
            PG8_WAIT_V(8); PG8_WAIT_L(0); PG8_BAR; PG8_MMA(1, 0, At, B0); PG8_MMA(1, 1, At, B1); PG8_BAR; PG8_SCHED;
            PG8_LDB(B0, 1, 0); PG8_LDB(B1, 1, 1); PG8_SCHED; PG8_LDA(At, 1, 0); PG8_STAGE(PG8_SA(0, 1), a2 + hstep, voffA);
            PG8_WAIT_V(8); PG8_WAIT_L(0); PG8_BAR; PG8_MMA(0, 0, At, B0); PG8_MMA(0, 1, At, B1); PG8_BAR; PG8_SCHED;
            PG8_LDA(At, 1, 1); PG8_STAGE(PG8_SB(1, 0), b3, voffB); PG8_STAGE(PG8_SB(1, 1), b3 + hstep, voffB); PG8_STAGE(PG8_SA(1, 0), a3, voffA);
            PG8_WAIT_V(8); PG8_WAIT_L(0); PG8_BAR; PG8_MMA(1, 0, At, B0); PG8_MMA(1, 1, At, B1); PG8_BAR; PG8_SCHED;
            } else {
            PG8_LDB(B0, 0, 0); PG8_SCHED; PG8_LDA(At, 0, 0); PG8_STAGE(PG8_SA(1, 1), a1 + hstep, voffA);
            PG8_WAIT_L(8); PG8_BAR; PG8_WAIT_L(0); PG8_MMA(0, 0, At, B0); PG8_BAR; PG8_SCHED;
            PG8_LDB(B1, 0, 1); PG8_STAGE(PG8_SB(0, 0), b2, voffB);
            PG8_BAR; PG8_WAIT_L(0); PG8_MMA(0, 1, At, B1); PG8_BAR;
            PG8_LDA(At, 0, 1); PG8_STAGE(PG8_SA(0, 0), a2, voffA);
            PG8_BAR; PG8_WAIT_L(0); PG8_MMA(1, 0, At, B0); PG8_BAR; PG8_SCHED;
            PG8_STAGE(PG8_SB(0, 1), b2 + hstep, voffB);
            PG8_WAIT_V(6); PG8_BAR; PG8_MMA(1, 1, At, B1); PG8_BAR;
            PG8_LDB(B0, 1, 0); PG8_SCHED; PG8_LDA(At, 1, 0); PG8_STAGE(PG8_SA(0, 1), a2 + hstep, voffA);
            PG8_WAIT_L(8); PG8_BAR; PG8_WAIT_L(0); PG8_MMA(0, 0, At, B0); PG8_BAR; PG8_SCHED;
            PG8_LDB(B1, 1, 1); PG8_STAGE(PG8_SB(1, 0), b3, voffB);
            PG8_BAR; PG8_WAIT_L(0); PG8_MMA(0, 1, At, B1); PG8_BAR;
            PG8_LDA(At, 1, 1); PG8_STAGE(PG8_SA(1, 0), a3, voffA);
            PG8_BAR; PG8_WAIT_L(0); PG8_MMA(1, 0, At, B0); PG8_BAR; PG8_SCHED;
            PG8_STAGE(PG8_SB(1, 1), b3 + hstep, voffB);
            PG8_WAIT_V(6); PG8_BAR; PG8_MMA(1, 1, At, B1); PG8_BAR;
            }
        }
        if constexpr (ALIGN_EPI) { if (wr == 0) PG8_BAR; }
        if constexpr (!Epi::AFTER_DRAIN) { E(acc, cur, wr, wc, fr, fq); S.done(cur); }
        if (!has_next) break;
#pragma unroll
        for (int a = 0; a < 2; ++a)
#pragma unroll
            for (int b = 0; b < 2; ++b)
#pragma unroll
                for (int m = 0; m < 4; ++m)
#pragma unroll
                    for (int n = 0; n < 2; ++n) acc[a][b][m][n] = (f32x4){0.f, 0.f, 0.f, 0.f};
        cur = nxt; cA = nA; cB = nB; ++ui;
        if constexpr (ALIGN_EPI) { if (wr == 1) PG8_BAR; }
    }
    PG8_WAIT_V(0);
    if constexpr (!ALIGN_EPI) { if (wr == 0) PG8_BAR; }
    PG8_BAR;
    if constexpr (Epi::AFTER_DRAIN) { E.fused(acc, cur, wr, wc, fr, fq, lds, wid, lane); S.done(cur); }
#undef PG8_SA
#undef PG8_SB
#undef PG8_STAGE
#undef PG8_LDA
#undef PG8_LDB
#undef PG8_MMA
#undef PG8_WAIT_V
#undef PG8_WAIT_L
#undef PG8_BAR
#undef PG8_SCHED
}
}
#define GAS __attribute__((address_space(1)))
#define LAS __attribute__((address_space(3)))
typedef unsigned short bf16;
typedef unsigned v4u __attribute__((ext_vector_type(4)));
typedef unsigned v2u __attribute__((ext_vector_type(2)));
typedef float f32x4 __attribute__((ext_vector_type(4)));
typedef short bf16x8 __attribute__((ext_vector_type(8)));
#ifndef REP_HG
#define REP_HG 1
#endif
#ifndef REP_RW
#define REP_RW 1
#endif
#ifndef REP_UP
#define REP_UP 1
#endif
#ifndef REP_ATT
#define REP_ATT 1
#endif
#ifndef REP_PRO
#define REP_PRO 1
#endif
#ifndef REP_G1
#define REP_G1 1
#endif
#ifndef REP_G2
#define REP_G2 1
#endif
#ifndef REP_SC
#define REP_SC 1
#endif
#ifndef REP_DN
#define REP_DN 1
#endif
#ifndef REP_OUT
#define REP_OUT 1
#endif
#ifndef REP_HGL
#define REP_HGL 1
#endif
#ifndef REP_IN
#define REP_IN 1
#endif
#ifndef REP_SYNC
#define REP_SYNC 1
#endif
#define GRID_SYNC() do { for (int r_ = 0; r_ < REP_SYNC; ++r_) xcd_barrier(xbar); } while (0)
constexpr int NWAVES = 8, NTHR = 512;
constexpr int M = 32768, D = 1024, SEQ = 8192, FF = 4096;
constexpr size_t MiB = 1u << 20;
constexpr size_t WS_BAR = 64 * 1024, WS_BAR_BYTES = 16 * 1024;
constexpr size_t WS_LBK = 0;
constexpr size_t WS_RS = 1 * MiB;
constexpr size_t WS_WA = 4 * MiB, WS_WB = 18 * MiB, WS_WO = 20 * MiB, WS_WUP = 22 * MiB, WS_WDN = 30 * MiB;
constexpr size_t WS_HB = 38 * MiB;
constexpr size_t WS_BIG = 102 * MiB;
constexpr size_t SLOT = 64 * MiB;
constexpr size_t WS_END = 512 * MiB;
constexpr int LDS_BYTES = 163840;
constexpr float LOG2E_F = 1.4426950408889634f;

#define LDS_WAIT() asm volatile("s_waitcnt lgkmcnt(0)" ::: "memory")
typedef float f32x2_t __attribute__((ext_vector_type(2))); typedef __bf16 bf16x2_t __attribute__((ext_vector_type(2)));
__device__ __forceinline__ unsigned pk2(float lo, float hi) { const f32x2_t v = {lo, hi}; const bf16x2_t b = __builtin_convertvector(v, bf16x2_t); return __builtin_bit_cast(unsigned, b); }
__device__ __forceinline__ unsigned f2bf(float f) { return pk2(f, 0.f) & 0xffffu; }
__device__ __forceinline__ float bflo(unsigned u) { return __builtin_bit_cast(float, u << 16); }
__device__ __forceinline__ float bfhi(unsigned u) { return __builtin_bit_cast(float, u & 0xffff0000u); }
__device__ __forceinline__ float bf1(unsigned short b) { return __builtin_bit_cast(float, (unsigned)b << 16); }
__device__ __forceinline__ f32x4 bf4(v2u u) { return (f32x4){bflo(u.x), bfhi(u.x), bflo(u.y), bfhi(u.y)}; }
__device__ __forceinline__ float wave_sum(float v) {
#pragma unroll
    for (int o = 1; o < 64; o <<= 1) v += __shfl_xor(v, o);
    return v;
}
template <int CTRL> __device__ __forceinline__ float dpp_f(float x) { return __builtin_bit_cast(float, __builtin_amdgcn_update_dpp(0, __builtin_bit_cast(int, x), CTRL, 0xf, 0xf, true)); }
__device__ __forceinline__ float row16_sum(float x) { x += dpp_f<0xB1>(x); x += dpp_f<0x4E>(x); x += dpp_f<0x141>(x); x += dpp_f<0x140>(x); return x; }

__device__ __forceinline__ void wt_item(const float* W, int K, int N, bf16* WT, int ld, int row_off, int col_off, const float* sc, LAS float* scr, int item, int lane) {
    const int nblk = N / 32, kb = item / nblk, nb = item % nblk, k0 = 64 * kb, n0 = 32 * nb;
    f32x4 wv[8]; float sv[8];
#pragma unroll
    for (int i = 0; i < 8; ++i) { const int kk = 8 * i + (lane >> 3); wv[i] = *(const f32x4*)(W + (size_t)(k0 + kk) * N + n0 + 4 * (lane & 7)); sv[i] = sc ? sc[k0 + kk] : 1.f; }
#pragma unroll
    for (int i = 0; i < 8; ++i) { const int kk = 8 * i + (lane >> 3); LAS float* d = scr + kk * 33 + 4 * (lane & 7); d[0] = wv[i][0] * sv[i]; d[1] = wv[i][1] * sv[i]; d[2] = wv[i][2] * sv[i]; d[3] = wv[i][3] * sv[i]; }
    LDS_WAIT(); asm volatile("" ::: "memory");
    const int c = lane & 7;
#pragma unroll
    for (int j = 0; j < 4; ++j) { const int n = (lane >> 3) + 8 * j; const LAS float* s = scr + (8 * c) * 33 + n;
        v4u o; o.x = pk2(s[0 * 33], s[1 * 33]); o.y = pk2(s[2 * 33], s[3 * 33]); o.z = pk2(s[4 * 33], s[5 * 33]); o.w = pk2(s[6 * 33], s[7 * 33]);
        *(v4u*)(WT + (size_t)(row_off + n0 + n) * ld + col_off + k0 + 8 * c) = o; }
    LDS_WAIT(); asm volatile("" ::: "memory");
}
__device__ __forceinline__ void conv_mat(const float* W, int K, int N, bf16* WT, int ld, int row_off, int col_off, const float* sc, LAS float* scr, int gw, int ngw, int lane) {
    const int nitems = (K / 64) * (N / 32);
    for (int it = gw; it < nitems; it += ngw) wt_item(W, K, N, WT, ld, row_off, col_off, sc, scr, it, lane);
}

__device__ __forceinline__ void attn_phase(const bf16* Q, const bf16* K, const bf16* V, bf16* O, int gw, int ngw, int lane) {
    const int fr = lane & 15, fq = lane >> 4;
    for (int unit = gw; unit < (M / 16) * 16; unit += ngw) {
        const int qt = unit & 511, bh = unit >> 9, h = bh & 15, b = bh >> 4;
        const int t0 = qt * 16; const size_t rowb = (size_t)b * SEQ;
        const bf16* qp = Q + (rowb + t0 + fr) * 1024 + h * 64 + fq * 8;
        const bf16x8 qb0 = *(const bf16x8*)(qp), qb1 = *(const bf16x8*)(qp + 32);
        f32x4 o[4];
#pragma unroll
        for (int dt = 0; dt < 4; ++dt) o[dt] = (f32x4){0.f, 0.f, 0.f, 0.f};
        float carry = 1.f;
        const int tq = t0 + fr;
        bf16x8 kn0, kn1; unsigned short vn[4][4];
#define ATT_LOAD(SH) { int sk_ = (SH) - fr; sk_ = sk_ < 0 ? 0 : sk_; const bf16* kp_ = K + (rowb + sk_) * 1024 + h * 64 + fq * 8; kn0 = *(const bf16x8*)(kp_); kn1 = *(const bf16x8*)(kp_ + 32); \
            _Pragma("unroll") for (int j = 0; j < 4; ++j) { int sv_ = (SH) - (4 * fq + j); sv_ = sv_ < 0 ? 0 : sv_; const bf16* vp_ = V + (rowb + sv_) * 1024 + h * 64 + fr; \
                _Pragma("unroll") for (int dt = 0; dt < 4; ++dt) vn[dt][j] = vp_[16 * dt]; } }
        ATT_LOAD(t0 + 14)
        for (int s_hi = t0 + 14; s_hi >= 0; s_hi -= 16) {
            const bf16x8 ka0 = kn0, ka1 = kn1;
            unsigned short vv[4][4];
#pragma unroll
            for (int j = 0; j < 4; ++j)
#pragma unroll
                for (int dt = 0; dt < 4; ++dt) vv[dt][j] = vn[dt][j];
            ATT_LOAD(s_hi - 16)
            f32x4 z = (f32x4){0.f, 0.f, 0.f, 0.f};
            z = __builtin_amdgcn_mfma_f32_16x16x32_bf16(ka0, qb0, z, 0, 0, 0);
            z = __builtin_amdgcn_mfma_f32_16x16x32_bf16(ka1, qb1, z, 0, 0, 0);
            float dd[4], sg[4];
#pragma unroll
            for (int i = 0; i < 4; ++i) {
                const int s = s_hi - (4 * fq + i);
                const bool valid = (s >= 0) && (s < tq);
                const float e = __builtin_amdgcn_exp2f(fminf(z[i], 100.f));
                const float d = __builtin_amdgcn_rcpf(1.0f + e);
                dd[i] = valid ? d : 1.f; sg[i] = valid ? e * d : 0.f;
            }
            const float c1 = dd[0], c2 = c1 * dd[1], c3 = c2 * dd[2], g = c3 * dd[3];
            const float g0 = __shfl(g, fr), g1 = __shfl(g, fr + 16), g2 = __shfl(g, fr + 32), g3 = __shfl(g, fr + 48);
            float pre = carry;
            if (fq > 0) pre *= g0;
            if (fq > 1) pre *= g1;
            if (fq > 2) pre *= g2;
            carry = carry * ((g0 * g1) * (g2 * g3));
            const float p0 = sg[0] * pre, p1 = sg[1] * (pre * c1), p2 = sg[2] * (pre * c2), p3 = sg[3] * (pre * c3);
            bf16x8 pb; { const unsigned w0 = pk2(p0, p1), w1 = pk2(p2, p3); pb[0] = (short)(w0 & 0xffff); pb[1] = (short)(w0 >> 16); pb[2] = (short)(w1 & 0xffff); pb[3] = (short)(w1 >> 16); pb[4] = 0; pb[5] = 0; pb[6] = 0; pb[7] = 0; }
#pragma unroll
            for (int dt = 0; dt < 4; ++dt) {
                bf16x8 va; va[0] = (short)vv[dt][0]; va[1] = (short)vv[dt][1]; va[2] = (short)vv[dt][2]; va[3] = (short)vv[dt][3]; va[4] = 0; va[5] = 0; va[6] = 0; va[7] = 0;
                o[dt] = __builtin_amdgcn_mfma_f32_16x16x32_bf16(va, pb, o[dt], 0, 0, 0);
            }
            if (__builtin_amdgcn_ballot_w64(carry != 0.f) == 0ull) break;
        }
#undef ATT_LOAD
        bf16* op = O + (rowb + t0 + fr) * 1024 + h * 64 + fq * 4;
#pragma unroll
        for (int dt = 0; dt < 4; ++dt) { v2u w; w.x = pk2(o[dt][0], o[dt][1]); w.y = pk2(o[dt][2], o[dt][3]); *(v2u*)(op + 16 * dt) = w; }
    }
}

typedef unsigned u32x4_t __attribute__((ext_vector_type(4)));
__device__ __forceinline__ bf16x8 mk8(unsigned a, unsigned b, unsigned c, unsigned d) { const u32x4_t t = {a, b, c, d}; return __builtin_bit_cast(bf16x8, t); }
__device__ __forceinline__ void hg_prep_item(const bf16* QS, const bf16* KF, bf16* QTL, bf16* KTLb, bf16* KT, float* DB, int chunk, int c) {
    {
        const size_t base = (size_t)chunk * 16 * 1024 + c;
        v2u kin[16], qin[16];
#pragma unroll
        for (int t = 0; t < 16; ++t) { kin[t] = *(const v2u*)(KF + base + (size_t)t * 1024); qin[t] = *(const v2u*)(QS + base + (size_t)t * 1024); }
        float b[4] = {0.f, 0.f, 0.f, 0.f};
        unsigned ktp[4][8];
#pragma unroll
        for (int t2 = 0; t2 < 8; ++t2) {
            float kt2[2][4];
#pragma unroll
            for (int u = 0; u < 2; ++u) {
                const int t = 2 * t2 + u;
                const f32x4 kf = bf4(kin[t]), q = bf4(qin[t]);
                float qt[4];
#pragma unroll
                for (int j = 0; j < 4; ++j) {
                    const float fdec = fmaxf(1.0f - kf[j], 1e-4f);
                    b[j] += __builtin_amdgcn_logf(fdec);
                    const float e = __builtin_amdgcn_exp2f(b[j]);
                    qt[j] = q[j] * e; kt2[u][j] = kf[j] * __builtin_amdgcn_rcpf(e);
                }
                const size_t tof = ((((size_t)chunk * 8 + (c >> 7)) * 8 + ((c & 127) >> 4)) * 16 + t) * 16 + (c & 15);
                v2u qo; qo.x = pk2(qt[0], qt[1]); qo.y = pk2(qt[2], qt[3]); *(v2u*)(QTL + tof) = qo;
                v2u ko; ko.x = pk2(kt2[u][0], kt2[u][1]); ko.y = pk2(kt2[u][2], kt2[u][3]); *(v2u*)(KTLb + tof) = ko;
            }
#pragma unroll
            for (int j = 0; j < 4; ++j) ktp[j][t2] = pk2(kt2[0][j], kt2[1][j]);
        }
        f32x4 dv; dv[0] = __builtin_amdgcn_exp2f(b[0]); dv[1] = __builtin_amdgcn_exp2f(b[1]); dv[2] = __builtin_amdgcn_exp2f(b[2]); dv[3] = __builtin_amdgcn_exp2f(b[3]);
        *(f32x4*)(DB + (size_t)chunk * 1024 + c) = dv;
#pragma unroll
        for (int j = 0; j < 4; ++j) { v4u* kp = (v4u*)(KT + ((size_t)chunk * 1024 + c + j) * 16);
            kp[0] = (v4u){ktp[j][0], ktp[j][1], ktp[j][2], ktp[j][3]}; kp[1] = (v4u){ktp[j][4], ktp[j][5], ktp[j][6], ktp[j][7]}; }
    }
}
__device__ __forceinline__ void hg_local(const bf16* QS, const bf16* KF, bf16* QTL, bf16* KTLb, bf16* KT, const bf16* IV, float* DB, float* SL, float* DT) {
    int tid_ = threadIdx.x; asm volatile("" : "+v"(tid_)); const int tid = tid_, lane = tid & 63, w = __builtin_amdgcn_readfirstlane(tid >> 6), fr = lane & 15, fq = lane >> 4;
    for (int unit = blockIdx.x; unit < 256; unit += gridDim.x) {
        const int seg = unit & 7, bh = unit >> 3, h = bh & 7, b = bh >> 3;
#pragma unroll 1
        for (int ps = 0; ps < 4; ++ps) hg_prep_item(QS, KF, QTL, KTLb, KT, DB, (int)((((size_t)b * SEQ + (size_t)seg * 1024) >> 4) + 16 * ps + 2 * w + (lane >> 5)), 128 * h + 4 * (lane & 31));
        asm volatile("s_waitcnt vmcnt(0)" ::: "memory"); __syncthreads();
        if (seg == 7) continue;
        f32x4 S[8], DTt[8];
#pragma unroll
        for (int kt = 0; kt < 8; ++kt) { S[kt] = (f32x4){0.f, 0.f, 0.f, 0.f}; DTt[kt] = (f32x4){1.f, 1.f, 1.f, 1.f}; }
        const size_t m0 = (size_t)b * SEQ + (size_t)seg * 1024;
        v2u kt1[8], kt2[8]; f32x4 d1[8], d2[8]; unsigned short v1_[4], v2_[4];
#define HGL_LOAD(KTV, DV, VV, CJ) { const int cj_ = (CJ) < 64 ? (CJ) : 63; const size_t chunk_ = (m0 >> 4) + cj_, mrow_ = m0 + 16 * cj_; \
          _Pragma("unroll") for (int kt = 0; kt < 8; ++kt) { KTV[kt] = *(const v2u*)(KT + (chunk_ * 1024 + 128 * h + 16 * kt + fr) * 16 + 4 * fq); DV[kt] = *(const f32x4*)(DB + chunk_ * 1024 + 128 * h + 16 * kt + 4 * fq); } \
          const bf16* vp_ = IV + (mrow_ + 4 * fq) * 1024 + 128 * h + 16 * w + fr; VV[0] = vp_[0]; VV[1] = vp_[1024]; VV[2] = vp_[2048]; VV[3] = vp_[3072]; }
        HGL_LOAD(kt1, d1, v1_, 0) HGL_LOAD(kt2, d2, v2_, 1)
        for (int ci = 0; ci < 64; ++ci) {
            v2u ktv[8]; f32x4 dv[8];
#pragma unroll
            for (int kt = 0; kt < 8; ++kt) { ktv[kt] = kt1[kt]; dv[kt] = d1[kt]; kt1[kt] = kt2[kt]; d1[kt] = d2[kt]; }
            const unsigned v0 = v1_[0], v1 = v1_[1], v2 = v1_[2], v3 = v1_[3];
#pragma unroll
            for (int x = 0; x < 4; ++x) v1_[x] = v2_[x];
            HGL_LOAD(kt2, d2, v2_, ci + 2)
            const bf16x8 vb = mk8(v0 | (v1 << 16), v2 | (v3 << 16), 0u, 0u);
#pragma unroll
            for (int kt = 0; kt < 8; ++kt) { S[kt] = __builtin_amdgcn_mfma_f32_16x16x32_bf16(mk8(ktv[kt].x, ktv[kt].y, 0u, 0u), vb, S[kt], 0, 0, 0); S[kt] = S[kt] * dv[kt]; DTt[kt] = DTt[kt] * dv[kt]; }
        }
#undef HGL_LOAD
#pragma unroll
        for (int kt = 0; kt < 8; ++kt) {
#pragma unroll
            for (int i = 0; i < 4; ++i) SL[((size_t)(bh * 8 + seg) * 128 + 16 * kt + 4 * fq + i) * 128 + 16 * w + fr] = S[kt][i];
            if (w == 0 && fr == 0) *(f32x4*)(DT + (size_t)(bh * 8 + seg) * 128 + 16 * kt + 4 * fq) = DTt[kt];
        }
    }
}
__device__ __forceinline__ void hg_out(const bf16* QT, const bf16* KTL, const bf16* KT, const bf16* IV, const float* DB, const float* SL, const float* DT, const float* norm_g, bf16* SGO, LAS unsigned char* lds) {
    int tid_ = threadIdx.x; asm volatile("" : "+v"(tid_)); const int tid = tid_, lane = tid & 63, w = __builtin_amdgcn_readfirstlane(tid >> 6), fr = lane & 15, fq = lane >> 4;
    LAS float* ssb = (LAS float*)lds;
    for (int unit = blockIdx.x; unit < 256; unit += gridDim.x) {
        const int seg = unit & 7, bh = unit >> 3, h = bh & 7, b = bh >> 3;
        f32x4 S[8];
#pragma unroll
        for (int kt = 0; kt < 8; ++kt) S[kt] = (f32x4){0.f, 0.f, 0.f, 0.f};
        for (int j = 0; j < seg; ++j) {
#pragma unroll
            for (int kt = 0; kt < 8; ++kt) {
                const f32x4 dt = *(const f32x4*)(DT + (size_t)(bh * 8 + j) * 128 + 16 * kt + 4 * fq);
#pragma unroll
                for (int i = 0; i < 4; ++i) S[kt][i] = S[kt][i] * dt[i] + SL[((size_t)(bh * 8 + j) * 128 + 16 * kt + 4 * fq + i) * 128 + 16 * w + fr];
            }
        }
        const float ng = norm_g[128 * h + 16 * w + fr];
        const size_t m0 = (size_t)b * SEQ + (size_t)seg * 1024;
        v2u qn[8], kn[8];
        { const size_t tb_ = (((m0 >> 4) * 8 + h) * 8) * 256 + fr * 16 + 4 * fq; const bf16* qp = QT + tb_; const bf16* kp = KTL + tb_;
#pragma unroll
          for (int x = 0; x < 8; ++x) { qn[x] = *(const v2u*)(qp + 256 * x); kn[x] = *(const v2u*)(kp + 256 * x); } }
        unsigned short vn[4], gn[4];
        { const bf16* vp = IV + (m0 + 4 * fq) * 1024 + 128 * h + 16 * w + fr; const bf16* gq = SGO + (m0 + 4 * fq) * 1024 + 128 * h + 16 * w + fr;
          vn[0] = vp[0]; vn[1] = vp[1024]; vn[2] = vp[2048]; vn[3] = vp[3072]; gn[0] = gq[0]; gn[1] = gq[1024]; gn[2] = gq[2048]; gn[3] = gq[3072]; }
        for (int ci = 0; ci < 64; ++ci) {
            const size_t chunk = (m0 >> 4) + ci, mrow = m0 + 16 * ci;
            v2u ktv[8]; f32x4 dv[8];
#pragma unroll
            for (int kt = 0; kt < 8; ++kt) { ktv[kt] = *(const v2u*)(KT + (chunk * 1024 + 128 * h + 16 * kt + fr) * 16 + 4 * fq); dv[kt] = *(const f32x4*)(DB + chunk * 1024 + 128 * h + 16 * kt + 4 * fq); }
            const unsigned v0 = vn[0], v1 = vn[1], v2 = vn[2], v3 = vn[3];
            bf16* gp = SGO + (mrow + 4 * fq) * 1024 + 128 * h + 16 * w + fr;
            const float sg0 = bf1(gn[0]), sg1 = bf1(gn[1]), sg2 = bf1(gn[2]), sg3 = bf1(gn[3]);
            { const size_t mn = m0 + 16 * (ci + 1 < 64 ? ci + 1 : ci); const bf16* vp = IV + (mn + 4 * fq) * 1024 + 128 * h + 16 * w + fr; const bf16* gq = SGO + (mn + 4 * fq) * 1024 + 128 * h + 16 * w + fr;
              if (ci + 1 < 64) { vn[0] = vp[0]; vn[1] = vp[1024]; vn[2] = vp[2048]; vn[3] = vp[3072]; gn[0] = gq[0]; gn[1] = gq[1024]; gn[2] = gq[2048]; gn[3] = gq[3072]; } }
            v2u qc[8], kc[8];
#pragma unroll
            for (int x = 0; x < 8; ++x) { qc[x] = qn[x]; kc[x] = kn[x]; }
            { const size_t mn = m0 + 16 * (ci + 1 < 64 ? ci + 1 : ci); const size_t tb_ = (((mn >> 4) * 8 + h) * 8) * 256 + fr * 16 + 4 * fq; const bf16* qp = QT + tb_; const bf16* kp = KTL + tb_;
#pragma unroll
              for (int x = 0; x < 8; ++x) { qn[x] = *(const v2u*)(qp + 256 * x); kn[x] = *(const v2u*)(kp + 256 * x); } }
            const bf16x8 vb = mk8(v0 | (v1 << 16), v2 | (v3 << 16), 0u, 0u);
            f32x4 pt = (f32x4){0.f, 0.f, 0.f, 0.f};
#pragma unroll
            for (int p = 0; p < 4; ++p) pt = __builtin_amdgcn_mfma_f32_16x16x32_bf16(mk8(kc[2 * p].x, kc[2 * p].y, kc[2 * p + 1].x, kc[2 * p + 1].y), mk8(qc[2 * p].x, qc[2 * p].y, qc[2 * p + 1].x, qc[2 * p + 1].y), pt, 0, 0, 0);
#pragma unroll
            for (int i = 0; i < 4; ++i) if (4 * fq + i > fr) pt[i] = 0.f;
            f32x4 o = (f32x4){0.f, 0.f, 0.f, 0.f};
#pragma unroll
            for (int p = 0; p < 4; ++p) {
                const bf16x8 sb = mk8(pk2(S[2 * p][0], S[2 * p][1]), pk2(S[2 * p][2], S[2 * p][3]), pk2(S[2 * p + 1][0], S[2 * p + 1][1]), pk2(S[2 * p + 1][2], S[2 * p + 1][3]));
                o = __builtin_amdgcn_mfma_f32_16x16x32_bf16(mk8(qc[2 * p].x, qc[2 * p].y, qc[2 * p + 1].x, qc[2 * p + 1].y), sb, o, 0, 0, 0);
            }
            o = __builtin_amdgcn_mfma_f32_16x16x32_bf16(mk8(pk2(pt[0], pt[1]), pk2(pt[2], pt[3]), 0u, 0u), vb, o, 0, 0, 0);
#pragma unroll
            for (int kt = 0; kt < 8; ++kt) { S[kt] = __builtin_amdgcn_mfma_f32_16x16x32_bf16(mk8(ktv[kt].x, ktv[kt].y, 0u, 0u), vb, S[kt], 0, 0, 0); S[kt] = S[kt] * dv[kt]; }
            LAS float* sb_ = ssb + (ci & 1) * 128;
#pragma unroll
            for (int i = 0; i < 4; ++i) { const float ss = row16_sum(o[i] * o[i]); if (fr == 0) sb_[(4 * fq + i) * 8 + w] = ss; }
            __syncthreads();
            const float sgv[4] = {sg0, sg1, sg2, sg3};
#pragma unroll
            for (int i = 0; i < 4; ++i) {
                const f32x4 a0 = *(const LAS f32x4*)(sb_ + (4 * fq + i) * 8), a1 = *(const LAS f32x4*)(sb_ + (4 * fq + i) * 8 + 4);
                const float tot = ((a0[0] + a0[1]) + (a0[2] + a0[3])) + ((a1[0] + a1[1]) + (a1[2] + a1[3]));
                const float r = 1.0f / sqrtf(tot * (1.0f / 128.0f) + 1e-6f);
                gp[(size_t)i * 1024] = (bf16)f2bf(o[i] * r * ng * sgv[i]);
            }
        }
        __syncthreads();
    }
}

__device__ __forceinline__ void rw_prep(const bf16* h, const float* rs, const float* g, bf16* A2, int gw, int ngw, int lane) {
    for (int it = gw; it < M / 2; it += ngw) {
        const int m = 2 * it, t = m & (SEQ - 1);
        const int mp = t ? m - 1 : m;
        f32x4 x[3][4], pr[3];
#pragma unroll
        for (int u = 0; u < 3; ++u) { const int mm = u == 0 ? mp : m + u - 1; pr[u] = *(const f32x4*)(rs + (size_t)mm * 16 + 4 * (lane & 3));
#pragma unroll
            for (int j = 0; j < 4; ++j) x[u][j] = bf4(*(const v2u*)(h + (size_t)mm * 1024 + 4 * lane + 256 * j)); }
        float r3[3];
#pragma unroll
        for (int u = 0; u < 3; ++u) { float s = (pr[u][0] + pr[u][1]) + (pr[u][2] + pr[u][3]); s += dpp_f<0xB1>(s); s += dpp_f<0x4E>(s); r3[u] = 1.0f / sqrtf(s * (1.0f / 1024.0f) + 1e-6f); }
        if (t == 0) r3[0] = 0.f;
#pragma unroll
        for (int j = 0; j < 4; ++j) {
            const int c = 4 * lane + 256 * j;
            const f32x4 gc = *(const f32x4*)(g + c);
            const f32x4 xp = x[0][j] * gc * r3[0], x0 = x[1][j] * gc * r3[1], x1 = x[2][j] * gc * r3[2];
            const f32x4 d0 = xp - x0, d1 = x0 - x1;
            v2u o;
            o.x = pk2(x0[0], x0[1]); o.y = pk2(x0[2], x0[3]); *(v2u*)(A2 + (size_t)m * 2048 + c) = o;
            o.x = pk2(d0[0], d0[1]); o.y = pk2(d0[2], d0[3]); *(v2u*)(A2 + (size_t)m * 2048 + 1024 + c) = o;
            o.x = pk2(x1[0], x1[1]); o.y = pk2(x1[2], x1[3]); *(v2u*)(A2 + (size_t)(m + 1) * 2048 + c) = o;
            o.x = pk2(d1[0], d1[1]); o.y = pk2(d1[2], d1[3]); *(v2u*)(A2 + (size_t)(m + 1) * 2048 + 1024 + c) = o;
        }
    }
}
constexpr int RWS_AH = 0, RWS_RB = 2048, RWS_KGT = 4096, RWS_BGT = 6144, RWS_G15 = 8192, RWS_KNI = 8448, RWS_WVI = 9472, RWS_VCI = 10496, RWS_SLOT = 11264;
constexpr int RWT_AB = 0, RWT_BT = 2048, RWT_KT = 4096, RWT_ABT = 6144, RWT_NM = 0  , RWT_TM = 2048  , RWT_BYTES = 8192;
__device__ __forceinline__ int rwz(int k) { return (k & ~7) | ((k & 7) ^ ((k >> 3) & 7)); }
constexpr int RW_NSLOT = 9, RW_NPROD = 7, RW_RING = RW_NSLOT * RWS_SLOT, RW_FLAGS = RW_RING + RW_NPROD * RWT_BYTES;
struct RwRaw4 { v2u r[4], k[4], wm[4], a[4]; unsigned short v[4]; };
__device__ __forceinline__ void rw_load4(RwRaw4& x, const bf16* R, const bf16* K, const bf16* V, const bf16* WM, const bf16* A, size_t m, int ch, int vch) {
#pragma unroll
    for (int j = 0; j < 4; ++j) { const size_t off = (m + j) * 1024 + ch;
        x.r[j] = *(const v2u*)(R + off); x.k[j] = *(const v2u*)(K + off); x.wm[j] = *(const v2u*)(WM + off); x.a[j] = *(const v2u*)(A + off); x.v[j] = V[(m + j) * 1024 + vch]; }
}
__device__ __forceinline__ bf16x8 lds_op16(const LAS unsigned char* mtx, int row, int kbyte) { return *(const LAS bf16x8*)(mtx + row * 128 + kbyte); }
__device__ __forceinline__ v2u lds_8(const LAS unsigned char* p) { return *(const LAS v2u*)p; }
__device__ __forceinline__ void rw_scan(const bf16* R, const bf16* K, const bf16* V, const bf16* WM, const bf16* A, const float* k_k, const float* k_a, bf16* Y, LAS unsigned char* lds) {
    int tid_ = threadIdx.x; asm volatile("" : "+v"(tid_)); const int tid = tid_, lane = tid & 63, w = __builtin_amdgcn_readfirstlane(tid >> 6);
    const int fr = lane & 15, fq = lane >> 4;
    constexpr int NCH = SEQ / 16;
    for (int unit = blockIdx.x; unit < 256; unit += gridDim.x) {
        const int rg = unit & 3, h = (unit >> 2) & 15, b = unit >> 6;
        const size_t row0 = (size_t)b * SEQ;
        volatile LAS unsigned* flg = (volatile LAS unsigned*)(lds + RW_FLAGS);
        if (tid < 16) flg[tid] = 0u;
        __syncthreads();
        if (w >= 1) {
            const int pw = w - 1, ch = 64 * h + 4 * fr, vch = 64 * h + 16 * rg + fr;
            LAS unsigned char* tmp = lds + RW_RING + pw * RWT_BYTES;
            const f32x4 kkc = *(const f32x4*)(k_k + ch), kac = *(const f32x4*)(k_a + ch);
            RwRaw4 nx; rw_load4(nx, R, K, V, WM, A, row0 + 16 * pw + 4 * fq, ch, vch);
            for (int cj = pw; cj < NCH; cj += RW_NPROD) {
                {
                    const RwRaw4 cu = nx;
                    { const int cn = cj + RW_NPROD < NCH ? cj + RW_NPROD : cj; rw_load4(nx, R, K, V, WM, A, row0 + 16 * (size_t)cn + 4 * fq, ch, vch); }
                    while ((int)flg[RW_NSLOT] < cj - (RW_NSLOT - 1)) __builtin_amdgcn_s_sleep(2);
                    asm volatile("" ::: "memory");
                    LAS unsigned char* slot = lds + (cj % RW_NSLOT) * RWS_SLOT;
                    f32x4 wv[4], kk[4], km[4], be[4], rr[4];
#pragma unroll
                    for (int j = 0; j < 4; ++j) {
                        const f32x4 r = bf4(cu.r[j]), k = bf4(cu.k[j]), wm = bf4(cu.wm[j]), a = bf4(cu.a[j]);
                        const f32x4 kr = k * kkc;
                        const float n2 = row16_sum((kr[0] * kr[0] + kr[1] * kr[1]) + (kr[2] * kr[2] + kr[3] * kr[3]));
                        const float inv = 1.0f / fmaxf(sqrtf(n2), 1e-12f);
                        kk[j] = kr * inv; be[j] = kk[j] * a; km[j] = k * (1.0f + (a - 1.0f) * kac); wv[j] = 1.0f - wm; rr[j] = r;
                    }
                    f32x4 g[4]; g[0] = wv[0]; g[1] = g[0] * wv[1]; g[2] = g[1] * wv[2]; g[3] = g[2] * wv[3];
                    f32x4 pre = (f32x4){1.f, 1.f, 1.f, 1.f}, all = (f32x4){1.f, 1.f, 1.f, 1.f};
#pragma unroll
                    for (int x = 0; x < 4; ++x) {
                        const float t0 = __shfl(g[3][x], fr), t1 = __shfl(g[3][x], 16 + fr), t2 = __shfl(g[3][x], 32 + fr), t3 = __shfl(g[3][x], 48 + fr);
                        float p = 1.f; if (fq > 0) p *= t0; if (fq > 1) p *= t1; if (fq > 2) p *= t2;
                        pre[x] = p; all[x] = (t0 * t1) * (t2 * t3);
                    }
                    unsigned kgp[4][2], bgp[4][2], abp[4][2];
                    float kgt[4][4], bgt[4][4], abt[4][4];
#pragma unroll
                    for (int j = 0; j < 4; ++j) {
                        const f32x4 Gs = pre * g[j], Gm = j ? pre * g[j - 1] : pre;
                        f32x4 ginv; ginv[0] = __builtin_amdgcn_rcpf(Gs[0]); ginv[1] = __builtin_amdgcn_rcpf(Gs[1]); ginv[2] = __builtin_amdgcn_rcpf(Gs[2]); ginv[3] = __builtin_amdgcn_rcpf(Gs[3]);
                        const f32x4 alb = kk[j] * Gm, rb = rr[j] * Gs, bet = be[j] * ginv, ktl = km[j] * ginv;
                        const int s = 4 * fq + j;
                        v2u o;
                        o.x = pk2(alb[0], alb[1]); o.y = pk2(alb[2], alb[3]); *(LAS v2u*)(tmp + RWT_AB + s * 128 + 8 * fr) = o;
                        o.x = pk2(bet[0], bet[1]); o.y = pk2(bet[2], bet[3]); *(LAS v2u*)(tmp + RWT_BT + s * 128 + 8 * fr) = o;
                        o.x = pk2(ktl[0], ktl[1]); o.y = pk2(ktl[2], ktl[3]); *(LAS v2u*)(tmp + RWT_KT + s * 128 + 8 * fr) = o;
                        o.x = pk2(rb[0], rb[1]); o.y = pk2(rb[2], rb[3]); *(LAS v2u*)(slot + RWS_RB + s * 128 + 8 * fr) = o;
#pragma unroll
                        for (int x = 0; x < 4; ++x) { kgt[x][j] = ktl[x] * all[x]; bgt[x][j] = -(bet[x] * all[x]); abt[x][j] = alb[x]; }
                    }
#pragma unroll
                    for (int x = 0; x < 4; ++x) {
                        const int kch = 4 * fr + x;
                        v2u o;
                        o.x = pk2(kgt[x][0], kgt[x][1]); o.y = pk2(kgt[x][2], kgt[x][3]); *(LAS v2u*)(slot + RWS_KGT + rwz(kch) * 32 + 8 * fq) = o;
                        o.x = pk2(bgt[x][0], bgt[x][1]); o.y = pk2(bgt[x][2], bgt[x][3]); *(LAS v2u*)(slot + RWS_BGT + rwz(kch) * 32 + 8 * fq) = o;
                        o.x = pk2(abt[x][0], abt[x][1]); o.y = pk2(abt[x][2], abt[x][3]); *(LAS v2u*)(tmp + RWT_ABT + rwz(kch) * 32 + 8 * fq) = o;
                    }
                    if (fq == 0) *(LAS f32x4*)(slot + RWS_G15 + 16 * fr) = all;
                    const unsigned vlo = (unsigned)cu.v[0] | ((unsigned)cu.v[1] << 16), vhi = (unsigned)cu.v[2] | ((unsigned)cu.v[3] << 16);
                    { v2u o; o.x = vlo; o.y = vhi; *(LAS v2u*)(slot + RWS_VCI + 8 * lane) = o; }
                    LDS_WAIT(); asm volatile("" ::: "memory");
                    f32x4 nac = (f32x4){0.f, 0.f, 0.f, 0.f}, kat = nac, krt = nac, nrt = nac;
#pragma unroll
                    for (int p = 0; p < 2; ++p) {
                        const int kb = (32 * p + 8 * fq) * 2;
                        const bf16x8 oAB = lds_op16(tmp + RWT_AB, fr, kb), oBT = lds_op16(tmp + RWT_BT, fr, kb), oKT = lds_op16(tmp + RWT_KT, fr, kb), oRB = lds_op16(slot + RWS_RB, fr, kb);
                        nac = __builtin_amdgcn_mfma_f32_16x16x32_bf16(oBT, oAB, nac, 0, 0, 0);
                        kat = __builtin_amdgcn_mfma_f32_16x16x32_bf16(oKT, oAB, kat, 0, 0, 0);
                        krt = __builtin_amdgcn_mfma_f32_16x16x32_bf16(oKT, oRB, krt, 0, 0, 0);
                        nrt = __builtin_amdgcn_mfma_f32_16x16x32_bf16(oBT, oRB, nrt, 0, 0, 0);
                    }
#pragma unroll
                    for (int i = 0; i < 4; ++i) { const int rr_ = 4 * fq + i;
                        if (rr_ >= fr) { nac[i] = 0.f; kat[i] = 0.f; }
                        if (rr_ > fr) { krt[i] = 0.f; nrt[i] = 0.f; } }
                    { u32x4_t o; o.x = pk2(krt[0], krt[1]); o.y = pk2(krt[2], krt[3]); o.z = pk2(-nrt[0], -nrt[1]); o.w = pk2(-nrt[2], -nrt[3]); *(LAS u32x4_t*)(slot + RWS_KNI + 16 * lane) = o; }
                    LDS_WAIT(); asm volatile("" ::: "memory");
                    *(LAS f32x4*)(tmp + RWT_NM + (fr * 16 + 4 * fq) * 4) = nac;
                    LDS_WAIT(); asm volatile("" ::: "memory");
                    float Tc[16];
                    f32x4 nvv[16][4];
#define RW_LD_ROWS(lo, hi) _Pragma("unroll") for (int s = lo; s <= hi; ++s) _Pragma("unroll") for (int r4 = 0; r4 < (s + 3) / 4; ++r4) nvv[s][r4] = *(const LAS f32x4*)(tmp + RWT_NM + (s * 16 + 4 * r4) * 4);
#define RW_DO_ROWS(lo, hi) _Pragma("unroll") for (int s = lo; s <= hi; ++s) { float acc_ = (s == fr) ? 1.f : 0.f; \
                        _Pragma("unroll") for (int r4 = 0; r4 < (s + 3) / 4; ++r4) _Pragma("unroll") for (int e = 0; e < 4; ++e) if (4 * r4 + e < s) acc_ -= nvv[s][r4][e] * Tc[4 * r4 + e]; \
                        Tc[s] = acc_; }
                    RW_LD_ROWS(1, 8) RW_LD_ROWS(9, 12)
                    asm volatile("" ::: "memory");
                    RW_DO_ROWS(0, 8)
                    RW_LD_ROWS(13, 15)
                    asm volatile("" ::: "memory");
                    RW_DO_ROWS(9, 12)
                    RW_DO_ROWS(13, 15)
#undef RW_LD_ROWS
#undef RW_DO_ROWS
#pragma unroll
                    for (int e = 0; e < 4; ++e) {
                        float tv = Tc[0];
#pragma unroll
                        for (int s = 0; s < 16; ++s) if (s == 4 * fq + e) tv = Tc[s];
                        *(LAS unsigned short*)(tmp + RWT_TM + ((4 * fq + e) * 16 + fr) * 2) = (unsigned short)f2bf(tv);
                    }
                    LDS_WAIT(); asm volatile("" ::: "memory");
                    const v2u tq = lds_8(tmp + RWT_TM + (fr * 16 + 4 * fq) * 2);
                    const bf16x8 opT = mk8(tq.x, tq.y, 0u, 0u);
                    f32x4 xac = __builtin_amdgcn_mfma_f32_16x16x32_bf16(mk8(pk2(kat[0], kat[1]), pk2(kat[2], kat[3]), 0u, 0u), mk8(vlo, vhi, 0u, 0u), (f32x4){0.f, 0.f, 0.f, 0.f}, 0, 0, 0);
                    const f32x4 wvv = __builtin_amdgcn_mfma_f32_16x16x32_bf16(opT, mk8(pk2(xac[0], xac[1]), pk2(xac[2], xac[3]), 0u, 0u), (f32x4){0.f, 0.f, 0.f, 0.f}, 0, 0, 0);
                    *(LAS f32x4*)(slot + RWS_WVI + 16 * lane) = wvv;
                    f32x4 aht[4];
#pragma unroll
                    for (int nt = 0; nt < 4; ++nt) {
                        const v2u ab = lds_8(tmp + RWT_ABT + rwz(16 * nt + fr) * 32 + 8 * fq);
                        aht[nt] = __builtin_amdgcn_mfma_f32_16x16x32_bf16(mk8(ab.x, ab.y, 0u, 0u), opT, (f32x4){0.f, 0.f, 0.f, 0.f}, 0, 0, 0);
                    }
#pragma unroll
                    for (int p = 0; p < 2; ++p) { u32x4_t o; o.x = pk2(aht[2 * p][0], aht[2 * p][1]); o.y = pk2(aht[2 * p][2], aht[2 * p][3]); o.z = pk2(aht[2 * p + 1][0], aht[2 * p + 1][1]); o.w = pk2(aht[2 * p + 1][2], aht[2 * p + 1][3]);
                        *(LAS u32x4_t*)(slot + RWS_AH + (p * 64 + lane) * 16) = o; }
                    LDS_WAIT(); asm volatile("" ::: "memory");
                    if (lane == 0) flg[cj % RW_NSLOT] = (unsigned)(cj + 1);
                }
            }
        } else {
            f32x4 St[4];
#pragma unroll
            for (int kt = 0; kt < 4; ++kt) St[kt] = (f32x4){0.f, 0.f, 0.f, 0.f};
            {
#pragma unroll 1
                for (int c = 0; c < NCH; ++c) {
                    const LAS unsigned char* slot = lds + (c % RW_NSLOT) * RWS_SLOT;
                    while (flg[c % RW_NSLOT] != (unsigned)(c + 1)) __builtin_amdgcn_s_sleep(1);
                    asm volatile("" ::: "memory");
                    f32x4 zt = *(const LAS f32x4*)(slot + RWS_WVI + 16 * lane);
                    f32x4 y = (f32x4){0.f, 0.f, 0.f, 0.f};
#pragma unroll
                    for (int p = 0; p < 2; ++p) {
                        const bf16x8 sb = mk8(pk2(St[2 * p][0], St[2 * p][1]), pk2(St[2 * p][2], St[2 * p][3]), pk2(St[2 * p + 1][0], St[2 * p + 1][1]), pk2(St[2 * p + 1][2], St[2 * p + 1][3]));
                        const v2u r0 = lds_8(slot + RWS_RB + fr * 128 + (32 * p + 4 * fq) * 2), r1 = lds_8(slot + RWS_RB + fr * 128 + (32 * p + 16 + 4 * fq) * 2);
                        zt = __builtin_amdgcn_mfma_f32_16x16x32_bf16(*(const LAS bf16x8*)(slot + RWS_AH + (p * 64 + lane) * 16), sb, zt, 0, 0, 0);
                        y = __builtin_amdgcn_mfma_f32_16x16x32_bf16(mk8(r0.x, r0.y, r1.x, r1.y), sb, y, 0, 0, 0);
                    }
                    const v2u vc = lds_8(slot + RWS_VCI + 8 * lane);
                    const bf16x8 b2 = mk8(vc.x, vc.y, pk2(zt[0], zt[1]), pk2(zt[2], zt[3]));
                    y = __builtin_amdgcn_mfma_f32_16x16x32_bf16(*(const LAS bf16x8*)(slot + RWS_KNI + 16 * lane), b2, y, 0, 0, 0);
#pragma unroll
                    for (int kt = 0; kt < 4; ++kt) {
                        const v2u kg = lds_8(slot + RWS_KGT + rwz(16 * kt + fr) * 32 + 8 * fq), bg = lds_8(slot + RWS_BGT + rwz(16 * kt + fr) * 32 + 8 * fq);
                        const f32x4 g15 = *(const LAS f32x4*)(slot + RWS_G15 + (16 * kt + 4 * fq) * 4);
                        St[kt] = __builtin_amdgcn_mfma_f32_16x16x32_bf16(mk8(kg.x, kg.y, bg.x, bg.y), b2, St[kt] * g15, 0, 0, 0);
                    }
                    bf16* yp = Y + (row0 + 16 * (size_t)c + 4 * fq) * 1024 + 64 * h + 16 * rg + fr;
#pragma unroll
                    for (int i = 0; i < 4; ++i) yp[(size_t)i * 1024] = (bf16)f2bf(y[i]);
                    LDS_WAIT(); asm volatile("" ::: "memory");
                    if (lane == 0) flg[RW_NSLOT] = (unsigned)(c + 1);
                }
            }
        }
        __syncthreads();
    }
}
__device__ __forceinline__ void rw_post(const bf16* Y, bf16* R, const bf16* K, const bf16* V, const bf16* A, const bf16* G, const float* k_a, const float* r_k, const float* ln_g, const float* ln_b, int gw, int ngw, int lane) {
    const int c = (gw & 3) * 256 + 4 * lane;
    const f32x4 ka = *(const f32x4*)(k_a + c), rk = *(const f32x4*)(r_k + c), lg = *(const f32x4*)(ln_g + c), lb = *(const f32x4*)(ln_b + c);
    for (int it = gw; it < M * 4; it += 2 * ngw) {
        const int it2 = (it + ngw < M * 4) ? it + ngw : it;
        const size_t off[2] = {(size_t)(it >> 2) * 1024 + c, (size_t)(it2 >> 2) * 1024 + c};
        v2u yv[2], rv[2], kv[2], vv[2], av[2], gv[2];
#pragma unroll
        for (int u = 0; u < 2; ++u) { yv[u] = *(const v2u*)(Y + off[u]); rv[u] = *(const v2u*)(R + off[u]); kv[u] = *(const v2u*)(K + off[u]); vv[u] = *(const v2u*)(V + off[u]); av[u] = *(const v2u*)(A + off[u]); gv[u] = *(const v2u*)(G + off[u]); }
#pragma unroll
        for (int u = 0; u < 2; ++u) {
            const f32x4 y = bf4(yv[u]), r = bf4(rv[u]), k = bf4(kv[u]), v = bf4(vv[u]), a = bf4(av[u]), g = bf4(gv[u]);
            const float mu = row16_sum((y[0] + y[1]) + (y[2] + y[3])) * (1.0f / 64.0f);
            const f32x4 yc = y - mu;
            const float var = row16_sum((yc[0] * yc[0] + yc[1] * yc[1]) + (yc[2] * yc[2] + yc[3] * yc[3])) * (1.0f / 64.0f);
            const float rstd = 1.0f / sqrtf(var + 64e-5f);
            const f32x4 km = k * (1.0f + (a - 1.0f) * ka);
            const f32x4 pr = r * km * rk;
            const float cs = row16_sum((pr[0] + pr[1]) + (pr[2] + pr[3]));
            const f32x4 o = (yc * rstd * lg + lb + v * cs) * g;
            v2u wv; wv.x = pk2(o[0], o[1]); wv.y = pk2(o[2], o[3]);
            if (u == 0 || it2 != it) *(v2u*)(R + off[u]) = wv;
        }
    }
}

__device__ __forceinline__ void sc_conv(const bf16* BG, const bf16* CG, const bf16* HX, const float* cw, const float* cb, bf16* O3, int gt, int ngt) {
    const int c = (gt & 127) * 8;
    float w0[8], w1[8], w2[8], bb[8];
#pragma unroll
    for (int j = 0; j < 8; ++j) { w0[j] = cw[c + j]; w1[j] = cw[1024 + c + j]; w2[j] = cw[2048 + c + j]; bb[j] = cb[c + j]; }
    for (int idx = gt; idx < M * 128; idx += 2 * ngt) {
        const int idx2 = idx + ngt < M * 128 ? idx + ngt : idx;
        v4u cv[2][3], hv[2][3], bv[2]; int tt[2]; size_t offs[2];
#pragma unroll
        for (int u = 0; u < 2; ++u) {
            const int m = (u ? idx2 : idx) >> 7; tt[u] = m & (SEQ - 1); offs[u] = (size_t)m * 1024 + c;
#pragma unroll
            for (int dt = 0; dt < 3; ++dt) { const size_t o2 = offs[u] - (size_t)((tt[u] - 2 + dt >= 0) ? (2 - dt) : 0) * 1024; cv[u][dt] = *(const v4u*)(CG + o2); hv[u][dt] = *(const v4u*)(HX + o2); }
            bv[u] = *(const v4u*)(BG + offs[u]);
        }
#pragma unroll
        for (int u = 0; u < 2; ++u) {
            float y[8];
#pragma unroll
            for (int j = 0; j < 8; ++j) y[j] = bb[j];
#pragma unroll
            for (int dt = 0; dt < 3; ++dt) {
                const float on = (tt[u] - 2 + dt >= 0) ? 1.f : 0.f;
                const float* wp = dt == 0 ? w0 : (dt == 1 ? w1 : w2);
                const v4u cq = cv[u][dt], hq = hv[u][dt];
                y[0] += on * wp[0] * (bflo(cq.x) * bflo(hq.x)); y[1] += on * wp[1] * (bfhi(cq.x) * bfhi(hq.x));
                y[2] += on * wp[2] * (bflo(cq.y) * bflo(hq.y)); y[3] += on * wp[3] * (bfhi(cq.y) * bfhi(hq.y));
                y[4] += on * wp[4] * (bflo(cq.z) * bflo(hq.z)); y[5] += on * wp[5] * (bfhi(cq.z) * bfhi(hq.z));
                y[6] += on * wp[6] * (bflo(cq.w) * bflo(hq.w)); y[7] += on * wp[7] * (bfhi(cq.w) * bfhi(hq.w));
            }
            const v4u bq = bv[u];
            v4u w; w.x = pk2(y[0] * bflo(bq.x), y[1] * bfhi(bq.x)); w.y = pk2(y[2] * bflo(bq.y), y[3] * bfhi(bq.y)); w.z = pk2(y[4] * bflo(bq.z), y[5] * bfhi(bq.z)); w.w = pk2(y[6] * bflo(bq.w), y[7] * bfhi(bq.w));
            if (u == 0 || idx2 != idx) *(v4u*)(O3 + offs[u]) = w;
        }
    }
}

#define XB_TMO      128
#define XB_XCNT(j)  (256  + 64 * (j))
#define XB_XSUB(j)  (1280 + 64 * (j))
#define XB_XGEN(j)  (2304 + 64 * (j))
#define XB_TOP      3328
#define XB_TOPGEN   3392
#define XCD_BAR_WORDS 3456
#define XB_SPIN_CAP (1u << 18)

__device__ __forceinline__ unsigned xb_ld(unsigned* p)              { return __hip_atomic_load(p, __ATOMIC_RELAXED, __HIP_MEMORY_SCOPE_AGENT); }
__device__ __forceinline__ unsigned xb_add(unsigned* p, unsigned v) { return __hip_atomic_fetch_add(p, v, __ATOMIC_RELAXED, __HIP_MEMORY_SCOPE_AGENT); }
__device__ __forceinline__ unsigned xb_xcc_id() { return (unsigned)__builtin_amdgcn_s_getreg((3 << 11) | 20) & 0xFu; }
#define XB_SPIN(cond, bar) do { unsigned _sp = 0; while (cond) { __builtin_amdgcn_s_sleep(1); \
    if ((++_sp & 255u) == 0u) { if (xb_ld(&(bar)[XB_TMO])) break; if (_sp > XB_SPIN_CAP) { atomicAdd(&(bar)[XB_TMO], 1u); break; } } } } while (0)

struct XcdBarrier {
    unsigned* bar; unsigned x;
    volatile LAS unsigned* st;
};

__device__ __forceinline__ XcdBarrier xcd_barrier_post(unsigned* bar, volatile LAS unsigned* st) {
    XcdBarrier b; b.bar = bar; b.x = xb_xcc_id(); b.st = st;
    if (threadIdx.x == 0) (void)xb_add(&bar[XB_XCNT(b.x)], 1u);
    return b;
}
__device__ __forceinline__ void xcd_barrier_complete(unsigned* bar, unsigned x, unsigned& nloc, unsigned& nx) {
    const unsigned G = gridDim.x * gridDim.y * gridDim.z;
    unsigned sum, cnt, mine, sp = 0u;
    for (;;) {
        sum = 0u; cnt = 0u; mine = 0u;
#pragma unroll
        for (unsigned j = 0; j < 16; ++j) { const unsigned c = xb_ld(&bar[XB_XCNT(j)]); sum += c; cnt += (c > 0u) ? 1u : 0u; mine = (j == x) ? c : mine; }
        if (sum == G) break;
        __builtin_amdgcn_s_sleep(1);
        if ((++sp & 255u) == 0u) { if (xb_ld(&bar[XB_TMO])) break; if (sp > XB_SPIN_CAP) { atomicAdd(&bar[XB_TMO], 1u); break; } }
    }
    nloc = mine > 0u ? mine : 1u; nx = cnt > 0u ? cnt : 1u;
}

__device__ __forceinline__ void xcd_barrier(const XcdBarrier& b) {
    asm volatile("s_waitcnt vmcnt(0)" ::: "memory");
    __syncthreads();
    if (threadIdx.x == 0) {
        unsigned* bar = b.bar;
        __builtin_amdgcn_s_waitcnt(0);
        unsigned nloc = b.st[0], nx = b.st[1];
        if (nloc == 0u) { xcd_barrier_complete(bar, b.x, nloc, nx); b.st[0] = nloc; b.st[1] = nx; }
        const unsigned old = xb_add(&bar[XB_XSUB(b.x)], 1u);
        const unsigned gen = old / nloc;
        if (old + 1u == (gen + 1u) * nloc) {
            __builtin_amdgcn_fence(__ATOMIC_RELEASE, "agent");
            asm volatile("s_waitcnt vmcnt(0)" ::: "memory");
            const unsigned og = xb_add(&bar[XB_TOP], 1u);
            const unsigned tg = og / nx;
            if (og + 1u == (tg + 1u) * nx) xb_add(&bar[XB_TOPGEN], 1u);
            else XB_SPIN(xb_ld(&bar[XB_TOPGEN]) == tg, bar);
            __builtin_amdgcn_fence(__ATOMIC_ACQUIRE, "agent");
            xb_add(&bar[XB_XGEN(b.x)], 1u);
            asm volatile("s_waitcnt vmcnt(0)" ::: "memory");
        } else {
            XB_SPIN(xb_ld(&bar[XB_XGEN(b.x)]) == gen, bar);
            __builtin_amdgcn_fence(__ATOMIC_ACQUIRE, "agent");
            asm volatile("s_waitcnt vmcnt(0)" ::: "memory");
        }
    }
    __syncthreads();
}

struct Args { const float* in[32]; float* out; unsigned char* ws; };
#define PHASE_VARS \
    size_t zoff_ = 0; asm volatile("" : "+s"(zoff_)); unsigned char* ws = a.ws + zoff_; float* out = a.out + zoff_;     \
    int tid = threadIdx.x; asm volatile("" : "+v"(tid)); \
    const int lane = tid & 63, wave = __builtin_amdgcn_readfirstlane(tid >> 6); \
    const int G = gridDim.x, gw = blockIdx.x * NWAVES + wave, ngw = G * NWAVES, gt = blockIdx.x * NTHR + tid, ngt = G * NTHR; \
    float* RS = (float*)(ws + WS_BIG + 402 * MiB)  ; float* RSM = (float*)(ws + WS_RS)  ; float* LBK = (float*)(ws + WS_LBK); (void)RSM; \
    bf16* WA = (bf16*)(ws + WS_WA); bf16* WB = (bf16*)(ws + WS_WB); bf16* WO = (bf16*)(ws + WS_WO); bf16* WUP = (bf16*)(ws + WS_WUP); bf16* WDN = (bf16*)(ws + WS_WDN); \
    bf16* HB = (bf16*)(ws + WS_HB); \
    bf16* B0 = (bf16*)(ws + WS_BIG); bf16* B1 = (bf16*)(ws + WS_BIG + SLOT); bf16* B2 = (bf16*)(ws + WS_BIG + 2 * SLOT); bf16* B3 = (bf16*)(ws + WS_BIG + 3 * SLOT); \
    bf16* B4 = (bf16*)(ws + WS_BIG + 4 * SLOT); bf16* B5 = (bf16*)(ws + WS_BIG + 5 * SLOT); bf16* B5b = (bf16*)(ws + WS_BIG + 5 * SLOT + 16 * MiB); \
    LAS float* scr = (LAS float*)(lds + wave * 16384); \
    (void)lane; (void)gw; (void)ngw; (void)gt; (void)ngt; (void)RS; (void)LBK; (void)WA; (void)WB; (void)WO; (void)WUP; (void)WDN; (void)HB; (void)B0; (void)B1; (void)B2; (void)B3; (void)B4; (void)B5; (void)B5b; (void)scr; (void)out; (void)G;
constexpr size_t SLOT_E = SLOT / 2;

__global__ void __launch_bounds__(NTHR, 2) fwd_megakernel(Args a) {
    extern __shared__ __attribute__((aligned(16))) unsigned char lds_raw[];
    cg::grid_group grid = cg::this_grid();
    LAS unsigned char* lds = (LAS unsigned char*)lds_raw;
    volatile LAS unsigned* xb_st = (volatile LAS unsigned*)(lds + LDS_BYTES - 64);
    if (threadIdx.x < 2) xb_st[threadIdx.x] = 0u;
    __syncthreads();
    const XcdBarrier xbar = xcd_barrier_post((unsigned*)(a.ws + WS_BAR), xb_st);

#pragma nounroll
    for (int layer = 0; layer < 4; ++layer) {
        for (int rp_ = 0; rp_ < REP_PRO; ++rp_) { PHASE_VARS
        const float* gmix = a.in[1] + layer * 1024; const float* gffn = a.in[2] + layer * 1024;
        conv_mat(a.in[3] + (size_t)layer * D * FF, D, FF, WUP, D, 0, 0, gffn, scr, gw, ngw, lane);
        conv_mat(a.in[4] + (size_t)layer * D * FF, FF, D, WDN, FF, 0, 0, nullptr, scr, gw, ngw, lane);
        if (layer == 0) {
            conv_mat(a.in[6], D, 3 * D, WA, D, 0, 0, gmix, scr, gw, ngw, lane);
            conv_mat(a.in[7], D, D, WO, D, 0, 0, nullptr, scr, gw, ngw, lane);
            for (int m0 = gw; m0 < M; m0 += 4 * ngw) {
                f32x4 v[4][4];
#pragma unroll
                for (int u = 0; u < 4; ++u) { const int ml = m0 + u * ngw < M ? m0 + u * ngw : m0; const f32x4* xr = (const f32x4*)(a.in[0] + (size_t)ml * 1024) + lane;
#pragma unroll
                    for (int j = 0; j < 4; ++j) v[u][j] = xr[64 * j]; }
#pragma unroll
                for (int u = 0; u < 4; ++u) { const int m = m0 + u * ngw; if (m >= M) break; float ss = 0.f;
#pragma unroll
                    for (int j = 0; j < 4; ++j) { ss += (v[u][j][0] * v[u][j][0] + v[u][j][1] * v[u][j][1]) + (v[u][j][2] * v[u][j][2] + v[u][j][3] * v[u][j][3]);
                        v2u w; w.x = pk2(v[u][j][0], v[u][j][1]); w.y = pk2(v[u][j][2], v[u][j][3]); *(v2u*)(HB + (size_t)m * 1024 + 4 * lane + 256 * j) = w; }
                    ss = wave_sum(ss);
                    if (lane < 16) RS[(size_t)m * 16 + lane] = lane == 0 ? ss : 0.f; }
            }
        } else if (layer == 1) {
            conv_mat(a.in[8], D, 4 * D, WA, D, 0, 0, gmix, scr, gw, ngw, lane);
            conv_mat(a.in[11], D, D, WO, D, 0, 0, nullptr, scr, gw, ngw, lane);
            for (int c = gt; c < 1024; c += ngt) {
                const float* tb = a.in[9]; const float t0 = tb[c], t1 = tb[1024 + c], t2 = tb[2048 + c], t3 = tb[3072 + c];
                const float mx = fmaxf(fmaxf(t0, t1), fmaxf(t2, t3));
                const float e0 = expf(t0 - mx), e1 = expf(t1 - mx), e2 = expf(t2 - mx), e3 = expf(t3 - mx);
                LBK[c] = 1.0f - e1 / (e0 + e1 + e2 + e3);
            }
        } else if (layer == 2) {
            const float* mix = a.in[12];
#pragma nounroll
            for (int j = 0; j < 3; ++j) {
                conv_mat(a.in[13] + (size_t)j * D * D, D, D, WA, 2048, 1024 * j, 0, nullptr, scr, gw, ngw, lane);
                conv_mat(a.in[13] + (size_t)j * D * D, D, D, WA, 2048, 1024 * j, 1024, mix + 1024 * j, scr, gw, ngw, lane);
            }
            conv_mat(a.in[15], D, 64, WA, 2048, 3072, 0, nullptr, scr, gw, ngw, lane); conv_mat(a.in[15], D, 64, WA, 2048, 3072, 1024, mix + 3 * 1024, scr, gw, ngw, lane);
            conv_mat(a.in[18], D, 64, WA, 2048, 3136, 0, nullptr, scr, gw, ngw, lane); conv_mat(a.in[18], D, 64, WA, 2048, 3136, 1024, mix + 4 * 1024, scr, gw, ngw, lane);
            conv_mat(a.in[20], D, 128, WA, 2048, 3200, 0, nullptr, scr, gw, ngw, lane); conv_mat(a.in[20], D, 128, WA, 2048, 3200, 1024, mix + 5 * 1024, scr, gw, ngw, lane);
            conv_mat(a.in[27], D, D, WO, D, 0, 0, nullptr, scr, gw, ngw, lane);
            for (int idx = gt; idx < 256 * 3072; idx += ngt) {
                const int k = idx / 3072, n = idx - k * 3072, grp = n >> 10, nn = n & 1023; float v = 0.f;
                if (grp == 0) { if (k < 64) v = a.in[16][k * 1024 + nn]; }
                else if (grp == 1) { if (k >= 64 && k < 128) v = a.in[19][(k - 64) * 1024 + nn]; }
                else { if (k >= 128) v = a.in[21][(k - 128) * 1024 + nn]; }
                WB[(size_t)n * 256 + k] = (bf16)f2bf(v);
            }
            rw_prep(HB, RS, gmix, B0, gw, ngw, lane);
        } else {
            conv_mat(a.in[28], D, 3 * D, WA, D, 0, 0, gmix, scr, gw, ngw, lane);
            conv_mat(a.in[31], D, D, WO, D, 0, 0, nullptr, scr, gw, ngw, lane);
        }
        }
        if (layer == 0) grid.sync();
        else GRID_SYNC();

        if (layer == 0 || layer == 3) {
            { PHASE_VARS
            pg8::Gemm g{HB, WA, M, 3 * D, D}; pg8::StaticOrder S; S.init(M, 3 * D, G, (int)blockIdx.x);
            pg8::EpiAct<0> E{B0, 1024, 1024, SLOT_E, RS, layer == 0 ? 0.125f * LOG2E_F : 1.0f, nullptr};
            for (int r_ = 0; r_ < REP_IN; ++r_) pg8::gemm_phase<pg8::EpiAct<0>, pg8::StaticOrder, true, true>(lds, g, S, E); }
            GRID_SYNC();
            { PHASE_VARS
            if (layer == 0) { for (int r_ = 0; r_ < REP_ATT; ++r_) attn_phase(B0, B1, B2, B3, gw, ngw, lane); }
            else { for (int r_ = 0; r_ < REP_SC; ++r_) sc_conv(B0, B1, B2, a.in[29], a.in[30], B3, gt, ngt); } }
        } else if (layer == 1) {
            { PHASE_VARS
            pg8::Gemm g{HB, WA, M, 4 * D, D}; pg8::StaticOrder S; S.init(M, 4 * D, G, (int)blockIdx.x);
            pg8::EpiAct<2> E{B0, 1024, 1024, SLOT_E, RS, 1.0f, LBK};
            for (int r_ = 0; r_ < REP_IN; ++r_) pg8::gemm_phase<pg8::EpiAct<2>, pg8::StaticOrder, true, true>(lds, g, S, E); }
            GRID_SYNC();
            { PHASE_VARS
            hg_local(B0, B1, (bf16*)out, (bf16*)out + (size_t)M * 1024, B4, B2, (float*)B5, (float*)(ws + WS_BIG + 5 * SLOT + 8 * MiB), (float*)(ws + WS_BIG + 5 * SLOT + 24 * MiB)); }
            GRID_SYNC();
            { PHASE_VARS
            hg_out((const bf16*)out, (const bf16*)out + (size_t)M * 1024, B4, B2, (const float*)B5, (const float*)(ws + WS_BIG + 5 * SLOT + 8 * MiB), (const float*)(ws + WS_BIG + 5 * SLOT + 24 * MiB), a.in[10], B3, lds); }
        } else {
            { PHASE_VARS
              pg8::Gemm g{B0, WA, M, 3328, 2048}; pg8::StaticOrder S; S.init(M, 3328, G, (int)blockIdx.x);
              pg8::EpiRw1 E{B2, SLOT_E, B5};
              for (int r_ = 0; r_ < REP_G1; ++r_) pg8::gemm_phase<pg8::EpiRw1, pg8::StaticOrder, true, true>(lds, g, S, E); }
            GRID_SYNC();
            { PHASE_VARS
              int k256 = 256; asm volatile("" : "+s"(k256));
              pg8::Gemm g{B5, WB, M, 3 * D, k256}; pg8::StaticOrder S; S.init(M, 3 * D, G, (int)blockIdx.x);
              pg8::EpiRw2 E{B0, SLOT_E, 5 * SLOT_E + 8 * MiB, a.in[14], a.in[17]};
              for (int r_ = 0; r_ < REP_G2; ++r_) pg8::gemm_phase<pg8::EpiRw2, pg8::StaticOrder, true, true>(lds, g, S, E); }
            GRID_SYNC();
            { PHASE_VARS
            for (int r_ = 0; r_ < REP_RW; ++r_) rw_scan(B2, B3, B4, B0, B1, a.in[22], a.in[23], (bf16*)out, lds); }
            GRID_SYNC();
            { PHASE_VARS
            rw_post((const bf16*)out, B2, B3, B4, B1, B5b, a.in[23], a.in[24], a.in[25], a.in[26], gw, ngw, lane); }
        }
        GRID_SYNC();
        { PHASE_VARS
          const bf16* mix_out = (layer == 2) ? B2 : B3;
          pg8::Gemm g{mix_out, WO, M, D, D}; pg8::StaticOrder S; S.init(M, D, G, (int)blockIdx.x);
          pg8::EpiResidB E{HB, RSM, nullptr};
          pg8::gemm_phase<pg8::EpiResidB, pg8::StaticOrder, true, true>(lds, g, S, E); }
        GRID_SYNC();
        { PHASE_VARS
          pg8::Gemm g{HB, WUP, M, FF, D}; pg8::StaticOrder S; S.init(M, FF, G, (int)blockIdx.x);
          pg8::EpiAct<1> E{B0, FF, 0, 0, nullptr, 1.0f, nullptr};
#pragma nounroll
          for (int r_ = 0; r_ < REP_UP; ++r_) pg8::gemm_phase<pg8::EpiAct<1>, pg8::StaticOrder, true, true>(lds, g, S, E); }
        GRID_SYNC();
        { PHASE_VARS
          pg8::Gemm g{B0, WDN, M, D, FF}; pg8::StaticOrder S; S.init(M, D, G, (int)blockIdx.x);
          pg8::EpiResidB E{HB, RS, RSM};
          pg8::gemm_phase<pg8::EpiResidB, pg8::StaticOrder, true, true>(lds, g, S, E); }
        GRID_SYNC();
    }
    { PHASE_VARS
    const f32x4* gr = (const f32x4*)(a.in[5]) + lane;
    const f32x4 g0 = gr[0], g1 = gr[64], g2 = gr[128], g3 = gr[192];
    for (int m0 = gw; m0 < M; m0 += 4 * ngw) {
        f32x4 v[4][4]; f32x4 pr[4];
#pragma unroll
        for (int u = 0; u < 4; ++u) { const int m = m0 + u * ngw < M ? m0 + u * ngw : m0;
            pr[u] = *(const f32x4*)(RS + (size_t)m * 16 + 4 * (lane & 3));
#pragma unroll
            for (int j = 0; j < 4; ++j) v[u][j] = bf4(*(const v2u*)(HB + (size_t)m * 1024 + 4 * lane + 256 * j)); }
#pragma unroll
        for (int u = 0; u < 4; ++u) { const int m = m0 + u * ngw; if (m >= M) break; f32x4* xr = (f32x4*)(out + (size_t)m * 1024) + lane;
            float s = (pr[u][0] + pr[u][1]) + (pr[u][2] + pr[u][3]); s += dpp_f<0xB1>(s); s += dpp_f<0x4E>(s);
            const float r = 1.0f / sqrtf(s * (1.0f / 1024.0f) + 1e-6f);
            xr[0] = v[u][0] * r * g0; xr[64] = v[u][1] * r * g1; xr[128] = v[u][2] * r * g2; xr[192] = v[u][3] * r * g3; }
    } }
}

extern "C" void kernel_launch(void* const* d_in, const int* in_sizes, int n_in, void* d_out, int out_size, void* d_ws, size_t ws_size, hipStream_t stream) {
    static int grid = 0;
    if (grid == 0) {
        if (n_in != 32 || out_size != M * D || ws_size < WS_END) { fprintf(stderr, "kernel_launch: unexpected shapes (n_in %d out %d ws %zu)\n", n_in, out_size, ws_size); grid = -1; return; }
        int dev = 0, cus = 0, per_cu = 0;
        hipGetDevice(&dev); hipDeviceGetAttribute(&cus, hipDeviceAttributeMultiprocessorCount, dev);
        hipFuncSetAttribute((const void*)fwd_megakernel, hipFuncAttributeMaxDynamicSharedMemorySize, LDS_BYTES);
        hipOccupancyMaxActiveBlocksPerMultiprocessor(&per_cu, (const void*)fwd_megakernel, NTHR, LDS_BYTES);
        if (per_cu < 1) { fprintf(stderr, "kernel_launch: occupancy query says %d blocks per CU\n", per_cu); per_cu = 1; }
        (void)hipGetLastError();
        grid = cus * per_cu;
    }
    if (grid < 0) return;
    if (hipMemsetAsync((char*)d_ws + WS_BAR, 0, WS_BAR_BYTES, stream) != hipSuccess) { fprintf(stderr, "kernel_launch: memset of the barrier words failed\n"); return; }
    Args a{};
    for (int i = 0; i < 32; ++i) a.in[i] = (const float*)d_in[i];
    a.out = (float*)d_out; a.ws = (unsigned char*)d_ws;
    void* args[] = {&a};
    hipError_t e = hipLaunchCooperativeKernel((const void*)fwd_megakernel, dim3(grid), dim3(NTHR), args, LDS_BYTES, stream);
    if (e != hipSuccess) fprintf(stderr, "cooperative launch failed: %s (grid %d)\n", hipGetErrorString(e), grid);
}
```

```cpp
#include <hip/hip_runtime.h>
#include <hip/hip_cooperative_groups.h>
#include <cstdio>
#include <cstdint>
namespace cg = cooperative_groups;
namespace pg8 {
#define PG8_LAS __attribute__((address_space(3)))
typedef unsigned short bf16_t;
typedef short bf16x8 __attribute__((ext_vector_type(8)));
typedef float f32x4 __attribute__((ext_vector_type(4)));
typedef unsigned u32x4 __attribute__((ext_vector_type(4)));
constexpr int BM = 256, BK = 64, HALF = 128, HTB = HALF * BK * 2  , STAGE_BYTES = 8 * HTB, NXCD = 8, WGM = 8;

__host__ __device__ __forceinline__ int lds_byte(int r, int c) { const int st = (r >> 4) * 2 + (c >> 5), rr = r & 15, cc = c & 31, ob = rr * 64 + cc * 2; return st * 1024 + (ob ^ (((ob >> 9) & 1) << 5)); }
__host__ __device__ __forceinline__ void stage_rc(int b, int& R, int& C) { const int st = b / 1024, sb = b % 1024, swz = sb ^ (((sb >> 9) & 1) << 5); R = (st >> 1) * 16 + swz / 64; C = (st & 1) * 32 + (swz % 64) / 2; }
__host__ __device__ __forceinline__ int perm32(int rho) { const int n = rho >> 4, i = rho & 15; return 8 * (i >> 2) + 4 * n + (i & 3); }

struct Unit { int pm, pn; };
struct Gemm { const bf16_t* A; const bf16_t* Bt; int M, N, K; };

struct StaticOrder {
    int nM, nN, nwg, G, c;
    __host__ __device__ void init(int M, int N, int G_, int c_) { nM = M / BM; nN = N / BM; nwg = nM * nN; G = G_; c = c_; }
    __host__ __device__ bool next(int i, Unit& u) const {
        const long L = (long)i * G + c; if (L >= nwg) return false;
        int wgid = (int)L; { const int q = nwg / NXCD, r = nwg % NXCD, xcd = wgid % NXCD, off = wgid / NXCD; wgid = (xcd < r ? xcd * (q + 1) : r * (q + 1) + (xcd - r) * q) + off; }
        const int wgm = nN >= 8 ? 4 : WGM; const int nig = wgm * nN, gid = wgid / nig, fm = gid * wgm, gsz = (nM - fm) < wgm ? (nM - fm) : wgm;
        u.pm = fm + ((wgid % nig) % gsz); u.pn = (wgid % nig) / gsz; return true;
    }
    __device__ __forceinline__ void a_ready(const Unit&) const {}
    __device__ __forceinline__ void done(const Unit&) const {}
};

__device__ __forceinline__ unsigned cvt_pk_bf16(float lo, float hi) { unsigned r; asm volatile("v_cvt_pk_bf16_f32 %0, %1, %2" : "=v"(r) : "v"(lo), "v"(hi)); return r; }
typedef unsigned u32x4 __attribute__((ext_vector_type(4)));
typedef unsigned u32x2 __attribute__((ext_vector_type(2)));
constexpr float LOG2E = 1.4426950408889634f;
__device__ __forceinline__ float fast_sigmoid(float x) { return __builtin_amdgcn_rcpf(1.0f + __builtin_amdgcn_exp2f(-x * LOG2E)); }
__device__ __forceinline__ float row_rs(const float* rs, int row) {
    const f32x4* p = (const f32x4*)(rs + (size_t)row * 16);
    const f32x4 a = p[0], b = p[1], c = p[2], d = p[3];
    const float s = ((a[0] + a[1]) + (a[2] + a[3])) + ((b[0] + b[1]) + (b[2] + b[3])) + ((c[0] + c[1]) + (c[2] + c[3])) + ((d[0] + d[1]) + (d[2] + d[3]));
    return 1.0f / sqrtf(s * (1.0f / 1024.0f) + 1e-6f);
}
template <int MODE> struct EpiAct {
    static constexpr bool PERM = true, AFTER_DRAIN = false;
    bf16_t* O; int ldc; int split_cols; size_t split_stride; const float* rs; float scale0; const float* aux;
    __device__ __forceinline__ void operator()(const f32x4 (&acc)[2][2][4][2], const Unit& u, int wr, int wc, int fr, int fq) const {
        const int row0 = u.pm * BM + wr * 64 + fr; int colt = u.pn * BM; bf16_t* base = O; int t = 0;
        if (split_cols) { t = colt / split_cols; base += (size_t)t * split_stride; colt -= t * split_cols; }
        const float sc = (MODE == 0 && t == 0) ? scale0 : 1.f;
        const int col0 = colt + wc * 32 + 8 * fq;
        f32x4 lbk[2][2];
#pragma unroll
        for (int bj = 0; bj < 2; ++bj)
#pragma unroll
            for (int n = 0; n < 2; ++n) lbk[bj][n] = (MODE == 2 && t == 1) ? *(const f32x4*)(aux + col0 + bj * HALF + 4 * n) : (f32x4){0.f, 0.f, 0.f, 0.f};
        float rsv[2][4];
        if (rs) {
            f32x4 part[2][4];
#pragma unroll
            for (int ai = 0; ai < 2; ++ai)
#pragma unroll
                for (int m = 0; m < 4; ++m) part[ai][m] = *(const f32x4*)(rs + (size_t)(row0 + ai * HALF + m * 16) * 16 + 4 * fq);
#pragma unroll
            for (int ai = 0; ai < 2; ++ai)
#pragma unroll
                for (int m = 0; m < 4; ++m) { float s = (part[ai][m][0] + part[ai][m][1]) + (part[ai][m][2] + part[ai][m][3]); s += __shfl_xor(s, 16); s += __shfl_xor(s, 32);
                    rsv[ai][m] = sc / sqrtf(s * (1.0f / 1024.0f) + 1e-6f); }
        } else {
#pragma unroll
            for (int ai = 0; ai < 2; ++ai)
#pragma unroll
                for (int m = 0; m < 4; ++m) rsv[ai][m] = sc;
        }
#pragma unroll
        for (int ai = 0; ai < 2; ++ai)
#pragma unroll
            for (int m = 0; m < 4; ++m) {
                const int row = row0 + ai * HALF + m * 16;
                const float r = rsv[ai][m];
                bf16_t* rowp = base + (size_t)row * ldc + col0;
#pragma unroll
                for (int bj = 0; bj < 2; ++bj) {
                    f32x4 v[2] = {acc[ai][bj][m][0] * r, acc[ai][bj][m][1] * r};
#pragma unroll
                    for (int n = 0; n < 2; ++n)
#pragma unroll
                        for (int j = 0; j < 4; ++j) {
                            float x = v[n][j];
                            if (MODE == 1) { x = fmaxf(x, 0.f); x = x * x; }
                            if (MODE == 2) {
                                if (t == 0 || t == 3) x = x * fast_sigmoid(x);
                                else if (t == 1) x = lbk[bj][n][j] * __builtin_amdgcn_rcpf(1.0f + __builtin_amdgcn_exp2f(x * LOG2E));
                            }
                            v[n][j] = x;
                        }
                    u32x4 w; w.x = cvt_pk_bf16(v[0][0], v[0][1]); w.y = cvt_pk_bf16(v[0][2], v[0][3]); w.z = cvt_pk_bf16(v[1][0], v[1][1]); w.w = cvt_pk_bf16(v[1][2], v[1][3]);
                    *(u32x4*)(rowp + bj * HALF) = w;
                }
            }
    }
};
struct EpiRw1 {
    static constexpr bool PERM = true, AFTER_DRAIN = false;
    bf16_t* RKV; size_t split_stride; bf16_t* L;
    __device__ __forceinline__ void operator()(const f32x4 (&acc)[2][2][4][2], const Unit& u, int wr, int wc, int fr, int fq) const {
        const int row0 = u.pm * BM + wr * 64 + fr;
        const bool lora = (u.pn >= 12);
        bf16_t* base = lora ? L : RKV + (size_t)(u.pn >> 2) * split_stride;
        const int ldc = lora ? 256 : 1024;
        const int col0 = (lora ? 0 : (u.pn & 3) * BM) + wc * 32 + 8 * fq;
#pragma unroll
        for (int ai = 0; ai < 2; ++ai)
#pragma unroll
            for (int m = 0; m < 4; ++m) {
                bf16_t* rowp = base + (size_t)(row0 + ai * HALF + m * 16) * ldc + col0;
#pragma unroll
                for (int bj = 0; bj < 2; ++bj) {
                    f32x4 v[2] = {acc[ai][bj][m][0], acc[ai][bj][m][1]};
                    if (lora) {
#pragma unroll
                        for (int n = 0; n < 2; ++n)
#pragma unroll
                            for (int j = 0; j < 4; ++j) {
                                float x = v[n][j];
                                if (bj == 1) x = fast_sigmoid(x);
                                else if (wc < 2) x = 1.0f - 2.0f * __builtin_amdgcn_rcpf(1.0f + __builtin_amdgcn_exp2f(fminf(x, 40.f) * (2.0f * LOG2E)));
                                v[n][j] = x;
                            }
                    }
                    u32x4 w; w.x = cvt_pk_bf16(v[0][0], v[0][1]); w.y = cvt_pk_bf16(v[0][2], v[0][3]); w.z = cvt_pk_bf16(v[1][0], v[1][1]); w.w = cvt_pk_bf16(v[1][2], v[1][3]);
                    *(u32x4*)(rowp + bj * HALF) = w;
                }
            }
    }
};
struct EpiRw2 {
    static constexpr bool PERM = true, AFTER_DRAIN = false;
    bf16_t* WM; size_t offA, offG; const float* w0; const float* a0;
    __device__ __forceinline__ void operator()(const f32x4 (&acc)[2][2][4][2], const Unit& u, int wr, int wc, int fr, int fq) const {
        const int row0 = u.pm * BM + wr * 64 + fr; const int t = u.pn >> 2;
        bf16_t* base = WM + (t == 1 ? offA : (size_t)0) + (t == 2 ? offG : (size_t)0);
        const float* bias = t == 0 ? w0 : a0;
        const int col0 = (u.pn & 3) * BM + wc * 32 + 8 * fq;
        f32x4 bv[2][2];
#pragma unroll
        for (int bj = 0; bj < 2; ++bj)
#pragma unroll
            for (int n = 0; n < 2; ++n) bv[bj][n] = (t < 2) ? *(const f32x4*)(bias + col0 + bj * HALF + 4 * n) : (f32x4){0.f, 0.f, 0.f, 0.f};
#pragma unroll
        for (int ai = 0; ai < 2; ++ai)
#pragma unroll
            for (int m = 0; m < 4; ++m) {
                bf16_t* rowp = base + (size_t)(row0 + ai * HALF + m * 16) * 1024 + col0;
#pragma unroll
                for (int bj = 0; bj < 2; ++bj) {
                    f32x4 v[2] = {acc[ai][bj][m][0], acc[ai][bj][m][1]};
                    if (t < 2) {
                        v[0] += bv[bj][0]; v[1] += bv[bj][1];
#pragma unroll
                        for (int n = 0; n < 2; ++n)
#pragma unroll
                            for (int j = 0; j < 4; ++j) {
                                float x = fast_sigmoid(v[n][j]);
                                if (t == 0) x = 1.0f - __builtin_amdgcn_exp2f(x * (-0.6065306597126334f * LOG2E));
                                v[n][j] = x;
                            }
                    }
                    u32x4 w; w.x = cvt_pk_bf16(v[0][0], v[0][1]); w.y = cvt_pk_bf16(v[0][2], v[0][3]); w.z = cvt_pk_bf16(v[1][0], v[1][1]); w.w = cvt_pk_bf16(v[1][2], v[1][3]);
                    *(u32x4*)(rowp + bj * HALF) = w;
                    asm volatile("" ::: "memory");
                }
            }
    }
};
struct EpiResid {
    static constexpr bool PERM = false, AFTER_DRAIN = false;
    const float* base; float* out; bf16_t* hb; float* rsq;
    __device__ __forceinline__ void operator()(const f32x4 (&acc)[2][2][4][2], const Unit& u, int wr, int wc, int fr, int fq) const {
        const int col0 = u.pn * BM + wc * 32 + 4 * fq;
#pragma unroll
        for (int ai = 0; ai < 2; ++ai) {
            f32x4 pre[4][2][2];
#pragma unroll
            for (int m = 0; m < 4; ++m) { const size_t off = (size_t)(u.pm * BM + ai * HALF + wr * 64 + m * 16 + fr) * 1024 + col0;
#pragma unroll
                for (int bj = 0; bj < 2; ++bj)
#pragma unroll
                    for (int n = 0; n < 2; ++n) pre[m][bj][n] = *(const f32x4*)(base + off + bj * HALF + n * 16); }
#pragma unroll
            for (int m = 0; m < 4; ++m) {
                const int row = u.pm * BM + ai * HALF + wr * 64 + m * 16 + fr; const size_t off = (size_t)row * 1024 + col0;
                float ss = 0.f;
#pragma unroll
                for (int bj = 0; bj < 2; ++bj)
#pragma unroll
                    for (int n = 0; n < 2; ++n) {
                        const f32x4 o = pre[m][bj][n] + acc[ai][bj][m][n];
                        *(f32x4*)(out + off + bj * HALF + n * 16) = o;
                        u32x2 w; w.x = cvt_pk_bf16(o[0], o[1]); w.y = cvt_pk_bf16(o[2], o[3]);
                        if (hb) *(u32x2*)(hb + off + bj * HALF + n * 16) = w;
                        ss += (o[0] * o[0] + o[1] * o[1]) + (o[2] * o[2] + o[3] * o[3]);
                    }
                ss += __shfl_xor(ss, 16); ss += __shfl_xor(ss, 32);
                if (fq == 0) rsq[(size_t)row * 16 + u.pn * 4 + wc] = ss;
            }
        }
    }
};

struct EpiResidB {
    static constexpr bool PERM = false, AFTER_DRAIN = false;
    bf16_t* hb; float* rsq; const float* rs_in;
    __device__ __forceinline__ void operator()(const f32x4 (&acc)[2][2][4][2], const Unit& u, int wr, int wc, int fr, int fq) const {
        const int col0 = u.pn * BM + wc * 32 + 4 * fq;
#pragma unroll
        for (int ai = 0; ai < 2; ++ai) {
            u32x2 pre[2][4][2][2]; f32x4 prs[4]; float sc2[4];
#pragma unroll
            for (int m = 0; m < 4; ++m) prs[m] = rs_in ? *(const f32x4*)(rs_in + (size_t)(u.pm * BM + ai * HALF + wr * 64 + m * 16 + fr) * 16 + 4 * fq) : (f32x4){0.f, 0.f, 0.f, 0.f};
#pragma unroll
            for (int m = 0; m < 4; ++m) { const size_t off = (size_t)(u.pm * BM + ai * HALF + wr * 64 + m * 16 + fr) * 1024 + col0;
#pragma unroll
                for (int bj = 0; bj < 2; ++bj)
#pragma unroll
                    for (int n = 0; n < 2; ++n) pre[ai][m][bj][n] = *(const u32x2*)(hb + off + bj * HALF + n * 16); }
#pragma unroll
            for (int m = 0; m < 4; ++m) { float s = (prs[m][0] + prs[m][1]) + (prs[m][2] + prs[m][3]); s += __shfl_xor(s, 16); s += __shfl_xor(s, 32);
                sc2[m] = rs_in ? 1.0f / (s * (1.0f / 1024.0f) + 1e-6f) : 1.0f; }
#pragma unroll
            for (int m = 0; m < 4; ++m) {
                const int row = u.pm * BM + ai * HALF + wr * 64 + m * 16 + fr; const size_t off = (size_t)row * 1024 + col0;
                float ss = 0.f;
#pragma unroll
                for (int bj = 0; bj < 2; ++bj)
#pragma unroll
                    for (int n = 0; n < 2; ++n) {
                        const u32x2 p = pre[ai][m][bj][n];
                        f32x4 o; o[0] = __builtin_bit_cast(float, p.x << 16); o[1] = __builtin_bit_cast(float, p.x & 0xffff0000u); o[2] = __builtin_bit_cast(float, p.y << 16); o[3] = __builtin_bit_cast(float, p.y & 0xffff0000u);
                        o = o + acc[ai][bj][m][n] * sc2[m];
                        u32x2 w; w.x = cvt_pk_bf16(o[0], o[1]); w.y = cvt_pk_bf16(o[2], o[3]);
                        *(u32x2*)(hb + off + bj * HALF + n * 16) = w;
                        ss += (o[0] * o[0] + o[1] * o[1]) + (o[2] * o[2] + o[3] * o[3]);
                    }
                ss += __shfl_xor(ss, 16); ss += __shfl_xor(ss, 32);
                if (fq == 0) rsq[(size_t)row * 16 + u.pn * 4 + wc] = ss;
            }
        }
    }
};
template <class Epi, class Sched, bool ALIGN_EPI = false, bool SP2 = false>
__device__ __forceinline__ void gemm_phase(PG8_LAS unsigned char* lds, const Gemm g, const Sched& S, const Epi& E) {
    int tid_ = threadIdx.x; asm volatile("" : "+v"(tid_)); const int tid = tid_, wid = __builtin_amdgcn_readfirstlane(tid >> 6), lane = tid & 63, wr = wid >> 2, wc = wid & 3, fr = lane & 15, fq = lane >> 4;
    const int K = g.K, nt = K / BK;
    unsigned voffA[2], voffB[2];
#pragma unroll
    for (int i = 0; i < 2; ++i) { int R, C; stage_rc(tid * 16 + i * 8192, R, C); const int Rb = Epi::PERM ? ((R & ~31) + perm32(R & 31)) : R;
        voffA[i] = (unsigned)(R * K + C) * 2u; voffB[i] = (unsigned)(Rb * K + C) * 2u; }
    const size_t kstep = (size_t)(BK * 2);
    const size_t hstep = (size_t)HALF * K * 2;
    const size_t tstep = 2 * hstep;
    const unsigned ldsw = (unsigned)wid * 1024u;
    const int aoff = lds_byte(wr * 64 + fr, fq * 8), boff = lds_byte(wc * 32 + fr, fq * 8);
#define PG8_SA(b, h) (((b) * 2 + (h)) * HTB)
#define PG8_SB(b, h) ((4 + (b) * 2 + (h)) * HTB)
#define PG8_STAGE(bufoff, gbase, voff) do { _Pragma("unroll") for (int _i = 0; _i < 2; ++_i) \
        __builtin_amdgcn_global_load_lds((const unsigned*)((const char*)(gbase) + (voff)[_i]), (PG8_LAS unsigned*)(lds + (bufoff) + ldsw + _i * 8192), 16, 0, 0); } while (0)
#define PG8_LDA(dst, b, h) do { _Pragma("unroll") for (int m = 0; m < 4; ++m) _Pragma("unroll") for (int k = 0; k < 2; ++k) dst[m][k] = *(const PG8_LAS bf16x8*)(lds + PG8_SA(b, h) + aoff + m * 2048 + k * 1024); } while (0)
#define PG8_LDB(dst, b, h) do { _Pragma("unroll") for (int n = 0; n < 2; ++n) _Pragma("unroll") for (int k = 0; k < 2; ++k) dst[n][k] = *(const PG8_LAS bf16x8*)(lds + PG8_SB(b, h) + boff + n * 2048 + k * 1024); } while (0)
#define PG8_MMA(ai, bj, At, Bt) do { __builtin_amdgcn_s_setprio(1); _Pragma("unroll") for (int m = 0; m < 4; ++m) _Pragma("unroll") for (int n = 0; n < 2; ++n) _Pragma("unroll") for (int k = 0; k < 2; ++k) \
        acc[ai][bj][m][n] = __builtin_amdgcn_mfma_f32_16x16x32_bf16(Bt[n][k], At[m][k], acc[ai][bj][m][n], 0, 0, 0); __builtin_amdgcn_s_setprio(0); } while (0)
#define PG8_WAIT_V(n) asm volatile("s_waitcnt vmcnt(" #n ")" ::: "memory")
#define PG8_WAIT_L(n) asm volatile("s_waitcnt lgkmcnt(" #n ")" ::: "memory")
#define PG8_BAR __builtin_amdgcn_s_barrier()
#define PG8_SCHED __builtin_amdgcn_sched_barrier(0)
    Unit cur, nxt; int ui = 0;
    if (!S.next(0, cur)) return;
    f32x4 acc[2][2][4][2];
#pragma unroll
    for (int a = 0; a < 2; ++a)
#pragma unroll
        for (int b = 0; b < 2; ++b)
#pragma unroll
            for (int m = 0; m < 4; ++m)
#pragma unroll
                for (int n = 0; n < 2; ++n) acc[a][b][m][n] = (f32x4){0.f, 0.f, 0.f, 0.f};
    bf16x8 At[4][2], B0[2][2], B1[2][2];
    const char* cA = (const char*)g.A + (size_t)cur.pm * tstep; const char* cB = (const char*)g.Bt + (size_t)cur.pn * tstep;
    S.a_ready(cur);
    if constexpr (SP2) {
        PG8_STAGE(PG8_SB(0, 0), cB, voffB); PG8_STAGE(PG8_SB(0, 1), cB + hstep, voffB); PG8_STAGE(PG8_SA(0, 0), cA, voffA); PG8_STAGE(PG8_SA(0, 1), cA + hstep, voffA);
        if (wr == 1) PG8_BAR;
        PG8_WAIT_V(2); PG8_BAR;
        PG8_STAGE(PG8_SB(1, 0), cB + kstep, voffB); PG8_STAGE(PG8_SA(1, 0), cA + kstep, voffA); PG8_STAGE(PG8_SB(1, 1), cB + hstep + kstep, voffB);
        PG8_WAIT_V(6); PG8_BAR;
    } else {
        PG8_STAGE(PG8_SB(0, 0), cB, voffB); PG8_STAGE(PG8_SA(0, 0), cA, voffA); PG8_STAGE(PG8_SB(0, 1), cB + hstep, voffB); PG8_STAGE(PG8_SA(0, 1), cA + hstep, voffA);
        if (wr == 1) PG8_BAR;
        PG8_WAIT_V(4); PG8_BAR;
        PG8_STAGE(PG8_SB(1, 0), cB + kstep, voffB); PG8_STAGE(PG8_SA(1, 0), cA + kstep, voffA); PG8_STAGE(PG8_SB(1, 1), cB + hstep + kstep, voffB);
        PG8_WAIT_V(6); PG8_BAR;
    }
    for (;;) {
        const bool has_next = S.next(ui + 1, nxt);
        const char* nA = has_next ? (const char*)g.A + (size_t)nxt.pm * tstep : cA; const char* nB = has_next ? (const char*)g.Bt + (size_t)nxt.pn * tstep : cB;
        for (int t = 0; t < nt; t += 2) {
            const bool last = (t == nt - 2);
            const char* a1 = cA + (size_t)(t + 1) * kstep;
            const char* a2 = last ? nA : cA + (size_t)(t + 2) * kstep; const char* b2 = last ? nB : cB + (size_t)(t + 2) * kstep;
            const char* a3 = a2 + kstep; const char* b3 = b2 + kstep;
            if (last && has_next) S.a_ready(nxt);
            if constexpr (SP2) {
            PG8_LDB(B0, 0, 0); PG8_LDB(B1, 0, 1); PG8_SCHED; PG8_LDA(At, 0, 0); PG8_STAGE(PG8_SA(1, 1), a1 + hstep, voffA);
            PG8_WAIT_V(8); PG8_WAIT_L(0); PG8_BAR; PG8_MMA(0, 0, At, B0); PG8_MMA(0, 1, At, B1); PG8_BAR; PG8_SCHED;
            PG8_LDA(At, 0, 1); PG8_STAGE(PG8_SB(0, 0), b2, voffB); PG8_STAGE(PG8_SB(0, 1), b2 + hstep, voffB); PG8_STAGE(PG8_SA(0, 0), a2, voffA);
            PG8_WAIT_V(8); PG8_WAIT_L(0); PG8_BAR; PG8_MMA(1, 0, At, B0); PG8_MMA(1, 1, At, B1); PG8_BAR; PG8_SCHED;
            PG8_LDB(B0, 1, 0); PG8_LDB(B1, 1, 1); PG8_SCHED; PG8_LDA(At, 1, 0); PG8_STAGE(PG8_SA(0, 1), a2 + hstep, voffA);
            PG8_WAIT_V(8); PG8_WAIT_L(0); PG8_BAR; PG8_MMA(0, 0, At, B0); PG8_MMA(0, 1, At, B1); PG8_BAR; PG8_SCHED;
            PG8_LDA(At, 1, 1); PG8_STAGE(PG8_SB(1, 0), b3, voffB); PG8_STAGE(PG8_SB(1, 1), b3 + hstep, voffB); PG8_STAGE(PG8_SA(1, 0), a3, voffA);
            PG8_WAIT_V(8); PG8_WAIT_L(0); PG8_BAR; PG8_MMA(1, 0, At, B0); PG8_MMA(1, 1, At, B1); PG8_BAR; PG8_SCHED;
            } else {
            PG8_LDB(B0, 0, 0); PG8_SCHED; PG8_LDA(At, 0, 0); PG8_STAGE(PG8_SA(1, 1), a1 + hstep, voffA);
            PG8_WAIT_L(8); PG8_BAR; PG8_WAIT_L(0); PG8_MMA(0, 0, At, B0); PG8_BAR; PG8_SCHED;
            PG8_LDB(B1, 0, 1); PG8_STAGE(PG8_SB(0, 0), b2, voffB);
            PG8_BAR; PG8_WAIT_L(0); PG8_MMA(0, 1, At, B1); PG8_BAR;
            PG8_LDA(At, 0, 1); PG8_STAGE(PG8_SA(0, 0), a2, voffA);
            PG8_BAR; PG8_WAIT_L(0); PG8_MMA(1, 0, At, B0); PG8_BAR; PG8_SCHED;
            PG8_STAGE(PG8_SB(0, 1), b2 + hstep, voffB);
            PG8_WAIT_V(6); PG8_BAR; PG8_MMA(1, 1, At, B1); PG8_BAR;
            PG8_LDB(B0, 1, 0); PG8_SCHED; PG8_LDA(At, 1, 0); PG8_STAGE(PG8_SA(0, 1), a2 + hstep, voffA);
            PG8_WAIT_L(8); PG8_BAR; PG8_WAIT_L(0); PG8_MMA(0, 0, At, B0); PG8_BAR; PG8_SCHED;
            PG8_LDB(B1, 1, 1); PG8_STAGE(PG8_SB(1, 0), b3, voffB);
            PG8_BAR; PG8_WAIT_L(0); PG8_MMA(0, 1, At, B1); PG8_BAR;
            PG8_LDA(At, 1, 1); PG8_STAGE(PG8_SA(1, 0), a3, voffA);
            PG8_BAR; PG8_WAIT_L(0); PG8_MMA(1, 0, At, B0); PG8_BAR; PG8_SCHED;
            PG8_STAGE(PG8_SB(1, 1), b3 + hstep, voffB);
            PG8_WAIT_V(6); PG8_BAR; PG8_MMA(1, 1, At, B1); PG8_BAR;
            }
        }
        if constexpr (ALIGN_EPI) { if (wr == 0) PG8_BAR; }
        if constexpr (!Epi::AFTER_DRAIN) { E(acc, cur, wr, wc, fr, fq); S.done(cur); }
        if (!has_next) break;
#pragma unroll
        for (int a = 0; a < 2; ++a)
#pragma unroll
            for (int b = 0; b < 2; ++b)
#pragma unroll
                for (int m = 0; m < 4; ++m)
#pragma unroll
                    for (int n = 0; n < 2; ++n) acc[a][b][m][n] = (f32x4){0.f, 0.f, 0.f, 0.f};
        cur = nxt; cA = nA; cB = nB; ++ui;
        if constexpr (ALIGN_EPI) { if (wr == 1) PG8_BAR; }
    }
    PG8_WAIT_V(0);
    if constexpr (!ALIGN_EPI) { if (wr == 0) PG8_BAR; }
    PG8_BAR;
    if constexpr (Epi::AFTER_DRAIN) { E.fused(acc, cur, wr, wc, fr, fq, lds, wid, lane); S.done(cur); }
#undef PG8_SA
#undef PG8_SB
#undef PG8_STAGE
#undef PG8_LDA
#undef PG8_LDB
#undef PG8_MMA
#undef PG8_WAIT_V
#undef PG8_WAIT_L
#undef PG8_BAR
#undef PG8_SCHED
}
}
#define GAS __attribute__((address_space(1)))
#define LAS __attribute__((address_space(3)))
typedef unsigned short bf16;
typedef unsigned v4u __attribute__((ext_vector_type(4)));
typedef unsigned v2u __attribute__((ext_vector_type(2)));
typedef float f32x4 __attribute__((ext_vector_type(4)));
typedef short bf16x8 __attribute__((ext_vector_type(8)));
#ifndef REP_HG
#define REP_HG 1
#endif
#ifndef REP_RW
#define REP_RW 1
#endif
#ifndef REP_UP
#define REP_UP 1
#endif
#ifndef REP_ATT
#define REP_ATT 1
#endif
#ifndef REP_PRO
#define REP_PRO 1
#endif
#ifndef REP_G1
#define REP_G1 1
#endif
#ifndef REP_G2
#define REP_G2 1
#endif
#ifndef REP_SC
#define REP_SC 1
#endif
#ifndef REP_DN
#define REP_DN 1
#endif
#ifndef REP_OUT
#define REP_OUT 1
#endif
#ifndef REP_HGL
#define REP_HGL 1
#endif
#ifndef REP_IN
#define REP_IN 1
#endif
#ifndef REP_SYNC
#define REP_SYNC 1
#endif
#define GRID_SYNC() do { for (int r_ = 0; r_ < REP_SYNC; ++r_) xcd_barrier(xbar); } while (0)
constexpr int NWAVES = 8, NTHR = 512;
constexpr int M = 32768, D = 1024, SEQ = 8192, FF = 4096;
constexpr size_t MiB = 1u << 20;
constexpr size_t WS_BAR = 64 * 1024, WS_BAR_BYTES = 16 * 1024;
constexpr size_t WS_LBK = 0;
constexpr size_t WS_RS = 1 * MiB;
constexpr size_t WS_WA = 4 * MiB, WS_WB = 18 * MiB, WS_WO = 20 * MiB, WS_WUP = 22 * MiB, WS_WDN = 30 * MiB;
constexpr size_t WS_HB = 38 * MiB;
constexpr size_t WS_BIG = 102 * MiB;
constexpr size_t SLOT = 64 * MiB;
constexpr size_t WS_END = 512 * MiB;
constexpr int LDS_BYTES = 163840;
constexpr float LOG2E_F = 1.4426950408889634f;

#define LDS_WAIT() asm volatile("s_waitcnt lgkmcnt(0)" ::: "memory")
typedef float f32x2_t __attribute__((ext_vector_type(2))); typedef __bf16 bf16x2_t __attribute__((ext_vector_type(2)));
__device__ __forceinline__ unsigned pk2(float lo, float hi) { const f32x2_t v = {lo, hi}; const bf16x2_t b = __builtin_convertvector(v, bf16x2_t); return __builtin_bit_cast(unsigned, b); }
__device__ __forceinline__ unsigned f2bf(float f) { return pk2(f, 0.f) & 0xffffu; }
__device__ __forceinline__ float bflo(unsigned u) { return __builtin_bit_cast(float, u << 16); }
__device__ __forceinline__ float bfhi(unsigned u) { return __builtin_bit_cast(float, u & 0xffff0000u); }
__device__ __forceinline__ float bf1(unsigned short b) { return __builtin_bit_cast(float, (unsigned)b << 16); }
__device__ __forceinline__ f32x4 bf4(v2u u) { return (f32x4){bflo(u.x), bfhi(u.x), bflo(u.y), bfhi(u.y)}; }
__device__ __forceinline__ float wave_sum(float v) {
#pragma unroll
    for (int o = 1; o < 64; o <<= 1) v += __shfl_xor(v, o);
    return v;
}
template <int CTRL> __device__ __forceinline__ float dpp_f(float x) { return __builtin_bit_cast(float, __builtin_amdgcn_update_dpp(0, __builtin_bit_cast(int, x), CTRL, 0xf, 0xf, true)); }
__device__ __forceinline__ float row16_sum(float x) { x += dpp_f<0xB1>(x); x += dpp_f<0x4E>(x); x += dpp_f<0x141>(x); x += dpp_f<0x140>(x); return x; }

__device__ __forceinline__ void wt_item(const float* W, int K, int N, bf16* WT, int ld, int row_off, int col_off, const float* sc, LAS float* scr, int item, int lane) {
    const int nblk = N / 32, kb = item / nblk, nb = item % nblk, k0 = 64 * kb, n0 = 32 * nb;
    f32x4 wv[8]; float sv[8];
#pragma unroll
    for (int i = 0; i < 8; ++i) { const int kk = 8 * i + (lane >> 3); wv[i] = *(const f32x4*)(W + (size_t)(k0 + kk) * N + n0 + 4 * (lane & 7)); sv[i] = sc ? sc[k0 + kk] : 1.f; }
#pragma unroll
    for (int i = 0; i < 8; ++i) { const int kk = 8 * i + (lane >> 3); LAS float* d = scr + kk * 33 + 4 * (lane & 7); d[0] = wv[i][0] * sv[i]; d[1] = wv[i][1] * sv[i]; d[2] = wv[i][2] * sv[i]; d[3] = wv[i][3] * sv[i]; }
    LDS_WAIT(); asm volatile("" ::: "memory");
    const int c = lane & 7;
#pragma unroll
    for (int j = 0; j < 4; ++j) { const int n = (lane >> 3) + 8 * j; const LAS float* s = scr + (8 * c) * 33 + n;
        v4u o; o.x = pk2(s[0 * 33], s[1 * 33]); o.y = pk2(s[2 * 33], s[3 * 33]); o.z = pk2(s[4 * 33], s[5 * 33]); o.w = pk2(s[6 * 33], s[7 * 33]);
        *(v4u*)(WT + (size_t)(row_off + n0 + n) * ld + col_off + k0 + 8 * c) = o; }
    LDS_WAIT(); asm volatile("" ::: "memory");
}
__device__ __forceinline__ void conv_mat(const float* W, int K, int N, bf16* WT, int ld, int row_off, int col_off, const float* sc, LAS float* scr, int gw, int ngw, int lane) {
    const int nitems = (K / 64) * (N / 32);
    for (int it = gw; it < nitems; it += ngw) wt_item(W, K, N, WT, ld, row_off, col_off, sc, scr, it, lane);
}

__device__ __forceinline__ void attn_phase(const bf16* Q, const bf16* K, const bf16* V, bf16* O, int gw, int ngw, int lane) {
    const int fr = lane & 15, fq = lane >> 4;
    for (int unit = gw; unit < (M / 16) * 16; unit += ngw) {
        const int qt = unit & 511, bh = unit >> 9, h = bh & 15, b = bh >> 4;
        const int t0 = qt * 16; const size_t rowb = (size_t)b * SEQ;
        const bf16* qp = Q + (rowb + t0 + fr) * 1024 + h * 64 + fq * 8;
        const bf16x8 qb0 = *(const bf16x8*)(qp), qb1 = *(const bf16x8*)(qp + 32);
        f32x4 o[4];
#pragma unroll
        for (int dt = 0; dt < 4; ++dt) o[dt] = (f32x4){0.f, 0.f, 0.f, 0.f};
        float carry = 1.f;
        const int tq = t0 + fr;
        bf16x8 kn0, kn1; unsigned short vn[4][4];
#define ATT_LOAD(SH) { int sk_ = (SH) - fr; sk_ = sk_ < 0 ? 0 : sk_; const bf16* kp_ = K + (rowb + sk_) * 1024 + h * 64 + fq * 8; kn0 = *(const bf16x8*)(kp_); kn1 = *(const bf16x8*)(kp_ + 32); \
            _Pragma("unroll") for (int j = 0; j < 4; ++j) { int sv_ = (SH) - (4 * fq + j); sv_ = sv_ < 0 ? 0 : sv_; const bf16* vp_ = V + (rowb + sv_) * 1024 + h * 64 + fr; \
                _Pragma("unroll") for (int dt = 0; dt < 4; ++dt) vn[dt][j] = vp_[16 * dt]; } }
        ATT_LOAD(t0 + 14)
        for (int s_hi = t0 + 14; s_hi >= 0; s_hi -= 16) {
            const bf16x8 ka0 = kn0, ka1 = kn1;
            unsigned short vv[4][4];
#pragma unroll
            for (int j = 0; j < 4; ++j)
#pragma unroll
                for (int dt = 0; dt < 4; ++dt) vv[dt][j] = vn[dt][j];
            ATT_LOAD(s_hi - 16)
            f32x4 z = (f32x4){0.f, 0.f, 0.f, 0.f};
            z = __builtin_amdgcn_mfma_f32_16x16x32_bf16(ka0, qb0, z, 0, 0, 0);
            z = __builtin_amdgcn_mfma_f32_16x16x32_bf16(ka1, qb1, z, 0, 0, 0);
            float dd[4], sg[4];
#pragma unroll
            for (int i = 0; i < 4; ++i) {
                const int s = s_hi - (4 * fq + i);
                const bool valid = (s >= 0) && (s < tq);
                const float e = __builtin_amdgcn_exp2f(fminf(z[i], 100.f));
                const float d = __builtin_amdgcn_rcpf(1.0f + e);
                dd[i] = valid ? d : 1.f; sg[i] = valid ? e * d : 0.f;
            }
            const float c1 = dd[0], c2 = c1 * dd[1], c3 = c2 * dd[2], g = c3 * dd[3];
            const float g0 = __shfl(g, fr), g1 = __shfl(g, fr + 16), g2 = __shfl(g, fr + 32), g3 = __shfl(g, fr + 48);
            float pre = carry;
            if (fq > 0) pre *= g0;
            if (fq > 1) pre *= g1;
            if (fq > 2) pre *= g2;
            carry = carry * ((g0 * g1) * (g2 * g3));
            const float p0 = sg[0] * pre, p1 = sg[1] * (pre * c1), p2 = sg[2] * (pre * c2), p3 = sg[3] * (pre * c3);
            bf16x8 pb; { const unsigned w0 = pk2(p0, p1), w1 = pk2(p2, p3); pb[0] = (short)(w0 & 0xffff); pb[1] = (short)(w0 >> 16); pb[2] = (short)(w1 & 0xffff); pb[3] = (short)(w1 >> 16); pb[4] = 0; pb[5] = 0; pb[6] = 0; pb[7] = 0; }
#pragma unroll
            for (int dt = 0; dt < 4; ++dt) {
                bf16x8 va; va[0] = (short)vv[dt][0]; va[1] = (short)vv[dt][1]; va[2] = (short)vv[dt][2]; va[3] = (short)vv[dt][3]; va[4] = 0; va[5] = 0; va[6] = 0; va[7] = 0;
                o[dt] = __builtin_amdgcn_mfma_f32_16x16x32_bf16(va, pb, o[dt], 0, 0, 0);
            }
            if (__builtin_amdgcn_ballot_w64(carry != 0.f) == 0ull) break;
        }
#undef ATT_LOAD
        bf16* op = O + (rowb + t0 + fr) * 1024 + h * 64 + fq * 4;
#pragma unroll
        for (int dt = 0; dt < 4; ++dt) { v2u w; w.x = pk2(o[dt][0], o[dt][1]); w.y = pk2(o[dt][2], o[dt][3]); *(v2u*)(op + 16 * dt) = w; }
    }
}

typedef unsigned u32x4_t __attribute__((ext_vector_type(4)));
__device__ __forceinline__ bf16x8 mk8(unsigned a, unsigned b, unsigned c, unsigned d) { const u32x4_t t = {a, b, c, d}; return __builtin_bit_cast(bf16x8, t); }
__device__ __forceinline__ void hg_prep_item(const bf16* QS, const bf16* KF, bf16* QTL, bf16* KTLb, bf16* KT, float* DB, int chunk, int c) {
    {
        const size_t base = (size_t)chunk * 16 * 1024 + c;
        v2u kin[16], qin[16];
#pragma unroll
        for (int t = 0; t < 16; ++t) { kin[t] = *(const v2u*)(KF + base + (size_t)t * 1024); qin[t] = *(const v2u*)(QS + base + (size_t)t * 1024); }
        float b[4] = {0.f, 0.f, 0.f, 0.f};
        unsigned ktp[4][8];
#pragma unroll
        for (int t2 = 0; t2 < 8; ++t2) {
            float kt2[2][4];
#pragma unroll
            for (int u = 0; u < 2; ++u) {
                const int t = 2 * t2 + u;
                const f32x4 kf = bf4(kin[t]), q = bf4(qin[t]);
                float qt[4];
#pragma unroll
                for (int j = 0; j < 4; ++j) {
                    const float fdec = fmaxf(1.0f - kf[j], 1e-4f);
                    b[j] += __builtin_amdgcn_logf(fdec);
                    const float e = __builtin_amdgcn_exp2f(b[j]);
                    qt[j] = q[j] * e; kt2[u][j] = kf[j] * __builtin_amdgcn_rcpf(e);
                }
                const size_t tof = ((((size_t)chunk * 8 + (c >> 7)) * 8 + ((c & 127) >> 4)) * 16 + t) * 16 + (c & 15);
                v2u qo; qo.x = pk2(qt[0], qt[1]); qo.y = pk2(qt[2], qt[3]); *(v2u*)(QTL + tof) = qo;
                v2u ko; ko.x = pk2(kt2[u][0], kt2[u][1]); ko.y = pk2(kt2[u][2], kt2[u][3]); *(v2u*)(KTLb + tof) = ko;
            }
#pragma unroll
            for (int j = 0; j < 4; ++j) ktp[j][t2] = pk2(kt2[0][j], kt2[1][j]);
        }
        f32x4 dv; dv[0] = __builtin_amdgcn_exp2f(b[0]); dv[1] = __builtin_amdgcn_exp2f(b[1]); dv[2] = __builtin_amdgcn_exp2f(b[2]); dv[3] = __builtin_amdgcn_exp2f(b[3]);
        *(f32x4*)(DB + (size_t)chunk * 1024 + c) = dv;
#pragma unroll
        for (int j = 0; j < 4; ++j) { v4u* kp = (v4u*)(KT + ((size_t)chunk * 1024 + c + j) * 16);
            kp[0] = (v4u){ktp[j][0], ktp[j][1], ktp[j][2], ktp[j][3]}; kp[1] = (v4u){ktp[j][4], ktp[j][5], ktp[j][6], ktp[j][7]}; }
    }
}
__device__ __forceinline__ void hg_local(const bf16* QS, const bf16* KF, bf16* QTL, bf16* KTLb, bf16* KT, const bf16* IV, float* DB, float* SL, float* DT) {
    int tid_ = threadIdx.x; asm volatile("" : "+v"(tid_)); const int tid = tid_, lane = tid & 63, w = __builtin_amdgcn_readfirstlane(tid >> 6), fr = lane & 15, fq = lane >> 4;
    for (int unit = blockIdx.x; unit < 256; unit += gridDim.x) {
        const int seg = unit & 7, bh = unit >> 3, h = bh & 7, b = bh >> 3;
#pragma unroll 1
        for (int ps = 0; ps < 4; ++ps) hg_prep_item(QS, KF, QTL, KTLb, KT, DB, (int)((((size_t)b * SEQ + (size_t)seg * 1024) >> 4) + 16 * ps + 2 * w + (lane >> 5)), 128 * h + 4 * (lane & 31));
        asm volatile("s_waitcnt vmcnt(0)" ::: "memory"); __syncthreads();
        if (seg == 7) continue;
        f32x4 S[8], DTt[8];
#pragma unroll
        for (int kt = 0; kt < 8; ++kt) { S[kt] = (f32x4){0.f, 0.f, 0.f, 0.f}; DTt[kt] = (f32x4){1.f, 1.f, 1.f, 1.f}; }
        const size_t m0 = (size_t)b * SEQ + (size_t)seg * 1024;
        v2u kt1[8], kt2[8]; f32x4 d1[8], d2[8]; unsigned short v1_[4], v2_[4];
#define HGL_LOAD(KTV, DV, VV, CJ) { const int cj_ = (CJ) < 64 ? (CJ) : 63; const size_t chunk_ = (m0 >> 4) + cj_, mrow_ = m0 + 16 * cj_; \
          _Pragma("unroll") for (int kt = 0; kt < 8; ++kt) { KTV[kt] = *(const v2u*)(KT + (chunk_ * 1024 + 128 * h + 16 * kt + fr) * 16 + 4 * fq); DV[kt] = *(const f32x4*)(DB + chunk_ * 1024 + 128 * h + 16 * kt + 4 * fq); } \
          const bf16* vp_ = IV + (mrow_ + 4 * fq) * 1024 + 128 * h + 16 * w + fr; VV[0] = vp_[0]; VV[1] = vp_[1024]; VV[2] = vp_[2048]; VV[3] = vp_[3072]; }
        HGL_LOAD(kt1, d1, v1_, 0) HGL_LOAD(kt2, d2, v2_, 1)
        for (int ci = 0; ci < 64; ++ci) {
            v2u ktv[8]; f32x4 dv[8];
#pragma unroll
            for (int kt = 0; kt < 8; ++kt) { ktv[kt] = kt1[kt]; dv[kt] = d1[kt]; kt1[kt] = kt2[kt]; d1[kt] = d2[kt]; }
            const unsigned v0 = v1_[0], v1 = v1_[1], v2 = v1_[2], v3 = v1_[3];
#pragma unroll
            for (int x = 0; x < 4; ++x) v1_[x] = v2_[x];
            HGL_LOAD(kt2, d2, v2_, ci + 2)
            const bf16x8 vb = mk8(v0 | (v1 << 16), v2 | (v3 << 16), 0u, 0u);
#pragma unroll
            for (int kt = 0; kt < 8; ++kt) { S[kt] = __builtin_amdgcn_mfma_f32_16x16x32_bf16(mk8(ktv[kt].x, ktv[kt].y, 0u, 0u), vb, S[kt], 0, 0, 0); S[kt] = S[kt] * dv[kt]; DTt[kt] = DTt[kt] * dv[kt]; }
        }
#undef HGL_LOAD
#pragma unroll
        for (int kt = 0; kt < 8; ++kt) {
#pragma unroll
            for (int i = 0; i < 4; ++i) SL[((size_t)(bh * 8 + seg) * 128 + 16 * kt + 4 * fq + i) * 128 + 16 * w + fr] = S[kt][i];
            if (w == 0 && fr == 0) *(f32x4*)(DT + (size_t)(bh * 8 + seg) * 128 + 16 * kt + 4 * fq) = DTt[kt];
        }
    }
}
__device__ __forceinline__ void hg_out(const bf16* QT, const bf16* KTL, const bf16* KT, const bf16* IV, const float* DB, const float* SL, const float* DT, const float* norm_g, bf16* SGO, LAS unsigned char* lds) {
    int tid_ = threadIdx.x; asm volatile("" : "+v"(tid_)); const int tid = tid_, lane = tid & 63, w = __builtin_amdgcn_readfirstlane(tid >> 6), fr = lane & 15, fq = lane >> 4;
    LAS float* ssb = (LAS float*)lds;
    for (int unit = blockIdx.x; unit < 256; unit += gridDim.x) {
        const int seg = unit & 7, bh = unit >> 3, h = bh & 7, b = bh >> 3;
        f32x4 S[8];
#pragma unroll
        for (int kt = 0; kt < 8; ++kt) S[kt] = (f32x4){0.f, 0.f, 0.f, 0.f};
        for (int j = 0; j < seg; ++j) {
#pragma unroll
            for (int kt = 0; kt < 8; ++kt) {
                const f32x4 dt = *(const f32x4*)(DT + (size_t)(bh * 8 + j) * 128 + 16 * kt + 4 * fq);
#pragma unroll
                for (int i = 0; i < 4; ++i) S[kt][i] = S[kt][i] * dt[i] + SL[((size_t)(bh * 8 + j) * 128 + 16 * kt + 4 * fq + i) * 128 + 16 * w + fr];
            }
        }
        const float ng = norm_g[128 * h + 16 * w + fr];
        const size_t m0 = (size_t)b * SEQ + (size_t)seg * 1024;
        v2u q1[8], k1[8], q2[8], k2[8]; unsigned short vn[4], gn[4];
#define HGO_LOAD(QV, KV, CJ) { const int cj_ = (CJ) < 64 ? (CJ) : 63; const size_t tb_ = ((((m0 >> 4) + cj_) * 8 + h) * 8) * 256 + fr * 16 + 4 * fq; \
          _Pragma("unroll") for (int x = 0; x < 8; ++x) { QV[x] = *(const v2u*)(QT + tb_ + 256 * x); KV[x] = *(const v2u*)(KTL + tb_ + 256 * x); } }
#define HGO_LOADV(CJ) { const int cj_ = (CJ) < 64 ? (CJ) : 63; const size_t mn_ = m0 + 16 * cj_; \
          const bf16* vp_ = IV + (mn_ + 4 * fq) * 1024 + 128 * h + 16 * w + fr; const bf16* gq_ = SGO + (mn_ + 4 * fq) * 1024 + 128 * h + 16 * w + fr; \
          vn[0] = vp_[0]; vn[1] = vp_[1024]; vn[2] = vp_[2048]; vn[3] = vp_[3072]; gn[0] = gq_[0]; gn[1] = gq_[1024]; gn[2] = gq_[2048]; gn[3] = gq_[3072]; }
        HGO_LOAD(q1, k1, 0) HGO_LOAD(q2, k2, 1) HGO_LOADV(0)
        for (int ci = 0; ci < 64; ++ci) {
            const size_t chunk = (m0 >> 4) + ci, mrow = m0 + 16 * ci;
            v2u ktv[8]; f32x4 dv[8];
#pragma unroll
            for (int kt = 0; kt < 8; ++kt) { ktv[kt] = *(const v2u*)(KT + (chunk * 1024 + 128 * h + 16 * kt + fr) * 16 + 4 * fq); dv[kt] = *(const f32x4*)(DB + chunk * 1024 + 128 * h + 16 * kt + 4 * fq); }
            const unsigned v0 = vn[0], v1 = vn[1], v2 = vn[2], v3 = vn[3];
            bf16* gp = SGO + (mrow + 4 * fq) * 1024 + 128 * h + 16 * w + fr;
            const float sg0 = bf1(gn[0]), sg1 = bf1(gn[1]), sg2 = bf1(gn[2]), sg3 = bf1(gn[3]);
            HGO_LOADV(ci + 1)
            v2u qc[8], kc[8];
#pragma unroll
            for (int x = 0; x < 8; ++x) { qc[x] = q1[x]; kc[x] = k1[x]; q1[x] = q2[x]; k1[x] = k2[x]; }
            HGO_LOAD(q2, k2, ci + 2)
            const bf16x8 vb = mk8(v0 | (v1 << 16), v2 | (v3 << 16), 0u, 0u);
            f32x4 pt = (f32x4){0.f, 0.f, 0.f, 0.f};
#pragma unroll
            for (int p = 0; p < 4; ++p) pt = __builtin_amdgcn_mfma_f32_16x16x32_bf16(mk8(kc[2 * p].x, kc[2 * p].y, kc[2 * p + 1].x, kc[2 * p + 1].y), mk8(qc[2 * p].x, qc[2 * p].y, qc[2 * p + 1].x, qc[2 * p + 1].y), pt, 0, 0, 0);
#pragma unroll
            for (int i = 0; i < 4; ++i) if (4 * fq + i > fr) pt[i] = 0.f;
            f32x4 o = (f32x4){0.f, 0.f, 0.f, 0.f};
#pragma unroll
            for (int p = 0; p < 4; ++p) {
                const bf16x8 sb = mk8(pk2(S[2 * p][0], S[2 * p][1]), pk2(S[2 * p][2], S[2 * p][3]), pk2(S[2 * p + 1][0], S[2 * p + 1][1]), pk2(S[2 * p + 1][2], S[2 * p + 1][3]));
                o = __builtin_amdgcn_mfma_f32_16x16x32_bf16(mk8(qc[2 * p].x, qc[2 * p].y, qc[2 * p + 1].x, qc[2 * p + 1].y), sb, o, 0, 0, 0);
            }
            o = __builtin_amdgcn_mfma_f32_16x16x32_bf16(mk8(pk2(pt[0], pt[1]), pk2(pt[2], pt[3]), 0u, 0u), vb, o, 0, 0, 0);
#pragma unroll
            for (int kt = 0; kt < 8; ++kt) { S[kt] = __builtin_amdgcn_mfma_f32_16x16x32_bf16(mk8(ktv[kt].x, ktv[kt].y, 0u, 0u), vb, S[kt], 0, 0, 0); S[kt] = S[kt] * dv[kt]; }
            LAS float* sb_ = ssb + (ci & 1) * 128;
#pragma unroll
            for (int i = 0; i < 4; ++i) { const float ss = row16_sum(o[i] * o[i]); if (fr == 0) sb_[(4 * fq + i) * 8 + w] = ss; }
            __syncthreads();
            const float sgv[4] = {sg0, sg1, sg2, sg3};
#pragma unroll
            for (int i = 0; i < 4; ++i) {
                const f32x4 a0 = *(const LAS f32x4*)(sb_ + (4 * fq + i) * 8), a1 = *(const LAS f32x4*)(sb_ + (4 * fq + i) * 8 + 4);
                const float tot = ((a0[0] + a0[1]) + (a0[2] + a0[3])) + ((a1[0] + a1[1]) + (a1[2] + a1[3]));
                const float r = 1.0f / sqrtf(tot * (1.0f / 128.0f) + 1e-6f);
                gp[(size_t)i * 1024] = (bf16)f2bf(o[i] * r * ng * sgv[i]);
            }
        }
#undef HGO_LOAD
#undef HGO_LOADV
        __syncthreads();
    }
}

__device__ __forceinline__ void rw_prep(const bf16* h, const float* rs, const float* g, bf16* A2, int gw, int ngw, int lane) {
    for (int it = gw; it < M / 2; it += ngw) {
        const int m = 2 * it, t = m & (SEQ - 1);
        const int mp = t ? m - 1 : m;
        f32x4 x[3][4], pr[3];
#pragma unroll
        for (int u = 0; u < 3; ++u) { const int mm = u == 0 ? mp : m + u - 1; pr[u] = *(const f32x4*)(rs + (size_t)mm * 16 + 4 * (lane & 3));
#pragma unroll
            for (int j = 0; j < 4; ++j) x[u][j] = bf4(*(const v2u*)(h + (size_t)mm * 1024 + 4 * lane + 256 * j)); }
        float r3[3];
#pragma unroll
        for (int u = 0; u < 3; ++u) { float s = (pr[u][0] + pr[u][1]) + (pr[u][2] + pr[u][3]); s += dpp_f<0xB1>(s); s += dpp_f<0x4E>(s); r3[u] = 1.0f / sqrtf(s * (1.0f / 1024.0f) + 1e-6f); }
        if (t == 0) r3[0] = 0.f;
#pragma unroll
        for (int j = 0; j < 4; ++j) {
            const int c = 4 * lane + 256 * j;
            const f32x4 gc = *(const f32x4*)(g + c);
            const f32x4 xp = x[0][j] * gc * r3[0], x0 = x[1][j] * gc * r3[1], x1 = x[2][j] * gc * r3[2];
            const f32x4 d0 = xp - x0, d1 = x0 - x1;
            v2u o;
            o.x = pk2(x0[0], x0[1]); o.y = pk2(x0[2], x0[3]); *(v2u*)(A2 + (size_t)m * 2048 + c) = o;
            o.x = pk2(d0[0], d0[1]); o.y = pk2(d0[2], d0[3]); *(v2u*)(A2 + (size_t)m * 2048 + 1024 + c) = o;
            o.x = pk2(x1[0], x1[1]); o.y = pk2(x1[2], x1[3]); *(v2u*)(A2 + (size_t)(m + 1) * 2048 + c) = o;
            o.x = pk2(d1[0], d1[1]); o.y = pk2(d1[2], d1[3]); *(v2u*)(A2 + (size_t)(m + 1) * 2048 + 1024 + c) = o;
        }
    }
}
constexpr int RWS_AH = 0, RWS_RB = 2048, RWS_KGT = 4096, RWS_BGT = 6144, RWS_G15 = 8192, RWS_KNI = 8448, RWS_WVI = 9472, RWS_VCI = 10496, RWS_SLOT = 11264;
constexpr int RWT_AB = 0, RWT_BT = 2048, RWT_KT = 4096, RWT_ABT = 6144, RWT_NM = 0  , RWT_TM = 2048  , RWT_BYTES = 8192;
__device__ __forceinline__ int rwz(int k) { return (k & ~7) | ((k & 7) ^ ((k >> 3) & 7)); }
constexpr int RW_NSLOT = 9, RW_NPROD = 7, RW_RING = RW_NSLOT * RWS_SLOT, RW_FLAGS = RW_RING + RW_NPROD * RWT_BYTES;
struct RwRaw4 { v2u r[4], k[4], wm[4], a[4]; unsigned short v[4]; };
__device__ __forceinline__ void rw_load4(RwRaw4& x, const bf16* R, const bf16* K, const bf16* V, const bf16* WM, const bf16* A, size_t m, int ch, int vch) {
#pragma unroll
    for (int j = 0; j < 4; ++j) { const size_t off = (m + j) * 1024 + ch;
        x.r[j] = *(const v2u*)(R + off); x.k[j] = *(const v2u*)(K + off); x.wm[j] = *(const v2u*)(WM + off); x.a[j] = *(const v2u*)(A + off); x.v[j] = V[(m + j) * 1024 + vch]; }
}
__device__ __forceinline__ bf16x8 lds_op16(const LAS unsigned char* mtx, int row, int kbyte) { return *(const LAS bf16x8*)(mtx + row * 128 + kbyte); }
__device__ __forceinline__ v2u lds_8(const LAS unsigned char* p) { return *(const LAS v2u*)p; }
__device__ __forceinline__ void rw_scan(const bf16* R, const bf16* K, const bf16* V, const bf16* WM, const bf16* A, const float* k_k, const float* k_a, bf16* Y, LAS unsigned char* lds) {
    int tid_ = threadIdx.x; asm volatile("" : "+v"(tid_)); const int tid = tid_, lane = tid & 63, w = __builtin_amdgcn_readfirstlane(tid >> 6);
    const int fr = lane & 15, fq = lane >> 4;
    constexpr int NCH = SEQ / 16;
    for (int unit = blockIdx.x; unit < 256; unit += gridDim.x) {
        const int rg = unit & 3, h = (unit >> 2) & 15, b = unit >> 6;
        const size_t row0 = (size_t)b * SEQ;
        volatile LAS unsigned* flg = (volatile LAS unsigned*)(lds + RW_FLAGS);
        if (tid < 16) flg[tid] = 0u;
        __syncthreads();
        if (w >= 1) {
            const int pw = w - 1, ch = 64 * h + 4 * fr, vch = 64 * h + 16 * rg + fr;
            LAS unsigned char* tmp = lds + RW_RING + pw * RWT_BYTES;
            const f32x4 kkc = *(const f32x4*)(k_k + ch), kac = *(const f32x4*)(k_a + ch);
            RwRaw4 nx; rw_load4(nx, R, K, V, WM, A, row0 + 16 * pw + 4 * fq, ch, vch);
            for (int cj = pw; cj < NCH; cj += RW_NPROD) {
                {
                    const RwRaw4 cu = nx;
                    { const int cn = cj + RW_NPROD < NCH ? cj + RW_NPROD : cj; rw_load4(nx, R, K, V, WM, A, row0 + 16 * (size_t)cn + 4 * fq, ch, vch); }
                    while ((int)flg[RW_NSLOT] < cj - (RW_NSLOT - 1)) __builtin_amdgcn_s_sleep(2);
                    asm volatile("" ::: "memory");
                    LAS unsigned char* slot = lds + (cj % RW_NSLOT) * RWS_SLOT;
                    f32x4 wv[4], kk[4], km[4], be[4], rr[4];
#pragma unroll
                    for (int j = 0; j < 4; ++j) {
                        const f32x4 r = bf4(cu.r[j]), k = bf4(cu.k[j]), wm = bf4(cu.wm[j]), a = bf4(cu.a[j]);
                        const f32x4 kr = k * kkc;
                        const float n2 = row16_sum((kr[0] * kr[0] + kr[1] * kr[1]) + (kr[2] * kr[2] + kr[3] * kr[3]));
                        const float inv = 1.0f / fmaxf(sqrtf(n2), 1e-12f);
                        kk[j] = kr * inv; be[j] = kk[j] * a; km[j] = k * (1.0f + (a - 1.0f) * kac); wv[j] = 1.0f - wm; rr[j] = r;
                    }
                    f32x4 g[4]; g[0] = wv[0]; g[1] = g[0] * wv[1]; g[2] = g[1] * wv[2]; g[3] = g[2] * wv[3];
                    f32x4 pre = (f32x4){1.f, 1.f, 1.f, 1.f}, all = (f32x4){1.f, 1.f, 1.f, 1.f};
#pragma unroll
                    for (int x = 0; x < 4; ++x) {
                        const float t0 = __shfl(g[3][x], fr), t1 = __shfl(g[3][x], 16 + fr), t2 = __shfl(g[3][x], 32 + fr), t3 = __shfl(g[3][x], 48 + fr);
                        float p = 1.f; if (fq > 0) p *= t0; if (fq > 1) p *= t1; if (fq > 2) p *= t2;
                        pre[x] = p; all[x] = (t0 * t1) * (t2 * t3);
                    }
                    unsigned kgp[4][2], bgp[4][2], abp[4][2];
                    float kgt[4][4], bgt[4][4], abt[4][4];
#pragma unroll
                    for (int j = 0; j < 4; ++j) {
                        const f32x4 Gs = pre * g[j], Gm = j ? pre * g[j - 1] : pre;
                        f32x4 ginv; ginv[0] = __builtin_amdgcn_rcpf(Gs[0]); ginv[1] = __builtin_amdgcn_rcpf(Gs[1]); ginv[2] = __builtin_amdgcn_rcpf(Gs[2]); ginv[3] = __builtin_amdgcn_rcpf(Gs[3]);
                        const f32x4 alb = kk[j] * Gm, rb = rr[j] * Gs, bet = be[j] * ginv, ktl = km[j] * ginv;
                        const int s = 4 * fq + j;
                        v2u o;
                        o.x = pk2(alb[0], alb[1]); o.y = pk2(alb[2], alb[3]); *(LAS v2u*)(tmp + RWT_AB + s * 128 + 8 * fr) = o;
                        o.x = pk2(bet[0], bet[1]); o.y = pk2(bet[2], bet[3]); *(LAS v2u*)(tmp + RWT_BT + s * 128 + 8 * fr) = o;
                        o.x = pk2(ktl[0], ktl[1]); o.y = pk2(ktl[2], ktl[3]); *(LAS v2u*)(tmp + RWT_KT + s * 128 + 8 * fr) = o;
                        o.x = pk2(rb[0], rb[1]); o.y = pk2(rb[2], rb[3]); *(LAS v2u*)(slot + RWS_RB + s * 128 + 8 * fr) = o;
#pragma unroll
                        for (int x = 0; x < 4; ++x) { kgt[x][j] = ktl[x] * all[x]; bgt[x][j] = -(bet[x] * all[x]); abt[x][j] = alb[x]; }
                    }
#pragma unroll
                    for (int x = 0; x < 4; ++x) {
                        const int kch = 4 * fr + x;
                        v2u o;
                        o.x = pk2(kgt[x][0], kgt[x][1]); o.y = pk2(kgt[x][2], kgt[x][3]); *(LAS v2u*)(slot + RWS_KGT + rwz(kch) * 32 + 8 * fq) = o;
                        o.x = pk2(bgt[x][0], bgt[x][1]); o.y = pk2(bgt[x][2], bgt[x][3]); *(LAS v2u*)(slot + RWS_BGT + rwz(kch) * 32 + 8 * fq) = o;
                        o.x = pk2(abt[x][0], abt[x][1]); o.y = pk2(abt[x][2], abt[x][3]); *(LAS v2u*)(tmp + RWT_ABT + rwz(kch) * 32 + 8 * fq) = o;
                    }
                    if (fq == 0) *(LAS f32x4*)(slot + RWS_G15 + 16 * fr) = all;
                    const unsigned vlo = (unsigned)cu.v[0] | ((unsigned)cu.v[1] << 16), vhi = (unsigned)cu.v[2] | ((unsigned)cu.v[3] << 16);
                    { v2u o; o.x = vlo; o.y = vhi; *(LAS v2u*)(slot + RWS_VCI + 8 * lane) = o; }
                    LDS_WAIT(); asm volatile("" ::: "memory");
                    f32x4 nac = (f32x4){0.f, 0.f, 0.f, 0.f}, kat = nac, krt = nac, nrt = nac;
#pragma unroll
                    for (int p = 0; p < 2; ++p) {
                        const int kb = (32 * p + 8 * fq) * 2;
                        const bf16x8 oAB = lds_op16(tmp + RWT_AB, fr, kb), oBT = lds_op16(tmp + RWT_BT, fr, kb), oKT = lds_op16(tmp + RWT_KT, fr, kb), oRB = lds_op16(slot + RWS_RB, fr, kb);
                        nac = __builtin_amdgcn_mfma_f32_16x16x32_bf16(oBT, oAB, nac, 0, 0, 0);
                        kat = __builtin_amdgcn_mfma_f32_16x16x32_bf16(oKT, oAB, kat, 0, 0, 0);
                        krt = __builtin_amdgcn_mfma_f32_16x16x32_bf16(oKT, oRB, krt, 0, 0, 0);
                        nrt = __builtin_amdgcn_mfma_f32_16x16x32_bf16(oBT, oRB, nrt, 0, 0, 0);
                    }
#pragma unroll
                    for (int i = 0; i < 4; ++i) { const int rr_ = 4 * fq + i;
                        if (rr_ >= fr) { nac[i] = 0.f; kat[i] = 0.f; }
                        if (rr_ > fr) { krt[i] = 0.f; nrt[i] = 0.f; } }
                    { u32x4_t o; o.x = pk2(krt[0], krt[1]); o.y = pk2(krt[2], krt[3]); o.z = pk2(-nrt[0], -nrt[1]); o.w = pk2(-nrt[2], -nrt[3]); *(LAS u32x4_t*)(slot + RWS_KNI + 16 * lane) = o; }
                    LDS_WAIT(); asm volatile("" ::: "memory");
                    *(LAS f32x4*)(tmp + RWT_NM + (fr * 16 + 4 * fq) * 4) = nac;
                    LDS_WAIT(); asm volatile("" ::: "memory");
                    float Tc[16];
                    f32x4 nvv[16][4];
#define RW_LD_ROWS(lo, hi) _Pragma("unroll") for (int s = lo; s <= hi; ++s) _Pragma("unroll") for (int r4 = 0; r4 < (s + 3) / 4; ++r4) nvv[s][r4] = *(const LAS f32x4*)(tmp + RWT_NM + (s * 16 + 4 * r4) * 4);
#define RW_DO_ROWS(lo, hi) _Pragma("unroll") for (int s = lo; s <= hi; ++s) { float acc_ = (s == fr) ? 1.f : 0.f; \
                        _Pragma("unroll") for (int r4 = 0; r4 < (s + 3) / 4; ++r4) _Pragma("unroll") for (int e = 0; e < 4; ++e) if (4 * r4 + e < s) acc_ -= nvv[s][r4][e] * Tc[4 * r4 + e]; \
                        Tc[s] = acc_; }
                    RW_LD_ROWS(1, 8) RW_LD_ROWS(9, 12)
                    asm volatile("" ::: "memory");
                    RW_DO_ROWS(0, 8)
                    RW_LD_ROWS(13, 15)
                    asm volatile("" ::: "memory");
                    RW_DO_ROWS(9, 12)
                    RW_DO_ROWS(13, 15)
#undef RW_LD_ROWS
#undef RW_DO_ROWS
#pragma unroll
                    for (int e = 0; e < 4; ++e) {
                        float tv = Tc[0];
#pragma unroll
                        for (int s = 0; s < 16; ++s) if (s == 4 * fq + e) tv = Tc[s];
                        *(LAS unsigned short*)(tmp + RWT_TM + ((4 * fq + e) * 16 + fr) * 2) = (unsigned short)f2bf(tv);
                    }
                    LDS_WAIT(); asm volatile("" ::: "memory");
                    const v2u tq = lds_8(tmp + RWT_TM + (fr * 16 + 4 * fq) * 2);
                    const bf16x8 opT = mk8(tq.x, tq.y, 0u, 0u);
                    f32x4 xac = __builtin_amdgcn_mfma_f32_16x16x32_bf16(mk8(pk2(kat[0], kat[1]), pk2(kat[2], kat[3]), 0u, 0u), mk8(vlo, vhi, 0u, 0u), (f32x4){0.f, 0.f, 0.f, 0.f}, 0, 0, 0);
                    const f32x4 wvv = __builtin_amdgcn_mfma_f32_16x16x32_bf16(opT, mk8(pk2(xac[0], xac[1]), pk2(xac[2], xac[3]), 0u, 0u), (f32x4){0.f, 0.f, 0.f, 0.f}, 0, 0, 0);
                    *(LAS f32x4*)(slot + RWS_WVI + 16 * lane) = wvv;
                    f32x4 aht[4];
#pragma unroll
                    for (int nt = 0; nt < 4; ++nt) {
                        const v2u ab = lds_8(tmp + RWT_ABT + rwz(16 * nt + fr) * 32 + 8 * fq);
                        aht[nt] = __builtin_amdgcn_mfma_f32_16x16x32_bf16(mk8(ab.x, ab.y, 0u, 0u), opT, (f32x4){0.f, 0.f, 0.f, 0.f}, 0, 0, 0);
                    }
#pragma unroll
                    for (int p = 0; p < 2; ++p) { u32x4_t o; o.x = pk2(aht[2 * p][0], aht[2 * p][1]); o.y = pk2(aht[2 * p][2], aht[2 * p][3]); o.z = pk2(aht[2 * p + 1][0], aht[2 * p + 1][1]); o.w = pk2(aht[2 * p + 1][2], aht[2 * p + 1][3]);
                        *(LAS u32x4_t*)(slot + RWS_AH + (p * 64 + lane) * 16) = o; }
                    LDS_WAIT(); asm volatile("" ::: "memory");
                    if (lane == 0) flg[cj % RW_NSLOT] = (unsigned)(cj + 1);
                }
            }
        } else {
            f32x4 St[4];
#pragma unroll
            for (int kt = 0; kt < 4; ++kt) St[kt] = (f32x4){0.f, 0.f, 0.f, 0.f};
            {
#pragma unroll 1
                for (int c = 0; c < NCH; ++c) {
                    const LAS unsigned char* slot = lds + (c % RW_NSLOT) * RWS_SLOT;
                    while (flg[c % RW_NSLOT] != (unsigned)(c + 1)) __builtin_amdgcn_s_sleep(1);
                    asm volatile("" ::: "memory");
                    f32x4 zt = *(const LAS f32x4*)(slot + RWS_WVI + 16 * lane);
                    f32x4 y = (f32x4){0.f, 0.f, 0.f, 0.f};
#pragma unroll
                    for (int p = 0; p < 2; ++p) {
                        const bf16x8 sb = mk8(pk2(St[2 * p][0], St[2 * p][1]), pk2(St[2 * p][2], St[2 * p][3]), pk2(St[2 * p + 1][0], St[2 * p + 1][1]), pk2(St[2 * p + 1][2], St[2 * p + 1][3]));
                        const v2u r0 = lds_8(slot + RWS_RB + fr * 128 + (32 * p + 4 * fq) * 2), r1 = lds_8(slot + RWS_RB + fr * 128 + (32 * p + 16 + 4 * fq) * 2);
                        zt = __builtin_amdgcn_mfma_f32_16x16x32_bf16(*(const LAS bf16x8*)(slot + RWS_AH + (p * 64 + lane) * 16), sb, zt, 0, 0, 0);
                        y = __builtin_amdgcn_mfma_f32_16x16x32_bf16(mk8(r0.x, r0.y, r1.x, r1.y), sb, y, 0, 0, 0);
                    }
                    const v2u vc = lds_8(slot + RWS_VCI + 8 * lane);
                    const bf16x8 b2 = mk8(vc.x, vc.y, pk2(zt[0], zt[1]), pk2(zt[2], zt[3]));
                    y = __builtin_amdgcn_mfma_f32_16x16x32_bf16(*(const LAS bf16x8*)(slot + RWS_KNI + 16 * lane), b2, y, 0, 0, 0);
#pragma unroll
                    for (int kt = 0; kt < 4; ++kt) {
                        const v2u kg = lds_8(slot + RWS_KGT + rwz(16 * kt + fr) * 32 + 8 * fq), bg = lds_8(slot + RWS_BGT + rwz(16 * kt + fr) * 32 + 8 * fq);
                        const f32x4 g15 = *(const LAS f32x4*)(slot + RWS_G15 + (16 * kt + 4 * fq) * 4);
                        St[kt] = __builtin_amdgcn_mfma_f32_16x16x32_bf16(mk8(kg.x, kg.y, bg.x, bg.y), b2, St[kt] * g15, 0, 0, 0);
                    }
                    bf16* yp = Y + (row0 + 16 * (size_t)c + 4 * fq) * 1024 + 64 * h + 16 * rg + fr;
#pragma unroll
                    for (int i = 0; i < 4; ++i) yp[(size_t)i * 1024] = (bf16)f2bf(y[i]);
                    LDS_WAIT(); asm volatile("" ::: "memory");
                    if (lane == 0) flg[RW_NSLOT] = (unsigned)(c + 1);
                }
            }
        }
        __syncthreads();
    }
}
__device__ __forceinline__ void rw_post(const bf16* Y, bf16* R, const bf16* K, const bf16* V, const bf16* A, const bf16* G, const float* k_a, const float* r_k, const float* ln_g, const float* ln_b, int gw, int ngw, int lane) {
    const int c = (gw & 3) * 256 + 4 * lane;
    const f32x4 ka = *(const f32x4*)(k_a + c), rk = *(const f32x4*)(r_k + c), lg = *(const f32x4*)(ln_g + c), lb = *(const f32x4*)(ln_b + c);
    for (int it = gw; it < M * 4; it += 2 * ngw) {
        const int it2 = (it + ngw < M * 4) ? it + ngw : it;
        const size_t off[2] = {(size_t)(it >> 2) * 1024 + c, (size_t)(it2 >> 2) * 1024 + c};
        v2u yv[2], rv[2], kv[2], vv[2], av[2], gv[2];
#pragma unroll
        for (int u = 0; u < 2; ++u) { yv[u] = *(const v2u*)(Y + off[u]); rv[u] = *(const v2u*)(R + off[u]); kv[u] = *(const v2u*)(K + off[u]); vv[u] = *(const v2u*)(V + off[u]); av[u] = *(const v2u*)(A + off[u]); gv[u] = *(const v2u*)(G + off[u]); }
#pragma unroll
        for (int u = 0; u < 2; ++u) {
            const f32x4 y = bf4(yv[u]), r = bf4(rv[u]), k = bf4(kv[u]), v = bf4(vv[u]), a = bf4(av[u]), g = bf4(gv[u]);
            const float mu = row16_sum((y[0] + y[1]) + (y[2] + y[3])) * (1.0f / 64.0f);
            const f32x4 yc = y - mu;
            const float var = row16_sum((yc[0] * yc[0] + yc[1] * yc[1]) + (yc[2] * yc[2] + yc[3] * yc[3])) * (1.0f / 64.0f);
            const float rstd = 1.0f / sqrtf(var + 64e-5f);
            const f32x4 km = k * (1.0f + (a - 1.0f) * ka);
            const f32x4 pr = r * km * rk;
            const float cs = row16_sum((pr[0] + pr[1]) + (pr[2] + pr[3]));
            const f32x4 o = (yc * rstd * lg + lb + v * cs) * g;
            v2u wv; wv.x = pk2(o[0], o[1]); wv.y = pk2(o[2], o[3]);
            if (u == 0 || it2 != it) *(v2u*)(R + off[u]) = wv;
        }
    }
}

__device__ __forceinline__ void sc_conv(const bf16* BG, const bf16* CG, const bf16* HX, const float* cw, const float* cb, bf16* O3, int gt, int ngt) {
    const int c = (gt & 127) * 8;
    float w0[8], w1[8], w2[8], bb[8];
#pragma unroll
    for (int j = 0; j < 8; ++j) { w0[j] = cw[c + j]; w1[j] = cw[1024 + c + j]; w2[j] = cw[2048 + c + j]; bb[j] = cb[c + j]; }
    for (int idx = gt; idx < M * 128; idx += 2 * ngt) {
        const int idx2 = idx + ngt < M * 128 ? idx + ngt : idx;
        v4u cv[2][3], hv[2][3], bv[2]; int tt[2]; size_t offs[2];
#pragma unroll
        for (int u = 0; u < 2; ++u) {
            const int m = (u ? idx2 : idx) >> 7; tt[u] = m & (SEQ - 1); offs[u] = (size_t)m * 1024 + c;
#pragma unroll
            for (int dt = 0; dt < 3; ++dt) { const size_t o2 = offs[u] - (size_t)((tt[u] - 2 + dt >= 0) ? (2 - dt) : 0) * 1024; cv[u][dt] = *(const v4u*)(CG + o2); hv[u][dt] = *(const v4u*)(HX + o2); }
            bv[u] = *(const v4u*)(BG + offs[u]);
        }
#pragma unroll
        for (int u = 0; u < 2; ++u) {
            float y[8];
#pragma unroll
            for (int j = 0; j < 8; ++j) y[j] = bb[j];
#pragma unroll
            for (int dt = 0; dt < 3; ++dt) {
                const float on = (tt[u] - 2 + dt >= 0) ? 1.f : 0.f;
                const float* wp = dt == 0 ? w0 : (dt == 1 ? w1 : w2);
                const v4u cq = cv[u][dt], hq = hv[u][dt];
                y[0] += on * wp[0] * (bflo(cq.x) * bflo(hq.x)); y[1] += on * wp[1] * (bfhi(cq.x) * bfhi(hq.x));
                y[2] += on * wp[2] * (bflo(cq.y) * bflo(hq.y)); y[3] += on * wp[3] * (bfhi(cq.y) * bfhi(hq.y));
                y[4] += on * wp[4] * (bflo(cq.z) * bflo(hq.z)); y[5] += on * wp[5] * (bfhi(cq.z) * bfhi(hq.z));
                y[6] += on * wp[6] * (bflo(cq.w) * bflo(hq.w)); y[7] += on * wp[7] * (bfhi(cq.w) * bfhi(hq.w));
            }
            const v4u bq = bv[u];
            v4u w; w.x = pk2(y[0] * bflo(bq.x), y[1] * bfhi(bq.x)); w.y = pk2(y[2] * bflo(bq.y), y[3] * bfhi(bq.y)); w.z = pk2(y[4] * bflo(bq.z), y[5] * bfhi(bq.z)); w.w = pk2(y[6] * bflo(bq.w), y[7] * bfhi(bq.w));
            if (u == 0 || idx2 != idx) *(v4u*)(O3 + offs[u]) = w;
        }
    }
}

#define XB_TMO      128
#define XB_XCNT(j)  (256  + 64 * (j))
#define XB_XSUB(j)  (1280 + 64 * (j))
#define XB_XGEN(j)  (2304 + 64 * (j))
#define XB_TOP      3328
#define XB_TOPGEN   3392
#define XCD_BAR_WORDS 3456
#define XB_SPIN_CAP (1u << 18)

__device__ __forceinline__ unsigned xb_ld(unsigned* p)              { return __hip_atomic_load(p, __ATOMIC_RELAXED, __HIP_MEMORY_SCOPE_AGENT); }
__device__ __forceinline__ unsigned xb_add(unsigned* p, unsigned v) { return __hip_atomic_fetch_add(p, v, __ATOMIC_RELAXED, __HIP_MEMORY_SCOPE_AGENT); }
__device__ __forceinline__ unsigned xb_xcc_id() { return (unsigned)__builtin_amdgcn_s_getreg((3 << 11) | 20) & 0xFu; }
#define XB_SPIN(cond, bar) do { unsigned _sp = 0; while (cond) { __builtin_amdgcn_s_sleep(1); \
    if ((++_sp & 255u) == 0u) { if (xb_ld(&(bar)[XB_TMO])) break; if (_sp > XB_SPIN_CAP) { atomicAdd(&(bar)[XB_TMO], 1u); break; } } } } while (0)

struct XcdBarrier {
    unsigned* bar; unsigned x;
    volatile LAS unsigned* st;
};

__device__ __forceinline__ XcdBarrier xcd_barrier_post(unsigned* bar, volatile LAS unsigned* st) {
    XcdBarrier b; b.bar = bar; b.x = xb_xcc_id(); b.st = st;
    if (threadIdx.x == 0) (void)xb_add(&bar[XB_XCNT(b.x)], 1u);
    return b;
}
__device__ __forceinline__ void xcd_barrier_complete(unsigned* bar, unsigned x, unsigned& nloc, unsigned& nx) {
    const unsigned G = gridDim.x * gridDim.y * gridDim.z;
    unsigned sum, cnt, mine, sp = 0u;
    for (;;) {
        sum = 0u; cnt = 0u; mine = 0u;
#pragma unroll
        for (unsigned j = 0; j < 16; ++j) { const unsigned c = xb_ld(&bar[XB_XCNT(j)]); sum += c; cnt += (c > 0u) ? 1u : 0u; mine = (j == x) ? c : mine; }
        if (sum == G) break;
        __builtin_amdgcn_s_sleep(1);
        if ((++sp & 255u) == 0u) { if (xb_ld(&bar[XB_TMO])) break; if (sp > XB_SPIN_CAP) { atomicAdd(&bar[XB_TMO], 1u); break; } }
    }
    nloc = mine > 0u ? mine : 1u; nx = cnt > 0u ? cnt : 1u;
}

__device__ __forceinline__ void xcd_barrier(const XcdBarrier& b) {
    asm volatile("s_waitcnt vmcnt(0)" ::: "memory");
    __syncthreads();
    if (threadIdx.x == 0) {
        unsigned* bar = b.bar;
        __builtin_amdgcn_s_waitcnt(0);
        unsigned nloc = b.st[0], nx = b.st[1];
        if (nloc == 0u) { xcd_barrier_complete(bar, b.x, nloc, nx); b.st[0] = nloc; b.st[1] = nx; }
        const unsigned old = xb_add(&bar[XB_XSUB(b.x)], 1u);
        const unsigned gen = old / nloc;
        if (old + 1u == (gen + 1u) * nloc) {
            __builtin_amdgcn_fence(__ATOMIC_RELEASE, "agent");
            asm volatile("s_waitcnt vmcnt(0)" ::: "memory");
            const unsigned og = xb_add(&bar[XB_TOP], 1u);
            const unsigned tg = og / nx;
            if (og + 1u == (tg + 1u) * nx) xb_add(&bar[XB_TOPGEN], 1u);
            else XB_SPIN(xb_ld(&bar[XB_TOPGEN]) == tg, bar);
            __builtin_amdgcn_fence(__ATOMIC_ACQUIRE, "agent");
            xb_add(&bar[XB_XGEN(b.x)], 1u);
            asm volatile("s_waitcnt vmcnt(0)" ::: "memory");
        } else {
            XB_SPIN(xb_ld(&bar[XB_XGEN(b.x)]) == gen, bar);
            __builtin_amdgcn_fence(__ATOMIC_ACQUIRE, "agent");
            asm volatile("s_waitcnt vmcnt(0)" ::: "memory");
        }
    }
    __syncthreads();
}

struct Args { const float* in[32]; float* out; unsigned char* ws; };
#define PHASE_VARS \
    size_t zoff_ = 0; asm volatile("" : "+s"(zoff_)); unsigned char* ws = a.ws + zoff_; float* out = a.out + zoff_;     \
    int tid = threadIdx.x; asm volatile("" : "+v"(tid)); \
    const int lane = tid & 63, wave = __builtin_amdgcn_readfirstlane(tid >> 6); \
    const int G = gridDim.x, gw = blockIdx.x * NWAVES + wave, ngw = G * NWAVES, gt = blockIdx.x * NTHR + tid, ngt = G * NTHR; \
    float* RS = (float*)(ws + WS_BIG + 402 * MiB)  ; float* RSM = (float*)(ws + WS_RS)  ; float* LBK = (float*)(ws + WS_LBK); (void)RSM; \
    bf16* WA = (bf16*)(ws + WS_WA); bf16* WB = (bf16*)(ws + WS_WB); bf16* WO = (bf16*)(ws + WS_WO); bf16* WUP = (bf16*)(ws + WS_WUP); bf16* WDN = (bf16*)(ws + WS_WDN); \
    bf16* HB = (bf16*)(ws + WS_HB); \
    bf16* B0 = (bf16*)(ws + WS_BIG); bf16* B1 = (bf16*)(ws + WS_BIG + SLOT); bf16* B2 = (bf16*)(ws + WS_BIG + 2 * SLOT); bf16* B3 = (bf16*)(ws + WS_BIG + 3 * SLOT); \
    bf16* B4 = (bf16*)(ws + WS_BIG + 4 * SLOT); bf16* B5 = (bf16*)(ws + WS_BIG + 5 * SLOT); bf16* B5b = (bf16*)(ws + WS_BIG + 5 * SLOT + 16 * MiB); \
    LAS float* scr = (LAS float*)(lds + wave * 16384); \
    (void)lane; (void)gw; (void)ngw; (void)gt; (void)ngt; (void)RS; (void)LBK; (void)WA; (void)WB; (void)WO; (void)WUP; (void)WDN; (void)HB; (void)B0; (void)B1; (void)B2; (void)B3; (void)B4; (void)B5; (void)B5b; (void)scr; (void)out; (void)G;
constexpr size_t SLOT_E = SLOT / 2;

__global__ void __launch_bounds__(NTHR, 2) fwd_megakernel(Args a) {
    extern __shared__ __attribute__((aligned(16))) unsigned char lds_raw[];
    cg::grid_group grid = cg::this_grid();
    LAS unsigned char* lds = (LAS unsigned char*)lds_raw;
    volatile LAS unsigned* xb_st = (volatile LAS unsigned*)(lds + LDS_BYTES - 64);
    if (threadIdx.x < 2) xb_st[threadIdx.x] = 0u;
    __syncthreads();
    const XcdBarrier xbar = xcd_barrier_post((unsigned*)(a.ws + WS_BAR), xb_st);

#pragma nounroll
    for (int layer = 0; layer < 4; ++layer) {
        for (int rp_ = 0; rp_ < REP_PRO; ++rp_) { PHASE_VARS
        const float* gmix = a.in[1] + layer * 1024; const float* gffn = a.in[2] + layer * 1024;
        conv_mat(a.in[3] + (size_t)layer * D * FF, D, FF, WUP, D, 0, 0, gffn, scr, gw, ngw, lane);
        conv_mat(a.in[4] + (size_t)layer * D * FF, FF, D, WDN, FF, 0, 0, nullptr, scr, gw, ngw, lane);
        if (layer == 0) {
            conv_mat(a.in[6], D, 3 * D, WA, D, 0, 0, gmix, scr, gw, ngw, lane);
            conv_mat(a.in[7], D, D, WO, D, 0, 0, nullptr, scr, gw, ngw, lane);
            for (int m0 = gw; m0 < M; m0 += 4 * ngw) {
                f32x4 v[4][4];
#pragma unroll
                for (int u = 0; u < 4; ++u) { const int ml = m0 + u * ngw < M ? m0 + u * ngw : m0; const f32x4* xr = (const f32x4*)(a.in[0] + (size_t)ml * 1024) + lane;
#pragma unroll
                    for (int j = 0; j < 4; ++j) v[u][j] = xr[64 * j]; }
#pragma unroll
                for (int u = 0; u < 4; ++u) { const int m = m0 + u * ngw; if (m >= M) break; float ss = 0.f;
#pragma unroll
                    for (int j = 0; j < 4; ++j) { ss += (v[u][j][0] * v[u][j][0] + v[u][j][1] * v[u][j][1]) + (v[u][j][2] * v[u][j][2] + v[u][j][3] * v[u][j][3]);
                        v2u w; w.x = pk2(v[u][j][0], v[u][j][1]); w.y = pk2(v[u][j][2], v[u][j][3]); *(v2u*)(HB + (size_t)m * 1024 + 4 * lane + 256 * j) = w; }
                    ss = wave_sum(ss);
                    if (lane < 16) RS[(size_t)m * 16 + lane] = lane == 0 ? ss : 0.f; }
            }
        } else if (layer == 1) {
            conv_mat(a.in[8], D, 4 * D, WA, D, 0, 0, gmix, scr, gw, ngw, lane);
            conv_mat(a.in[11], D, D, WO, D, 0, 0, nullptr, scr, gw, ngw, lane);
            for (int c = gt; c < 1024; c += ngt) {
                const float* tb = a.in[9]; const float t0 = tb[c], t1 = tb[1024 + c], t2 = tb[2048 + c], t3 = tb[3072 + c];
                const float mx = fmaxf(fmaxf(t0, t1), fmaxf(t2, t3));
                const float e0 = expf(t0 - mx), e1 = expf(t1 - mx), e2 = expf(t2 - mx), e3 = expf(t3 - mx);
                LBK[c] = 1.0f - e1 / (e0 + e1 + e2 + e3);
            }
        } else if (layer == 2) {
            const float* mix = a.in[12];
#pragma nounroll
            for (int j = 0; j < 3; ++j) {
                conv_mat(a.in[13] + (size_t)j * D * D, D, D, WA, 2048, 1024 * j, 0, nullptr, scr, gw, ngw, lane);
                conv_mat(a.in[13] + (size_t)j * D * D, D, D, WA, 2048, 1024 * j, 1024, mix + 1024 * j, scr, gw, ngw, lane);
            }
            conv_mat(a.in[15], D, 64, WA, 2048, 3072, 0, nullptr, scr, gw, ngw, lane); conv_mat(a.in[15], D, 64, WA, 2048, 3072, 1024, mix + 3 * 1024, scr, gw, ngw, lane);
            conv_mat(a.in[18], D, 64, WA, 2048, 3136, 0, nullptr, scr, gw, ngw, lane); conv_mat(a.in[18], D, 64, WA, 2048, 3136, 1024, mix + 4 * 1024, scr, gw, ngw, lane);
            conv_mat(a.in[20], D, 128, WA, 2048, 3200, 0, nullptr, scr, gw, ngw, lane); conv_mat(a.in[20], D, 128, WA, 2048, 3200, 1024, mix + 5 * 1024, scr, gw, ngw, lane);
            conv_mat(a.in[27], D, D, WO, D, 0, 0, nullptr, scr, gw, ngw, lane);
            for (int idx = gt; idx < 256 * 3072; idx += ngt) {
                const int k = idx / 3072, n = idx - k * 3072, grp = n >> 10, nn = n & 1023; float v = 0.f;
                if (grp == 0) { if (k < 64) v = a.in[16][k * 1024 + nn]; }
                else if (grp == 1) { if (k >= 64 && k < 128) v = a.in[19][(k - 64) * 1024 + nn]; }
                else { if (k >= 128) v = a.in[21][(k - 128) * 1024 + nn]; }
                WB[(size_t)n * 256 + k] = (bf16)f2bf(v);
            }
            rw_prep(HB, RS, gmix, B0, gw, ngw, lane);
        } else {
            conv_mat(a.in[28], D, 3 * D, WA, D, 0, 0, gmix, scr, gw, ngw, lane);
            conv_mat(a.in[31], D, D, WO, D, 0, 0, nullptr, scr, gw, ngw, lane);
        }
        }
        if (layer == 0) grid.sync();
        else GRID_SYNC();

        if (layer == 0 || layer == 3) {
            { PHASE_VARS
            pg8::Gemm g{HB, WA, M, 3 * D, D}; pg8::StaticOrder S; S.init(M, 3 * D, G, (int)blockIdx.x);
            pg8::EpiAct<0> E{B0, 1024, 1024, SLOT_E, RS, layer == 0 ? 0.125f * LOG2E_F : 1.0f, nullptr};
            for (int r_ = 0; r_ < REP_IN; ++r_) pg8::gemm_phase<pg8::EpiAct<0>, pg8::StaticOrder, true, true>(lds, g, S, E); }
            GRID_SYNC();
            { PHASE_VARS
            if (layer == 0) { for (int r_ = 0; r_ < REP_ATT; ++r_) attn_phase(B0, B1, B2, B3, gw, ngw, lane); }
            else { for (int r_ = 0; r_ < REP_SC; ++r_) sc_conv(B0, B1, B2, a.in[29], a.in[30], B3, gt, ngt); } }
        } else if (layer == 1) {
            { PHASE_VARS
            pg8::Gemm g{HB, WA, M, 4 * D, D}; pg8::StaticOrder S; S.init(M, 4 * D, G, (int)blockIdx.x);
            pg8::EpiAct<2> E{B0, 1024, 1024, SLOT_E, RS, 1.0f, LBK};
            for (int r_ = 0; r_ < REP_IN; ++r_) pg8::gemm_phase<pg8::EpiAct<2>, pg8::StaticOrder, true, true>(lds, g, S, E); }
            GRID_SYNC();
            { PHASE_VARS
            hg_local(B0, B1, (bf16*)out, (bf16*)out + (size_t)M * 1024, B4, B2, (float*)B5, (float*)(ws + WS_BIG + 5 * SLOT + 8 * MiB), (float*)(ws + WS_BIG + 5 * SLOT + 24 * MiB)); }
            GRID_SYNC();
            { PHASE_VARS
            hg_out((const bf16*)out, (const bf16*)out + (size_t)M * 1024, B4, B2, (const float*)B5, (const float*)(ws + WS_BIG + 5 * SLOT + 8 * MiB), (const float*)(ws + WS_BIG + 5 * SLOT + 24 * MiB), a.in[10], B3, lds); }
        } else {
            { PHASE_VARS
              pg8::Gemm g{B0, WA, M, 3328, 2048}; pg8::StaticOrder S; S.init(M, 3328, G, (int)blockIdx.x);
              pg8::EpiRw1 E{B2, SLOT_E, B5};
              for (int r_ = 0; r_ < REP_G1; ++r_) pg8::gemm_phase<pg8::EpiRw1, pg8::StaticOrder, true, true>(lds, g, S, E); }
            GRID_SYNC();
            { PHASE_VARS
              int k256 = 256; asm volatile("" : "+s"(k256));
              pg8::Gemm g{B5, WB, M, 3 * D, k256}; pg8::StaticOrder S; S.init(M, 3 * D, G, (int)blockIdx.x);
              pg8::EpiRw2 E{B0, SLOT_E, 5 * SLOT_E + 8 * MiB, a.in[14], a.in[17]};
              for (int r_ = 0; r_ < REP_G2; ++r_) pg8::gemm_phase<pg8::EpiRw2, pg8::StaticOrder, true, true>(lds, g, S, E); }
            GRID_SYNC();
            { PHASE_VARS
            for (int r_ = 0; r_ < REP_RW; ++r_) rw_scan(B2, B3, B4, B0, B1, a.in[22], a.in[23], (bf16*)out, lds); }
            GRID_SYNC();
            { PHASE_VARS
            rw_post((const bf16*)out, B2, B3, B4, B1, B5b, a.in[23], a.in[24], a.in[25], a.in[26], gw, ngw, lane); }
        }
        GRID_SYNC();
        { PHASE_VARS
          const bf16* mix_out = (layer == 2) ? B2 : B3;
          pg8::Gemm g{mix_out, WO, M, D, D}; pg8::StaticOrder S; S.init(M, D, G, (int)blockIdx.x);
          pg8::EpiResidB E{HB, RSM, nullptr};
          pg8::gemm_phase<pg8::EpiResidB, pg8::StaticOrder, true, true>(lds, g, S, E); }
        GRID_SYNC();
        { PHASE_VARS
          pg8::Gemm g{HB, WUP, M, FF, D}; pg8::StaticOrder S; S.init(M, FF, G, (int)blockIdx.x);
          pg8::EpiAct<1> E{B0, FF, 0, 0, nullptr, 1.0f, nullptr};
#pragma nounroll
          for (int r_ = 0; r_ < REP_UP; ++r_) pg8::gemm_phase<pg8::EpiAct<1>, pg8::StaticOrder, true, true>(lds, g, S, E); }
        GRID_SYNC();
        { PHASE_VARS
          pg8::Gemm g{B0, WDN, M, D, FF}; pg8::StaticOrder S; S.init(M, D, G, (int)blockIdx.x);
          pg8::EpiResidB E{HB, RS, RSM};
          pg8::gemm_phase<pg8::EpiResidB, pg8::StaticOrder, true, true>(lds, g, S, E); }
        GRID_SYNC();
    }
    { PHASE_VARS
    const f32x4* gr = (const f32x4*)(a.in[5]) + lane;
    const f32x4 g0 = gr[0], g1 = gr[64], g2 = gr[128], g3 = gr[192];
    for (int m0 = gw; m0 < M; m0 += 4 * ngw) {
        f32x4 v[4][4]; f32x4 pr[4];
#pragma unroll
        for (int u = 0; u < 4; ++u) { const int m = m0 + u * ngw < M ? m0 + u * ngw : m0;
            pr[u] = *(const f32x4*)(RS + (size_t)m * 16 + 4 * (lane & 3));
#pragma unroll
            for (int j = 0; j < 4; ++j) v[u][j] = bf4(*(const v2u*)(HB + (size_t)m * 1024 + 4 * lane + 256 * j)); }
#pragma unroll
        for (int u = 0; u < 4; ++u) { const int m = m0 + u * ngw; if (m >= M) break; f32x4* xr = (f32x4*)(out + (size_t)m * 1024) + lane;
            float s = (pr[u][0] + pr[u][1]) + (pr[u][2] + pr[u][3]); s += dpp_f<0xB1>(s); s += dpp_f<0x4E>(s);
            const float r = 1.0f / sqrtf(s * (1.0f / 1024.0f) + 1e-6f);
            xr[0] = v[u][0] * r * g0; xr[64] = v[u][1] * r * g1; xr[128] = v[u][2] * r * g2; xr[192] = v[u][3] * r * g3; }
    } }
}

extern "C" void kernel_launch(void* const* d_in, const int* in_sizes, int n_in, void* d_out, int out_size, void* d_ws, size_t ws_size, hipStream_t stream) {
    static int grid = 0;
    if (grid == 0) {
        if (n_in != 32 || out_size != M * D || ws_size < WS_END) { fprintf(stderr, "kernel_launch: unexpected shapes (n_in %d out %d ws %zu)\n", n_in, out_size, ws_size); grid = -1; return; }
        int dev = 0, cus = 0, per_cu = 0;
        hipGetDevice(&dev); hipDeviceGetAttribute(&cus, hipDeviceAttributeMultiprocessorCount, dev);
        hipFuncSetAttribute((const void*)fwd_megakernel, hipFuncAttributeMaxDynamicSharedMemorySize, LDS_BYTES);
        hipOccupancyMaxActiveBlocksPerMultiprocessor(&per_cu, (const void*)fwd_megakernel, NTHR, LDS_BYTES);
        if (per_cu < 1) { fprintf(stderr, "kernel_launch: occupancy query says %d blocks per CU\n", per_cu); per_cu = 1; }
        (void)hipGetLastError();
        grid = cus * per_cu;
    }
    if (grid < 0) return;
    if (hipMemsetAsync((char*)d_ws + WS_BAR, 0, WS_BAR_BYTES, stream) != hipSuccess) { fprintf(stderr, "kernel_launch: memset of the barrier words failed\n"); return; }
    Args a{};
    for (int i = 0; i < 32; ++i) a.in[i] = (const float*)d_in[i];
    a.out = (float*)d_out; a.ws = (unsigned char*)d_ws;
    void* args[] = {&a};
    hipError_t e = hipLaunchCooperativeKernel((const void*)fwd_megakernel, dim3(grid), dim3(NTHR), args, LDS_BYTES, stream);
    if (e != hipSuccess) fprintf(stderr, "cooperative launch failed: %s (grid %d)\n", hipGetErrorString(e), grid);
}
```
